# Optimizing an MI355X kernel written in HIP

```python
import jax, jax.numpy as jnp
from jax import lax
import numpy as np

D_MODEL = 1024
BATCH = 8
SEQ = 4096
DEPTH = 1

MIX_WIDTH = D_MODEL
CONV_CH = MIX_WIDTH // 2
RWKV_CH = MIX_WIDTH - CONV_CH
RWKV_HEAD = 64
RWKV_HEADS = RWKV_CH // RWKV_HEAD
CONV_WIDTH = 31
LORA_W = 64
LORA_A = 64
LORA_G = 128
RWKV_PROJ = 3 * RWKV_CH + LORA_W + LORA_A + LORA_G
IN_PROJ = 2 * CONV_CH + RWKV_PROJ
RWKV_SPLITS = [RWKV_CH, 2 * RWKV_CH, 3 * RWKV_CH, 3 * RWKV_CH + LORA_W, 3 * RWKV_CH + LORA_W + LORA_A]
PEER_HEADS = 8
PEER_NKEYS = 128
PEER_EXPERTS = PEER_NKEYS * PEER_NKEYS
PEER_DQ = 256
PEER_TOPK = 16
PEER_CHUNK = 128
RMS_EPS = 1e-6
LN_EPS = 1e-5
GN_EPS = 64e-5

kernel_name = 'hymba_conv_rwkv7_peer_adaln_block'

F32 = jnp.float32


def rmsnorm(x, g):
    xf = x.astype(F32)
    y = xf * lax.rsqrt(jnp.mean(xf * xf, axis=-1, keepdims=True) + RMS_EPS)
    return (y * g.astype(F32)).astype(x.dtype)


def modulate(x, shift, scale):
    return x * (1 + scale[:, None, :]) + shift[:, None, :]


def conformer_conv(p_conv, w_dw, b_dw, ln_w, ln_b):
    a, b = jnp.split(p_conv, 2, axis=-1)
    y = a * jax.nn.sigmoid(b)
    y = lax.conv_general_dilated(
        y, w_dw[:, None, :], window_strides=(1,), padding=[(CONV_WIDTH - 1, 0)],
        dimension_numbers=('NWC', 'WIO', 'NWC'), feature_group_count=CONV_CH) + b_dw
    yf = y.astype(F32)
    mu = jnp.mean(yf, axis=-1, keepdims=True)
    var = jnp.mean(jnp.square(yf - mu), axis=-1, keepdims=True)
    yf = (yf - mu) * lax.rsqrt(var + LN_EPS) * ln_w.astype(F32) + ln_b.astype(F32)
    return jax.nn.silu(yf).astype(p_conv.dtype)


def token_shift(p, mu):
    prev = jnp.pad(p, ((0, 0), (1, 0), (0, 0)))[:, :-1]
    return p + mu * (prev - p)


def rwkv7_mix(p_rwkv, mu, w0, w2, a0, a2, g2, k_k, k_a, r_k, gn_w, gn_b):
    B, S, _ = p_rwkv.shape
    xs = token_shift(p_rwkv, mu)
    r, k, v, wl, al, gl = jnp.split(xs, RWKV_SPLITS, axis=-1)
    w = -jax.nn.softplus(-(w0 + jnp.tanh(wl) @ w2)) - 0.5
    decay = jnp.exp(-jnp.exp(w.astype(F32)))
    a = jax.nn.sigmoid(a0 + al @ a2)
    g = jax.nn.sigmoid(gl) @ g2
    kk = k * k_k
    k = k * (1 + (a - 1) * k_a)

    def heads(t):
        return t.reshape(B, S, RWKV_HEADS, RWKV_HEAD).astype(F32)

    kk_h = heads(kk)
    kk_h = kk_h / jnp.maximum(jnp.sqrt(jnp.sum(kk_h * kk_h, axis=-1, keepdims=True)), 1e-12)
    r_h, k_h, v_h, w_h, a_h = heads(r), heads(k), heads(v), decay.reshape(B, S, RWKV_HEADS, RWKV_HEAD), heads(a)

    def step(state, inp):
        r_t, k_t, v_t, w_t, kk_t, a_t = inp
        sa = jnp.einsum('bhij,bhj->bhi', state, -kk_t)
        state = (state * w_t[:, :, None, :]
                 + sa[..., None] * (kk_t * a_t)[:, :, None, :]
                 + v_t[..., None] * k_t[:, :, None, :])
        y_t = jnp.einsum('bhij,bhj->bhi', state, r_t)
        return state, y_t

    def seq_first(t):
        return jnp.moveaxis(t, 1, 0)

    state0 = jnp.zeros((B, RWKV_HEADS, RWKV_HEAD, RWKV_HEAD), F32)
    _, y = lax.scan(step, state0, (seq_first(r_h), seq_first(k_h), seq_first(v_h),
                                   seq_first(w_h), seq_first(kk_h), seq_first(a_h)))
    y = jnp.moveaxis(y, 0, 1)
    mean = jnp.mean(y, axis=-1, keepdims=True)
    var = jnp.mean(jnp.square(y - mean), axis=-1, keepdims=True)
    y = ((y - mean) * lax.rsqrt(var + GN_EPS)).reshape(B, S, RWKV_CH) * gn_w.astype(F32) + gn_b.astype(F32)
    bonus = jnp.sum(r_h * k_h * r_k.astype(F32), axis=-1, keepdims=True) * v_h
    y = y + bonus.reshape(B, S, RWKV_CH)
    return (y * g.astype(F32)).astype(p_rwkv.dtype)


def peer_ffn(u, w_q, sub_keys, expert_u, expert_v):
    B, S, D = u.shape
    tokens = u.reshape(-1, PEER_CHUNK, D)

    def chunk(xc):
        tc = xc.shape[0]
        q = (xc @ w_q).reshape(tc, PEER_HEADS, 2, PEER_DQ // 2)
        s = jnp.einsum('thpd,hpkd->thpk', q, sub_keys).astype(F32)
        s_top, i_top = lax.top_k(s, PEER_TOPK)
        cand = s_top[:, :, 0, :, None] + s_top[:, :, 1, None, :]
        cand_idx = i_top[:, :, 0, :, None] * PEER_NKEYS + i_top[:, :, 1, None, :]
        best, pos = lax.top_k(cand.reshape(tc, PEER_HEADS, PEER_TOPK * PEER_TOPK), PEER_TOPK)
        expert = jnp.take_along_axis(cand_idx.reshape(tc, PEER_HEADS, PEER_TOPK * PEER_TOPK), pos, axis=-1)
        gate = jax.nn.softmax(best, axis=-1)
        ue = jnp.take(expert_u, expert, axis=0)
        ve = jnp.take(expert_v, expert, axis=0)
        h = jax.nn.gelu(jnp.einsum('thkd,td->thk', ue, xc).astype(F32), approximate=False)
        return jnp.einsum('thk,thkd->td', (gate * h).astype(xc.dtype), ve)

    out = lax.map(chunk, tokens)
    return out.reshape(B, S, D)


def setup_inputs(seed: int = 0) -> dict:
    key = jax.random.key(seed)
    ks = iter(jax.random.split(key, 32))

    def nrm(shape, scale):
        return scale * jax.random.normal(next(ks), shape, jnp.float32)

    def gain(shape):
        return 1.0 + nrm(shape, 0.02)

    L = DEPTH
    return {
        'x': nrm((BATCH, SEQ, D_MODEL), 1.0),
        'c': nrm((BATCH, D_MODEL), 1.0),
        'ada_w': nrm((L, D_MODEL, 6 * D_MODEL), D_MODEL ** -0.5),
        'ada_b': nrm((L, 6 * D_MODEL), 0.02),
        'norm_mix_g': gain((L, D_MODEL)),
        'w_in': nrm((L, D_MODEL, IN_PROJ), D_MODEL ** -0.5),
        'conv_dw_w': nrm((L, CONV_WIDTH, CONV_CH), CONV_WIDTH ** -0.5),
        'conv_dw_b': nrm((L, CONV_CH), 0.02),
        'conv_ln_w': gain((L, CONV_CH)),
        'conv_ln_b': nrm((L, CONV_CH), 0.02),
        'rwkv_mu': jax.random.uniform(next(ks), (L, RWKV_PROJ), jnp.float32),
        'rwkv_w0': jax.random.uniform(next(ks), (L, RWKV_CH), jnp.float32, -6.0, 1.0),
        'rwkv_w2': nrm((L, LORA_W, RWKV_CH), 0.5 * LORA_W ** -0.5),
        'rwkv_a0': nrm((L, RWKV_CH), 0.1),
        'rwkv_a2': nrm((L, LORA_A, RWKV_CH), 0.5 * LORA_A ** -0.5),
        'rwkv_g2': nrm((L, LORA_G, RWKV_CH), LORA_G ** -0.5),
        'rwkv_k_k': 0.85 + nrm((L, RWKV_CH), 0.02),
        'rwkv_k_a': gain((L, RWKV_CH)),
        'rwkv_r_k': nrm((L, RWKV_HEADS, RWKV_HEAD), 0.1),
        'rwkv_gn_w': gain((L, RWKV_CH)),
        'rwkv_gn_b': nrm((L, RWKV_CH), 0.02),
        'w_out': nrm((L, MIX_WIDTH, D_MODEL), MIX_WIDTH ** -0.5),
        'norm_ffn_g': gain((L, D_MODEL)),
        'peer_w_q': nrm((L, D_MODEL, PEER_HEADS * PEER_DQ), D_MODEL ** -0.5),
        'peer_sub_keys': nrm((L, PEER_HEADS, 2, PEER_NKEYS, PEER_DQ // 2), (PEER_DQ // 2) ** -0.5),
        'peer_u': nrm((L, PEER_EXPERTS, D_MODEL), D_MODEL ** -0.5),
        'peer_v': nrm((L, PEER_EXPERTS, D_MODEL), (PEER_HEADS * PEER_TOPK) ** -0.5),
        'final_g': gain((D_MODEL,)),
    }


def reference(x, c, ada_w, ada_b, norm_mix_g, w_in, conv_dw_w, conv_dw_b, conv_ln_w, conv_ln_b,
              rwkv_mu, rwkv_w0, rwkv_w2, rwkv_a0, rwkv_a2, rwkv_g2, rwkv_k_k, rwkv_k_a, rwkv_r_k,
              rwkv_gn_w, rwkv_gn_b, w_out, norm_ffn_g, peer_w_q, peer_sub_keys, peer_u, peer_v, final_g):
    for l in range(DEPTH):
        mod = jax.nn.silu(c) @ ada_w[l] + ada_b[l]
        sh_mix, sc_mix, gt_mix, sh_ffn, sc_ffn, gt_ffn = jnp.split(mod, 6, axis=-1)

        u = modulate(rmsnorm(x, norm_mix_g[l]), sh_mix, sc_mix)
        p = u @ w_in[l]
        y_conv = conformer_conv(p[..., :2 * CONV_CH], conv_dw_w[l], conv_dw_b[l], conv_ln_w[l], conv_ln_b[l])
        y_rwkv = rwkv7_mix(p[..., 2 * CONV_CH:], rwkv_mu[l], rwkv_w0[l], rwkv_w2[l], rwkv_a0[l], rwkv_a2[l],
                           rwkv_g2[l], rwkv_k_k[l], rwkv_k_a[l], rwkv_r_k[l], rwkv_gn_w[l], rwkv_gn_b[l])
        mix = jnp.concatenate([y_conv, y_rwkv], axis=-1) @ w_out[l]
        x = x + gt_mix[:, None, :] * mix

        u = modulate(rmsnorm(x, norm_ffn_g[l]), sh_ffn, sc_ffn)
        x = x + gt_ffn[:, None, :] * peer_ffn(u, peer_w_q[l], peer_sub_keys[l], peer_u[l], peer_v[l])
    return rmsnorm(x, final_g)
```

```cpp
#include <hip/hip_runtime.h>
#include <hip/hip_cooperative_groups.h>
#include <cstdio>
#include <cstdint>
namespace cg = cooperative_groups;

typedef unsigned short u16;
typedef unsigned int u32;
using bf16x8 = __attribute__((ext_vector_type(8))) short;
using f32x4 = __attribute__((ext_vector_type(4))) float;
using f32x16 = __attribute__((ext_vector_type(16))) float;
typedef __attribute__((ext_vector_type(2))) __bf16 bf2_t;
typedef float v2f __attribute__((ext_vector_type(2)));

constexpr int D = 1024, NBATCH = 8, SEQ = 4096, T = NBATCH * SEQ;
constexpr int CONV_CH = 512, RW = 512, NPROJ = 2816, RWKV_PROJ = 1792;
constexpr int CONV_W = 31;
constexpr int NHEAD = 8;
constexpr int PEER_H = 8, PEER_K = 16, NKEYS = 128;
constexpr int NTHREADS = 256;
constexpr int SMEM_BYTES = 79872;

constexpr size_t MB = 1ull << 20;
constexpr size_t OFF_WIN = 0;
constexpr size_t OFF_WOUT = OFF_WIN + (size_t)NPROJ * D * 2;
constexpr size_t OFF_WQ = OFF_WOUT + (size_t)D * D * 2;
constexpr size_t OFF_WLORA = OFF_WQ + (size_t)2048 * D * 2;
constexpr size_t OFF_KEYS = OFF_WLORA + (size_t)1536 * 256 * 2;
constexpr size_t OFF_MOD = OFF_KEYS + (size_t)16 * 128 * 128 * 2;
constexpr size_t OFF_BONUS = OFF_MOD + (size_t)8 * 6144 * 4;
constexpr size_t OFF_BAR = OFF_BONUS + (size_t)T * 8 * 4;
constexpr size_t OFF_REGB = 16 * MB;
constexpr size_t OFF_REGC = OFF_REGB + 64 * MB;
constexpr size_t SZ_P = (size_t)T * NPROJ * 2;
constexpr size_t OFF_PC = OFF_REGC;
constexpr size_t OFF_PR = OFF_REGC + 64 * MB;
constexpr size_t OFF_Y = OFF_REGC + 64 * MB;
constexpr size_t OFF_EXPID = OFF_REGC + 160 * MB;
constexpr size_t OFF_GATE = OFF_REGC + 176 * MB;
constexpr size_t OFF_REGD = OFF_REGC + 176 * MB + 16 * MB;
constexpr size_t OFF_REGF = OFF_REGD + 64 * MB;
constexpr size_t WS_NEEDED = OFF_REGF + 160 * MB;
static_assert(OFF_BAR + (3456 + 2 * (2048 + 64)) * 4 <= OFF_REGB, "small region overflow");
static_assert(SZ_P <= 192 * MB, "P overflow");

struct Params {
  const float *x, *c, *ada_w, *ada_b, *norm_mix_g, *w_in, *conv_w, *conv_b, *ln_w, *ln_b;
  const float *mu, *w0, *w2, *a0, *a2, *g2, *k_k, *k_a, *r_k, *gn_w, *gn_b, *w_out, *norm_ffn_g;
  const float *w_q, *sub_keys, *peer_u, *peer_v, *final_g;
  float* out;
  char* ws;
};

__device__ __forceinline__ u16 f2bf(float f) {
  u32 u = __float_as_uint(f);
  u += 0x7FFFu + ((u >> 16) & 1u);
  return (u16)(u >> 16);
}
__device__ __forceinline__ float bf2f(u16 h) { return __uint_as_float(((u32)h) << 16); }
__device__ __forceinline__ u32 pack2(float a, float b) { return (u32)f2bf(a) | ((u32)f2bf(b) << 16); }
__device__ __forceinline__ float bflo(u32 v) { return __uint_as_float(v << 16); }
__device__ __forceinline__ float bfhi(u32 v) { return __uint_as_float(v & 0xFFFF0000u); }
__device__ __forceinline__ float sigmoidf_(float x) { return 1.0f / (1.0f + __expf(-x)); }
__device__ __forceinline__ float siluf_(float x) { return x * sigmoidf_(x); }
__device__ __forceinline__ float wave_sum(float v) {
#pragma unroll
  for (int o = 32; o > 0; o >>= 1) v += __shfl_xor(v, o);
  return v;
}
__device__ __forceinline__ float dpp_ror_add(float x, int) { return x; }
#define DPP_ROR(x, N) __builtin_bit_cast(float, __builtin_amdgcn_update_dpp(0, __builtin_bit_cast(int, (x)), 0x120 + (N), 0xF, 0xF, false))
__device__ __forceinline__ float row16_sum(float x) {
  x += DPP_ROR(x, 8);
  x += DPP_ROR(x, 4);
  x += DPP_ROR(x, 2);
  x += DPP_ROR(x, 1);
  return x;
}

#define XB_TMO      128
#define XB_XCNT(j)  (256  + 64 * (j))
#define XB_XSUB(j)  (1280 + 64 * (j))
#define XB_XGEN(j)  (2304 + 64 * (j))
#define XB_TOP      3328
#define XB_TOPGEN   3392
#define XCD_BAR_WORDS 3456
#define XB_SPIN_CAP (1u << 18)
#define LAS __attribute__((address_space(3)))
__device__ __forceinline__ unsigned xb_ld(unsigned* p)              { return __hip_atomic_load(p, __ATOMIC_RELAXED, __HIP_MEMORY_SCOPE_AGENT); }
__device__ __forceinline__ unsigned xb_add(unsigned* p, unsigned v) { return __hip_atomic_fetch_add(p, v, __ATOMIC_RELAXED, __HIP_MEMORY_SCOPE_AGENT); }
__device__ __forceinline__ unsigned xb_xcc_id() { return (unsigned)__builtin_amdgcn_s_getreg((3 << 11) | 20) & 0xFu; }
#define XB_SPIN(cond, bar) do { unsigned _sp = 0; while (cond) { __builtin_amdgcn_s_sleep(1); \
    if ((++_sp & 255u) == 0u) { if (xb_ld(&(bar)[XB_TMO])) break; if (_sp > XB_SPIN_CAP) { atomicAdd(&(bar)[XB_TMO], 1u); break; } } } } while (0)
struct XcdBarrier { unsigned* bar; unsigned x; volatile LAS unsigned* st; };
__device__ __forceinline__ XcdBarrier xcd_barrier_post(unsigned* bar, volatile LAS unsigned* st) {
    XcdBarrier b; b.bar = bar; b.x = xb_xcc_id(); b.st = st;
    if (threadIdx.x == 0) (void)xb_add(&bar[XB_XCNT(b.x)], 1u);
    return b;
}
__device__ __forceinline__ void xcd_barrier_complete(unsigned* bar, unsigned x, unsigned& nloc, unsigned& nx) {
    const unsigned G = gridDim.x * gridDim.y * gridDim.z;
    unsigned sum, cnt, mine, sp = 0u;
    for (;;) {
        sum = 0u; cnt = 0u; mine = 0u;
#pragma unroll
        for (unsigned j = 0; j < 16; ++j) { const unsigned c = xb_ld(&bar[XB_XCNT(j)]); sum += c; cnt += (c > 0u) ? 1u : 0u; mine = (j == x) ? c : mine; }
        if (sum == G) break;
        __builtin_amdgcn_s_sleep(1);
        if ((++sp & 255u) == 0u) { if (xb_ld(&bar[XB_TMO])) break; if (sp > XB_SPIN_CAP) { atomicAdd(&bar[XB_TMO], 1u); break; } }
    }
    nloc = mine > 0u ? mine : 1u; nx = cnt > 0u ? cnt : 1u;
}
__device__ __forceinline__ void xcd_barrier(const XcdBarrier& b) {
    asm volatile("s_waitcnt vmcnt(0)" ::: "memory");
    __syncthreads();
    if (threadIdx.x == 0) {
        unsigned* bar = b.bar;
        __builtin_amdgcn_s_waitcnt(0);
        unsigned nloc = b.st[0], nx = b.st[1];
        if (nloc == 0u) { xcd_barrier_complete(bar, b.x, nloc, nx); b.st[0] = nloc; b.st[1] = nx; }
        const unsigned old = xb_add(&bar[XB_XSUB(b.x)], 1u);
        const unsigned gen = old / nloc;
        if (old + 1u == (gen + 1u) * nloc) {
            __builtin_amdgcn_fence(__ATOMIC_RELEASE, "agent");
            asm volatile("s_waitcnt vmcnt(0)" ::: "memory");
            const unsigned og = xb_add(&bar[XB_TOP], 1u);
            const unsigned tg = og / nx;
            if (og + 1u == (tg + 1u) * nx) xb_add(&bar[XB_TOPGEN], 1u);
            else XB_SPIN(xb_ld(&bar[XB_TOPGEN]) == tg, bar);
            __builtin_amdgcn_fence(__ATOMIC_ACQUIRE, "agent");
            xb_add(&bar[XB_XGEN(b.x)], 1u);
            asm volatile("s_waitcnt vmcnt(0)" ::: "memory");
        } else {
            XB_SPIN(xb_ld(&bar[XB_XGEN(b.x)]) == gen, bar);
            __builtin_amdgcn_fence(__ATOMIC_ACQUIRE, "agent");
            asm volatile("s_waitcnt vmcnt(0)" ::: "memory");
        }
    }
    __syncthreads();
}

constexpr int G_ROWB = 144;
constexpr int G_TILEB = 128 * G_ROWB;
__device__ __forceinline__ void gemm128(const u16* __restrict__ A, int lda, const u16* __restrict__ B, int ldb, int K,
                                        int m0, int n0, char* smem, f32x16 (&acc)[2][2]) {
  const int tid = threadIdx.x, lane = tid & 63, wid = tid >> 6, wm = wid >> 1, wn = wid & 1;
  const int fr = lane & 15, fq = lane >> 4;
  const int ldrow = tid >> 3, ldc = tid & 7;
#pragma unroll
  for (int i = 0; i < 2; ++i)
#pragma unroll
    for (int j = 0; j < 2; ++j)
#pragma unroll
      for (int r = 0; r < 16; ++r) acc[i][j][r] = 0.f;
  const int fr32 = lane & 31, fh = lane >> 5;
  uint4 ra[4], rb[4];
  const u16* ga = A + (size_t)(m0 + ldrow) * lda + ldc * 8;
  const u16* gb = B + (size_t)(n0 + ldrow) * ldb + ldc * 8;
  const int nk = K >> 6;
#pragma unroll
  for (int i = 0; i < 4; ++i) {
    ra[i] = *(const uint4*)(ga + (size_t)(32 * i) * lda);
    rb[i] = *(const uint4*)(gb + (size_t)(32 * i) * ldb);
  }
  {
    char* sa = smem + ldrow * G_ROWB + ldc * 16;
#pragma unroll
    for (int i = 0; i < 4; ++i) {
      *(uint4*)(sa + 32 * i * G_ROWB) = ra[i];
      *(uint4*)(sa + G_TILEB + 32 * i * G_ROWB) = rb[i];
    }
  }
  __syncthreads();
  for (int kt = 0; kt < nk; ++kt) {
    const bool more = (kt + 1 < nk);
    if (more) {
      const int k0 = (kt + 1) << 6;
#pragma unroll
      for (int i = 0; i < 4; ++i) {
        ra[i] = *(const uint4*)(ga + (size_t)(32 * i) * lda + k0);
        rb[i] = *(const uint4*)(gb + (size_t)(32 * i) * ldb + k0);
      }
    }
    const char* cur = smem + (kt & 1) * 2 * G_TILEB;
    const char* sa = cur + (wm * 64 + fr32) * G_ROWB + fh * 16;
    const char* sb = cur + G_TILEB + (wn * 64 + fr32) * G_ROWB + fh * 16;
#pragma unroll
    for (int ks = 0; ks < 4; ++ks) {
      bf16x8 af[2], bfr[2];
#pragma unroll
      for (int i = 0; i < 2; ++i) {
        af[i] = *(const bf16x8*)(sa + i * 32 * G_ROWB + ks * 32);
        bfr[i] = *(const bf16x8*)(sb + i * 32 * G_ROWB + ks * 32);
      }
#pragma unroll
      for (int mi = 0; mi < 2; ++mi)
#pragma unroll
        for (int ni = 0; ni < 2; ++ni)
          acc[mi][ni] = __builtin_amdgcn_mfma_f32_32x32x16_bf16(bfr[ni], af[mi], acc[mi][ni], 0, 0, 0);
    }
    if (more) {
      char* nxt = smem + ((kt + 1) & 1) * 2 * G_TILEB + ldrow * G_ROWB + ldc * 16;
#pragma unroll
      for (int i = 0; i < 4; ++i) {
        *(uint4*)(nxt + 32 * i * G_ROWB) = ra[i];
        *(uint4*)(nxt + G_TILEB + 32 * i * G_ROWB) = rb[i];
      }
    }
    __syncthreads();
  }
}

__device__ __forceinline__ void gemm128d(const u16* __restrict__ A, int lda, const u16* __restrict__ B, int ldb, int K,
                                        int m0, int n0, char* smem, f32x16 (&acc)[2][2]) {
  const int tid = threadIdx.x, lane = tid & 63, wid = tid >> 6, wm = wid >> 1, wn = wid & 1;
  const int fr = lane & 15, fq = lane >> 4;
  const int ldrow = tid >> 3, ldc = tid & 7;
#pragma unroll
  for (int i = 0; i < 2; ++i)
#pragma unroll
    for (int j = 0; j < 2; ++j)
#pragma unroll
      for (int r = 0; r < 16; ++r) acc[i][j][r] = 0.f;
  const int fr32 = lane & 31, fh = lane >> 5;
  uint4 ra0_0, ra0_1, ra0_2, ra0_3, rb0_0, rb0_1, rb0_2, rb0_3;
  uint4 ra1_0, ra1_1, ra1_2, ra1_3, rb1_0, rb1_1, rb1_2, rb1_3;
  const u16* ga = A + (size_t)(m0 + ldrow) * lda + ldc * 8;
  const u16* gb = B + (size_t)(n0 + ldrow) * ldb + ldc * 8;
  const int nk = K >> 6;
  char* const sw = smem + ldrow * G_ROWB + ldc * 16;
#define G_LOAD1(RA, RB, I, k0)                                          \
  RA##_##I = *(const uint4*)(ga + (size_t)(32 * I) * lda + k0);         \
  RB##_##I = *(const uint4*)(gb + (size_t)(32 * I) * ldb + k0);
#define G_LOAD(RA, RB, KT)                                              \
  {                                                                     \
    const int k0 = (KT) << 6;                                           \
    G_LOAD1(RA, RB, 0, k0) G_LOAD1(RA, RB, 1, k0) G_LOAD1(RA, RB, 2, k0) G_LOAD1(RA, RB, 3, k0) \
  }
#define G_STORE1(RA, RB, I)                                             \
  *(uint4*)(d + 32 * I * G_ROWB) = RA##_##I;                            \
  *(uint4*)(d + G_TILEB + 32 * I * G_ROWB) = RB##_##I;
#define G_STORE(RA, RB, BUF)                                            \
  {                                                                     \
    char* d = sw + (BUF) * 2 * G_TILEB;                                 \
    G_STORE1(RA, RB, 0) G_STORE1(RA, RB, 1) G_STORE1(RA, RB, 2) G_STORE1(RA, RB, 3) \
  }
#define G_COMPUTE(BUF)                                                                          \
  {                                                                                             \
    const char* cur = smem + (BUF) * 2 * G_TILEB;                                               \
    const char* sa = cur + (wm * 64 + fr32) * G_ROWB + fh * 16;                                 \
    const char* sb = cur + G_TILEB + (wn * 64 + fr32) * G_ROWB + fh * 16;                       \
    _Pragma("unroll") for (int ks = 0; ks < 4; ++ks) {                                          \
      bf16x8 af[2], bfr[2];                                                                     \
      _Pragma("unroll") for (int i = 0; i < 2; ++i) {                                           \
        af[i] = *(const bf16x8*)(sa + i * 32 * G_ROWB + ks * 32);                               \
        bfr[i] = *(const bf16x8*)(sb + i * 32 * G_ROWB + ks * 32);                              \
      }                                                                                         \
      _Pragma("unroll") for (int mi = 0; mi < 2; ++mi)                                          \
      _Pragma("unroll") for (int ni = 0; ni < 2; ++ni)                                          \
        acc[mi][ni] = __builtin_amdgcn_mfma_f32_32x32x16_bf16(bfr[ni], af[mi], acc[mi][ni], 0, 0, 0); \
    }                                                                                           \
  }
  G_LOAD(ra0, rb0, 0)
  G_STORE(ra0, rb0, 0)
  G_LOAD(ra0, rb0, 1)
  if (nk > 2) G_LOAD(ra1, rb1, 2)
  __syncthreads();
  for (int kt = 0; kt < nk; kt += 2) {
    G_COMPUTE(0)
    G_STORE(ra0, rb0, 1)
    if (kt + 3 < nk) G_LOAD(ra0, rb0, kt + 3)
    __syncthreads();
    G_COMPUTE(1)
    if (kt + 2 < nk) {
      G_STORE(ra1, rb1, 0)
      if (kt + 4 < nk) G_LOAD(ra1, rb1, kt + 4)
    }
    __syncthreads();
  }
#undef G_LOAD
#undef G_LOAD1
#undef G_STORE
#undef G_STORE1
#undef G_COMPUTE
}

#define ACC_FOREACH(BODY)                                                            \
  {                                                                                  \
    const int _lane = threadIdx.x & 63, _wid = threadIdx.x >> 6;                     \
    const int _wm = _wid >> 1, _wn = _wid & 1, _fr = _lane & 15, _fq = _lane >> 4;   \
    _Pragma("unroll") for (int mi = 0; mi < 4; ++mi)                                 \
    _Pragma("unroll") for (int ni = 0; ni < 4; ++ni)                                 \
    _Pragma("unroll") for (int j = 0; j < 4; ++j) {                                  \
      const int lrow = _wm * 64 + mi * 16 + _fq * 4 + j;                             \
      const int lcol = _wn * 64 + ni * 16 + _fr;                                     \
      const float v = acc[mi][ni][j];                                                \
      BODY                                                                           \
    }                                                                                \
  }

template <class F>
__device__ __forceinline__ void epi_staged(f32x16 (&acc)[2][2], char* smem, F f) {
  float* st = (float*)smem;
  {
    const int lane = threadIdx.x & 63, wid = threadIdx.x >> 6, wm = wid >> 1, wn = wid & 1, fr32 = lane & 31, fh = lane >> 5;
#pragma unroll
    for (int mi = 0; mi < 2; ++mi)
#pragma unroll
      for (int ni = 0; ni < 2; ++ni)
#pragma unroll
        for (int g = 0; g < 4; ++g)
          *(f32x4*)(st + (wm * 64 + mi * 32 + fr32) * 132 + wn * 64 + ni * 32 + g * 8 + fh * 4) =
              f32x4{acc[mi][ni][g * 4 + 0], acc[mi][ni][g * 4 + 1], acc[mi][ni][g * 4 + 2], acc[mi][ni][g * 4 + 3]};
  }
  __syncthreads();
#pragma unroll 4
  for (int i = threadIdx.x; i < 128 * 32; i += NTHREADS) {
    const int row = i >> 5, c4 = (i & 31) << 2;
    const float4 v = *(const float4*)(st + row * 132 + c4);
    f(row, c4, v);
  }
  __syncthreads();
}

constexpr int H_ROWB = 80;
constexpr int H_A = 256 * H_ROWB, H_B = 128 * H_ROWB, H_STAGE = H_A + H_B;
__device__ __forceinline__ void gemm256(const u16* __restrict__ A, int lda, const u16* __restrict__ B, int ldb, int K,
                                        int m0, int n0, char* smem, f32x16 (&acc)[4][2]) {
  const int tid = threadIdx.x, lane = tid & 63, wid = tid >> 6, wm = wid >> 1, wn = wid & 1;
  const int fr32 = lane & 31, fh = lane >> 5;
#pragma unroll
  for (int i = 0; i < 4; ++i)
#pragma unroll
    for (int j = 0; j < 2; ++j)
#pragma unroll
      for (int r = 0; r < 16; ++r) acc[i][j][r] = 0.f;
  const int ldrow = tid >> 2, ldc = tid & 3;
  const u16* ga = A + (size_t)(m0 + ldrow) * lda + ldc * 8;
  const u16* gb = B + (size_t)(n0 + ldrow) * ldb + ldc * 8;
  uint4 a0, a1, a2, a3, b0, b1;
  uint4 c0, c1, c2, c3, d0, d1;
  const int nk = K >> 5;
  char* const swa = smem + ldrow * H_ROWB + ldc * 16;
  char* const swb = smem + H_A + ldrow * H_ROWB + ldc * 16;
#define H_LOAD(k0, A0, A1, A2, A3, B0, B1)                      \
  A0 = *(const uint4*)(ga + (k0));                              \
  A1 = *(const uint4*)(ga + (size_t)64 * lda + (k0));           \
  A2 = *(const uint4*)(ga + (size_t)128 * lda + (k0));          \
  A3 = *(const uint4*)(ga + (size_t)192 * lda + (k0));          \
  B0 = *(const uint4*)(gb + (k0));                              \
  B1 = *(const uint4*)(gb + (size_t)64 * ldb + (k0));
#define H_STORE(BUF, A0, A1, A2, A3, B0, B1)                    \
  *(uint4*)(swa + (BUF) * H_STAGE) = A0;                        \
  *(uint4*)(swa + (BUF) * H_STAGE + 64 * H_ROWB) = A1;          \
  *(uint4*)(swa + (BUF) * H_STAGE + 128 * H_ROWB) = A2;         \
  *(uint4*)(swa + (BUF) * H_STAGE + 192 * H_ROWB) = A3;         \
  *(uint4*)(swb + (BUF) * H_STAGE) = B0;                        \
  *(uint4*)(swb + (BUF) * H_STAGE + 64 * H_ROWB) = B1;
#define H_COMPUTE(BUF)                                                                          \
  {                                                                                             \
    const char* cur = smem + (BUF) * H_STAGE;                                                   \
    const char* sa = cur + (wm * 128 + fr32) * H_ROWB + fh * 16;                                \
    const char* sb = cur + H_A + (wn * 64 + fr32) * H_ROWB + fh * 16;                           \
    _Pragma("unroll") for (int ks = 0; ks < 2; ++ks) {                                          \
      bf16x8 af[4], bfr[2];                                                                     \
      _Pragma("unroll") for (int i = 0; i < 4; ++i) af[i] = *(const bf16x8*)(sa + i * 32 * H_ROWB + ks * 32); \
      _Pragma("unroll") for (int i = 0; i < 2; ++i) bfr[i] = *(const bf16x8*)(sb + i * 32 * H_ROWB + ks * 32); \
      _Pragma("unroll") for (int mi = 0; mi < 4; ++mi)                                          \
      _Pragma("unroll") for (int ni = 0; ni < 2; ++ni)                                          \
        acc[mi][ni] = __builtin_amdgcn_mfma_f32_32x32x16_bf16(bfr[ni], af[mi], acc[mi][ni], 0, 0, 0); \
    }                                                                                           \
  }
  H_LOAD(0, a0, a1, a2, a3, b0, b1)
  H_STORE(0, a0, a1, a2, a3, b0, b1)
  H_LOAD(32, a0, a1, a2, a3, b0, b1)
  if (nk > 2) { H_LOAD(64, c0, c1, c2, c3, d0, d1) }
  __syncthreads();
  for (int kt = 0; kt < nk; kt += 2) {
    H_COMPUTE(0)
    H_STORE(1, a0, a1, a2, a3, b0, b1)
    if (kt + 3 < nk) { const int k0 = (kt + 3) << 5; H_LOAD(k0, a0, a1, a2, a3, b0, b1) }
    __syncthreads();
    H_COMPUTE(1)
    if (kt + 2 < nk) {
      H_STORE(0, c0, c1, c2, c3, d0, d1)
      if (kt + 4 < nk) { const int k0 = (kt + 4) << 5; H_LOAD(k0, c0, c1, c2, c3, d0, d1) }
    }
    __syncthreads();
  }
#undef H_COMPUTE
#undef H_LOAD
#undef H_STORE
}
template <class F>
__device__ __forceinline__ void epi_staged256(f32x16 (&acc)[4][2], char* smem, F f) {
  float* st = (float*)smem;
  const int lane = threadIdx.x & 63, wid = threadIdx.x >> 6, wm = wid >> 1, wn = wid & 1, fr32 = lane & 31, fh = lane >> 5;
#pragma unroll
  for (int half = 0; half < 2; ++half) {
    if (wm == half) {
#pragma unroll
      for (int mi = 0; mi < 4; ++mi)
#pragma unroll
        for (int ni = 0; ni < 2; ++ni)
#pragma unroll
          for (int g = 0; g < 4; ++g)
            *(f32x4*)(st + (mi * 32 + fr32) * 132 + wn * 64 + ni * 32 + g * 8 + fh * 4) =
                f32x4{acc[mi][ni][g * 4 + 0], acc[mi][ni][g * 4 + 1], acc[mi][ni][g * 4 + 2], acc[mi][ni][g * 4 + 3]};
    }
    __syncthreads();
#pragma unroll 4
    for (int i = threadIdx.x; i < 128 * 32; i += NTHREADS) {
      const int row = i >> 5, c4 = (i & 31) << 2;
      const float4 v = *(const float4*)(st + row * 132 + c4);
      f(half * 128 + row, c4, v);
    }
    __syncthreads();
  }
}

__device__ __forceinline__ void transpose_tile(const float* __restrict__ W, int N, u16* __restrict__ Wt, int K, int k0, int n0, float* lds) {
  const int tid = threadIdx.x;
  __syncthreads();
#pragma unroll
  for (int i = 0; i < 16; ++i) {
    int k = i * 4 + (tid >> 6), n = tid & 63;
    lds[k * 65 + n] = W[(size_t)(k0 + k) * N + n0 + n];
  }
  __syncthreads();
#pragma unroll
  for (int i = 0; i < 16; ++i) {
    int n = i * 4 + (tid >> 6), k = tid & 63;
    Wt[(size_t)(n0 + n) * K + k0 + k] = f2bf(lds[k * 65 + n]);
  }
}

__device__ __forceinline__ void phase_prep(const Params& p, char* smem) {
  const int tid = threadIdx.x;
  float* lds = (float*)smem;
  u16* WIN = (u16*)(p.ws + OFF_WIN);
  u16* WOUT = (u16*)(p.ws + OFF_WOUT);
  u16* WQ = (u16*)(p.ws + OFF_WQ);
  u16* WLORA = (u16*)(p.ws + OFF_WLORA);
  u16* KEYS = (u16*)(p.ws + OFF_KEYS);
  float* MOD = (float*)(p.ws + OFF_MOD);
  constexpr int N_MOD = 96, N_T1 = 44 * 16, N_T2 = 16 * 16, N_T3 = 32 * 16;
  constexpr int N_TASK = N_MOD + N_T1 + N_T2 + N_T3;
  for (int task = blockIdx.x; task < N_TASK; task += gridDim.x) {
    if (task < N_MOD) {
      __syncthreads();
      for (int i = tid; i < 8 * 1024; i += NTHREADS) lds[i] = siluf_(p.c[i]);
      __syncthreads();
      const int lane = tid & 63, w = tid >> 6;
      const int col = task * 64 + lane;
      float a[8];
#pragma unroll
      for (int b = 0; b < 8; ++b) a[b] = 0.f;
      const float* wp = p.ada_w + (size_t)(w * 256) * 6144 + col;
#pragma unroll 8
      for (int k = 0; k < 256; ++k) {
        float wv = wp[(size_t)k * 6144];
#pragma unroll
        for (int b = 0; b < 8; ++b) a[b] += lds[b * 1024 + w * 256 + k] * wv;
      }
      __syncthreads();
#pragma unroll
      for (int b = 0; b < 8; ++b) lds[8192 + (w * 8 + b) * 64 + lane] = a[b];
      __syncthreads();
      for (int i = tid; i < 512; i += NTHREADS) {
        int b = i >> 6, l = i & 63;
        float s = lds[8192 + (0 * 8 + b) * 64 + l] + lds[8192 + (1 * 8 + b) * 64 + l] + lds[8192 + (2 * 8 + b) * 64 + l] +
                  lds[8192 + (3 * 8 + b) * 64 + l];
        MOD[b * 6144 + task * 64 + l] = s + p.ada_b[task * 64 + l];
      }
    } else {
      int t = task - N_MOD;
      if (t < N_T1) {
        transpose_tile(p.w_in, NPROJ, WIN, D, (t & 15) * 64, (t >> 4) * 64, lds);
      } else if (t < N_T1 + N_T2) {
        t -= N_T1;
        transpose_tile(p.w_out, D, WOUT, D, (t & 15) * 64, (t >> 4) * 64, lds);
      } else {
        t -= N_T1 + N_T2;
        transpose_tile(p.w_q, 2048, WQ, D, (t & 15) * 64, (t >> 4) * 64, lds);
      }
    }
  }
  const size_t gtid = (size_t)blockIdx.x * NTHREADS + tid, gn = (size_t)gridDim.x * NTHREADS;
  for (size_t i = gtid; i < (size_t)1536 * 256; i += gn) {
    int n = (int)(i >> 8), k = (int)(i & 255);
    float v = 0.f;
    if (n < 512) { if (k < 64) v = p.w2[k * 512 + n]; }
    else if (n < 1024) { if (k >= 64 && k < 128) v = p.a2[(k - 64) * 512 + (n - 512)]; }
    else { if (k >= 128) v = p.g2[(k - 128) * 512 + (n - 1024)]; }
    WLORA[i] = f2bf(v);
  }
  for (size_t i = gtid; i < (size_t)16 * 128 * 128; i += gn) KEYS[i] = f2bf(p.sub_keys[i]);
}

__device__ __forceinline__ void phase_normmod(const float* __restrict__ X, const float* __restrict__ g, const float* __restrict__ MOD,
                              int sh_off, int sc_off, u16* __restrict__ U) {
  const int lane = threadIdx.x & 63;
  const int gw = blockIdx.x * 4 + (threadIdx.x >> 6), nw = gridDim.x * 4;
  for (int t = gw; t < T; t += nw) {
    const int b = t / SEQ;
    const float4* xr = (const float4*)(X + (size_t)t * D);
    float4 v[4];
    float ss = 0.f;
#pragma unroll
    for (int i = 0; i < 4; ++i) {
      v[i] = xr[i * 64 + lane];
      ss += v[i].x * v[i].x + v[i].y * v[i].y + v[i].z * v[i].z + v[i].w * v[i].w;
    }
    ss = wave_sum(ss);
    const float rstd = rsqrtf(ss * (1.0f / D) + 1e-6f);
    const float4* gp = (const float4*)g;
    const float4* shp = (const float4*)(MOD + b * 6144 + sh_off);
    const float4* scp = (const float4*)(MOD + b * 6144 + sc_off);
    uint2* up = (uint2*)(U + (size_t)t * D);
#pragma unroll
    for (int i = 0; i < 4; ++i) {
      float4 gg = gp[i * 64 + lane], sh = shp[i * 64 + lane], sc = scp[i * 64 + lane];
      float o0 = v[i].x * rstd * gg.x * (1.f + sc.x) + sh.x;
      float o1 = v[i].y * rstd * gg.y * (1.f + sc.y) + sh.y;
      float o2 = v[i].z * rstd * gg.z * (1.f + sc.z) + sh.z;
      float o3 = v[i].w * rstd * gg.w * (1.f + sc.w) + sh.w;
      up[i * 64 + lane] = make_uint2(pack2(o0, o1), pack2(o2, o3));
    }
  }
}

__device__ __forceinline__ void phase_gemm_in(const Params& p, char* smem) {
  const u16* U1 = (const u16*)(p.ws + OFF_REGB);
  const u16* WIN = (const u16*)(p.ws + OFF_WIN);
  u16* P = (u16*)(p.ws + OFF_REGC);
  constexpr int NT = NPROJ / 128, MT = T / 256;
  for (int tile = blockIdx.x; tile < NT * MT; tile += gridDim.x) {
    const int mt = tile / NT, nt = tile % NT;
    f32x16 acc[4][2];
    gemm256(U1, D, WIN, D, D, mt * 256, nt * 128, smem, acc);
    epi_staged256(acc, smem, [&](int row, int c4, float4 v) {
      u16* dst = (nt < 8) ? (P + (size_t)(mt * 256 + row) * 1024 + nt * 128 + c4)
                          : (P + (size_t)32 * MB + (size_t)(mt * 256 + row) * 1792 + (nt - 8) * 128 + c4);
      *(uint2*)dst = make_uint2(pack2(v.x, v.y), pack2(v.z, v.w));
    });
  }
}

__device__ __forceinline__ void phase_act(const Params& p) {
  const u16* P = (const u16*)(p.ws + OFF_PR);
  u16* ACT = (u16*)(p.ws + OFF_REGF + 128 * MB);
  const size_t gtid = (size_t)blockIdx.x * NTHREADS + threadIdx.x, gn = (size_t)gridDim.x * NTHREADS;
  for (size_t i = gtid; i < (size_t)T * 64; i += gn) {
    const int t = (int)(i >> 6), c = (int)(i & 63) * 4;
    const u16* pr = P + (size_t)t * 1792 + 1536 + c;
    uint2 cur = *(const uint2*)pr;
    uint2 prv = make_uint2(0u, 0u);
    if ((t % SEQ) != 0) prv = *(const uint2*)(pr - 1792);
    float4 m = *(const float4*)(p.mu + 1536 + c);
    float x0 = bflo(cur.x), x1 = bfhi(cur.x), x2 = bflo(cur.y), x3 = bfhi(cur.y);
    x0 += m.x * (bflo(prv.x) - x0);
    x1 += m.y * (bfhi(prv.x) - x1);
    x2 += m.z * (bflo(prv.y) - x2);
    x3 += m.w * (bfhi(prv.y) - x3);
    if (c < 64) { x0 = tanhf(x0); x1 = tanhf(x1); x2 = tanhf(x2); x3 = tanhf(x3); }
    else if (c >= 128) { x0 = sigmoidf_(x0); x1 = sigmoidf_(x1); x2 = sigmoidf_(x2); x3 = sigmoidf_(x3); }
    *(uint2*)(ACT + (size_t)t * 256 + c) = make_uint2(pack2(x0, x1), pack2(x2, x3));
  }
}

__device__ __forceinline__ void conv_tile(const Params& p, int tile, char* smem) {
  const u16* P = (const u16*)(p.ws + OFF_PC);
  u16* MIXIN = (u16*)(p.ws + OFF_REGB);
  const int tid = threadIdx.x, lane = tid & 63, wid = tid >> 6;
  u32* ylds = (u32*)smem;
  float* olds = (float*)(smem + 62 * 1024);
  const int tok0 = tile * 32;
  const int s0 = tok0 % SEQ;
  __syncthreads();
  for (int r = 0; r < 62; ++r) {
    const int s = s0 - 30 + r;
    u32 val = 0u;
    if (s >= 0) {
      const u16* pr = P + (size_t)(tok0 - 30 + r) * 1024;
      u32 a = *(const u32*)(pr + 2 * tid);
      u32 bq = *(const u32*)(pr + 512 + 2 * tid);
      val = pack2(bflo(a) * sigmoidf_(bflo(bq)), bfhi(a) * sigmoidf_(bfhi(bq)));
    }
    ylds[r * 256 + tid] = val;
  }
  __syncthreads();
  float w0[31], w1[31];
#pragma unroll
  for (int j = 0; j < 31; ++j) {
    const float2 wv = *(const float2*)(p.conv_w + j * 512 + 2 * tid);
    w0[j] = wv.x; w1[j] = wv.y;
  }
  const float2 bias = *(const float2*)(p.conv_b + 2 * tid);
  for (int sub = 0; sub < 4; ++sub) {
    float a0[8], a1[8];
#pragma unroll
    for (int q = 0; q < 8; ++q) { a0[q] = bias.x; a1[q] = bias.y; }
#pragma unroll
    for (int rr = 0; rr < 38; ++rr) {
      const u32 yv = ylds[(sub * 8 + rr) * 256 + tid];
      const float y0 = bflo(yv), y1 = bfhi(yv);
#pragma unroll
      for (int q = 0; q < 8; ++q) {
        const int j = rr - q;
        if (j >= 0 && j < 31) { a0[q] += w0[j] * y0; a1[q] += w1[j] * y1; }
      }
    }
#pragma unroll
    for (int q = 0; q < 8; ++q) *(float2*)(olds + q * 512 + 2 * tid) = make_float2(a0[q], a1[q]);
    __syncthreads();
#pragma unroll
    for (int q2 = 0; q2 < 2; ++q2) {
      const int q = wid * 2 + q2;
      const float4 va = *(const float4*)(olds + q * 512 + lane * 8);
      const float4 vb = *(const float4*)(olds + q * 512 + lane * 8 + 4);
      float s = va.x + va.y + va.z + va.w + vb.x + vb.y + vb.z + vb.w;
      s = wave_sum(s);
      const float mean = s * (1.0f / 512.f);
      float d[8] = {va.x - mean, va.y - mean, va.z - mean, va.w - mean, vb.x - mean, vb.y - mean, vb.z - mean, vb.w - mean};
      float vs = 0.f;
#pragma unroll
      for (int e = 0; e < 8; ++e) vs += d[e] * d[e];
      vs = wave_sum(vs);
      const float rstd = rsqrtf(vs * (1.0f / 512.f) + 1e-5f);
      const float4 lw0 = *(const float4*)(p.ln_w + lane * 8), lw1 = *(const float4*)(p.ln_w + lane * 8 + 4);
      const float4 lb0 = *(const float4*)(p.ln_b + lane * 8), lb1 = *(const float4*)(p.ln_b + lane * 8 + 4);
      const float lw[8] = {lw0.x, lw0.y, lw0.z, lw0.w, lw1.x, lw1.y, lw1.z, lw1.w};
      const float lb[8] = {lb0.x, lb0.y, lb0.z, lb0.w, lb1.x, lb1.y, lb1.z, lb1.w};
      float o[8];
#pragma unroll
      for (int e = 0; e < 8; ++e) o[e] = siluf_(d[e] * rstd * lw[e] + lb[e]);
      uint4 pk = make_uint4(pack2(o[0], o[1]), pack2(o[2], o[3]), pack2(o[4], o[5]), pack2(o[6], o[7]));
      *(uint4*)(MIXIN + (size_t)(tok0 + sub * 8 + q) * D + lane * 8) = pk;
    }
    __syncthreads();
  }
}

__device__ __forceinline__ void phase_lora_conv(const Params& p, char* smem) {
  const u16* ACT = (const u16*)(p.ws + OFF_REGF + 128 * MB);
  const u16* WLORA = (const u16*)(p.ws + OFF_WLORA);
  u16* LW = (u16*)(p.ws + OFF_REGF);
  u16* AA = (u16*)(p.ws + OFF_REGD);
  u16* GG = (u16*)(p.ws + OFF_REGD + 32 * MB);
  constexpr int NT = 12, MT = T / 128, NG = NT * MT, NC = T / 32;
  for (int task = blockIdx.x; task < NG; task += gridDim.x) {
    {
      const int mt = task / NT, nt = task % NT;
      f32x16 acc[2][2];
      gemm128d(ACT, 256, WLORA, 256, 256, mt * 128, nt * 128, smem, acc);
      if (nt < 4) {
        epi_staged(acc, smem, [&](int row, int c4, float4 v) {
          const int n = nt * 128 + c4;
          const float4 w0 = *(const float4*)(p.w0 + n);
          const float vv[4] = {v.x + w0.x, v.y + w0.y, v.z + w0.z, v.w + w0.w};
          float o[4];
#pragma unroll
          for (int e = 0; e < 4; ++e) {
            const float z = -vv[e];
            const float sp = fmaxf(z, 0.f) + log1pf(__expf(-fabsf(z)));
            o[e] = -__expf(-sp - 0.5f);
          }
          *(uint2*)(LW + (size_t)(mt * 128 + row) * 512 + n) = make_uint2(pack2(o[0], o[1]), pack2(o[2], o[3]));
        });
      } else if (nt < 8) {
        epi_staged(acc, smem, [&](int row, int c4, float4 v) {
          const int n = (nt - 4) * 128 + c4;
          const float4 a0 = *(const float4*)(p.a0 + n);
          *(uint2*)(AA + (size_t)(mt * 128 + row) * 512 + n) =
              make_uint2(pack2(sigmoidf_(a0.x + v.x), sigmoidf_(a0.y + v.y)), pack2(sigmoidf_(a0.z + v.z), sigmoidf_(a0.w + v.w)));
        });
      } else {
        epi_staged(acc, smem, [&](int row, int c4, float4 v) {
          const int n = (nt - 8) * 128 + c4;
          *(uint2*)(GG + (size_t)(mt * 128 + row) * 512 + n) = make_uint2(pack2(v.x, v.y), pack2(v.z, v.w));
        });
      }
    }
  }
}

__device__ __forceinline__ void phase_scanprep(const Params& p) {
  const u16* P = (const u16*)(p.ws + OFF_PR);
  const u16* AA = (const u16*)(p.ws + OFF_REGD);
  u16* R = (u16*)(p.ws + OFF_REGF + 32 * MB);
  u16* KM = (u16*)(p.ws + OFF_REGF + 64 * MB);
  u16* V = (u16*)(p.ws + OFF_REGF + 96 * MB);
  u16* KKN = (u16*)(p.ws + OFF_REGF + 128 * MB);
  float* BONUS = (float*)(p.ws + OFF_BONUS);
  const int tid = threadIdx.x;
  const int c = (tid & 127) * 4;
  const float4 mur = *(const float4*)(p.mu + c), muk = *(const float4*)(p.mu + 512 + c), muv = *(const float4*)(p.mu + 1024 + c);
  const float4 kk_ = *(const float4*)(p.k_k + c), ka_ = *(const float4*)(p.k_a + c), rk_ = *(const float4*)(p.r_k + c);
  for (int tp = blockIdx.x; tp < T / 2; tp += gridDim.x) {
    const int t = tp * 2 + (tid >> 7);
    const bool first = (t % SEQ) == 0;
    const u16* pr = P + (size_t)t * 1792 + c;
    float r[4], k[4], v[4];
    {
      uint2 cu = *(const uint2*)pr, pv = first ? make_uint2(0u, 0u) : *(const uint2*)(pr - 1792);
      r[0] = bflo(cu.x); r[1] = bfhi(cu.x); r[2] = bflo(cu.y); r[3] = bfhi(cu.y);
      r[0] += mur.x * (bflo(pv.x) - r[0]); r[1] += mur.y * (bfhi(pv.x) - r[1]);
      r[2] += mur.z * (bflo(pv.y) - r[2]); r[3] += mur.w * (bfhi(pv.y) - r[3]);
    }
    {
      uint2 cu = *(const uint2*)(pr + 512), pv = first ? make_uint2(0u, 0u) : *(const uint2*)(pr + 512 - 1792);
      k[0] = bflo(cu.x); k[1] = bfhi(cu.x); k[2] = bflo(cu.y); k[3] = bfhi(cu.y);
      k[0] += muk.x * (bflo(pv.x) - k[0]); k[1] += muk.y * (bfhi(pv.x) - k[1]);
      k[2] += muk.z * (bflo(pv.y) - k[2]); k[3] += muk.w * (bfhi(pv.y) - k[3]);
    }
    {
      uint2 cu = *(const uint2*)(pr + 1024), pv = first ? make_uint2(0u, 0u) : *(const uint2*)(pr + 1024 - 1792);
      v[0] = bflo(cu.x); v[1] = bfhi(cu.x); v[2] = bflo(cu.y); v[3] = bfhi(cu.y);
      v[0] += muv.x * (bflo(pv.x) - v[0]); v[1] += muv.y * (bfhi(pv.x) - v[1]);
      v[2] += muv.z * (bflo(pv.y) - v[2]); v[3] += muv.w * (bfhi(pv.y) - v[3]);
    }
    const uint2 au = *(const uint2*)(AA + (size_t)t * 512 + c);
    const float a[4] = {bflo(au.x), bfhi(au.x), bflo(au.y), bfhi(au.y)};
    const float kkc[4] = {kk_.x, kk_.y, kk_.z, kk_.w}, kac[4] = {ka_.x, ka_.y, ka_.z, ka_.w}, rkc[4] = {rk_.x, rk_.y, rk_.z, rk_.w};
    float kk[4], km[4];
    float n2 = 0.f, bs = 0.f;
#pragma unroll
    for (int e = 0; e < 4; ++e) {
      kk[e] = k[e] * kkc[e];
      km[e] = k[e] * (1.f + (a[e] - 1.f) * kac[e]);
      n2 += kk[e] * kk[e];
      bs += r[e] * km[e] * rkc[e];
    }
    n2 = row16_sum(n2);
    bs = row16_sum(bs);
    const float inv = 1.0f / fmaxf(sqrtf(n2), 1e-12f);
    const size_t o = (size_t)t * 512 + c;
    *(uint2*)(R + o) = make_uint2(pack2(r[0], r[1]), pack2(r[2], r[3]));
    *(uint2*)(KM + o) = make_uint2(pack2(km[0], km[1]), pack2(km[2], km[3]));
    *(uint2*)(V + o) = make_uint2(pack2(v[0], v[1]), pack2(v[2], v[3]));
    *(uint2*)(KKN + o) = make_uint2(pack2(kk[0] * inv, kk[1] * inv), pack2(kk[2] * inv, kk[3] * inv));
    if ((tid & 15) == 0) BONUS[(size_t)t * 8 + (c >> 6)] = bs;
  }
}

constexpr size_t OFF_EU8 = OFF_REGC + 128 * MB;
constexpr size_t OFF_EV8 = OFF_REGC + 144 * MB;
constexpr int CVT_CHUNKS = 256;
__device__ __forceinline__ void cvt_chunk(const Params& p, int chunk) {
  u32* EU = (u32*)(p.ws + OFF_EU8);
  u32* EV = (u32*)(p.ws + OFF_EV8);
  const float4* su = (const float4*)p.peer_u;
  const float4* sv = (const float4*)p.peer_v;
  const size_t base = (size_t)chunk * 16384;
#pragma unroll 4
  for (int q = 0; q < 64; ++q) {
    const size_t i = base + q * 256 + threadIdx.x;
    const float4 a = su[i], b = sv[i];
    int va = 0, vb = 0;
    va = __builtin_amdgcn_cvt_pk_fp8_f32(a.x * 512.f, a.y * 512.f, va, false);
    va = __builtin_amdgcn_cvt_pk_fp8_f32(a.z * 512.f, a.w * 512.f, va, true);
    vb = __builtin_amdgcn_cvt_pk_fp8_f32(b.x * 128.f, b.y * 128.f, vb, false);
    vb = __builtin_amdgcn_cvt_pk_fp8_f32(b.z * 128.f, b.w * 128.f, vb, true);
    EU[i] = (u32)va;
    EV[i] = (u32)vb;
  }
}

__device__ __forceinline__ void mix_unit(const Params& p, int u, char* smem) {
  for (int ci = 0; ci < 4; ++ci) conv_tile(p, u * 4 + ci, smem);
}

template <int OFF>
__device__ __forceinline__ f32x4 lds_ld4(unsigned addr) {
  f32x4 r;
  asm volatile("ds_read_b128 %0, %1 offset:%2" : "=v"(r) : "v"(addr), "n"(OFF));
  return r;
}
template <int OFF>
__device__ __forceinline__ float lds_ld1(unsigned addr) {
  float r;
  asm volatile("ds_read_b32 %0, %1 offset:%2" : "=v"(r) : "v"(addr), "n"(OFF));
  return r;
}
constexpr int SC_BUF = 27648;
template <int OFF>
__device__ __forceinline__ v2f lds_ld2(unsigned addr) {
  v2f r;
  asm volatile("ds_read_b64 %0, %1 offset:%2" : "=v"(r) : "v"(addr), "n"(OFF));
  return r;
}
__device__ __forceinline__ void phase_scan(const Params& p, char* smem, int rep) {
  const u16* LW = (const u16*)(p.ws + OFF_REGF);
  const u16* R = (const u16*)(p.ws + OFF_REGF + 32 * MB);
  const u16* KM = (const u16*)(p.ws + OFF_REGF + 64 * MB);
  const u16* V = (const u16*)(p.ws + OFF_REGF + 96 * MB);
  const u16* KKN = (const u16*)(p.ws + OFF_REGF + 128 * MB);
  const u16* AA = (const u16*)(p.ws + OFF_REGD);
  float* Y = (float*)(p.ws + OFF_Y);
  const int tid = threadIdx.x, lane = tid & 63, w = tid >> 6;
  const int jl = lane & 15;
  const int ss = tid >> 4, sg = tid & 15;
  unsigned* claim = (unsigned*)(p.ws + OFF_BAR) + XCD_BAR_WORDS + rep * (2048 + 64);
  unsigned* qctr = claim + 2048;
  int* sflag = (int*)(smem + 2 * SC_BUF);
  float* ypw = (float*)(smem + 56320) + w * 1024;
  const unsigned sbase = (unsigned)(size_t)(LAS char*)smem;
  if (tid == 0) {
    const unsigned key = (xb_xcc_id() & 7u) * 256u + (((unsigned)__builtin_amdgcn_s_getreg(63492) >> 8) & 0xffu);
    sflag[0] = (atomicAdd(&claim[key], 1u) == 0u) ? 1 : 0;
  }
  __syncthreads();
  const bool scan_role = sflag[0] != 0;
  for (;;) {
    if (!scan_role) break;
    __syncthreads();
    if (tid == 0) sflag[1] = (int)atomicAdd(&qctr[0], 1u);
    __syncthreads();
    const int task = sflag[1];
    if (task >= 256) break;
    const int bh = task >> 2, rg = task & 3, b = bh >> 3, h = bh & 7;
    const int il = rg * 16 + w * 4 + (lane >> 4);
    v2f Sa = v2f{0.f, 0.f}, Sb = v2f{0.f, 0.f};
    const size_t base = (size_t)b * SEQ * 512 + h * 64 + sg * 4;
    uint2 gA_lw, gA_r, gA_km, gA_v, gA_kkn, gA_a;
    uint2 gB_lw, gB_r, gB_km, gB_v, gB_kkn, gB_a;
#define SC_GLOAD(X, t0)                                      \
  {                                                          \
    const size_t o = base + (size_t)((t0) + ss) * 512;       \
    X##_lw = *(const uint2*)(LW + o); X##_r = *(const uint2*)(R + o);   \
    X##_km = *(const uint2*)(KM + o); X##_v = *(const uint2*)(V + o);   \
    X##_kkn = *(const uint2*)(KKN + o); X##_a = *(const uint2*)(AA + o); \
  }
#define SC_STORE(X, bi)                                                                                \
  {                                                                                                    \
    float* d = (float*)(smem + (bi) * SC_BUF) + ss * 64 + sg * 4;                                      \
    const float4 kq = make_float4(bflo(X##_kkn.x), bfhi(X##_kkn.x), bflo(X##_kkn.y), bfhi(X##_kkn.y)); \
    *(float4*)(d) = make_float4(__expf(bflo(X##_lw.x)), __expf(bfhi(X##_lw.x)), __expf(bflo(X##_lw.y)), __expf(bfhi(X##_lw.y))); \
    *(float4*)(d + 1024) = kq;                                                                         \
    *(float4*)(d + 2048) = make_float4(kq.x * bflo(X##_a.x), kq.y * bfhi(X##_a.x), kq.z * bflo(X##_a.y), kq.w * bfhi(X##_a.y)); \
    *(float4*)(d + 3072) = make_float4(bflo(X##_km.x), bfhi(X##_km.x), bflo(X##_km.y), bfhi(X##_km.y)); \
    *(float4*)(d + 4096) = make_float4(bflo(X##_r.x), bfhi(X##_r.x), bflo(X##_r.y), bfhi(X##_r.y));    \
    float* vt = (float*)(smem + (bi) * SC_BUF) + 5120 + (sg * 4) * 16 + ss;     \
    vt[0] = bflo(X##_v.x); vt[16] = bfhi(X##_v.x); vt[32] = bflo(X##_v.y); vt[48] = bfhi(X##_v.y);     \
  }
#define SC_ISSUE(sl, S)                                     \
  {                                                         \
    dec_[sl] = lds_ld4<(S) * 256>(a0);                      \
    kkn_[sl] = lds_ld4<4096 + (S) * 256>(a0);               \
    km_[sl] = lds_ld4<12288 + (S) * 256>(a0);               \
    if (((S) & 3) == 0) vq_[((S) >> 2) & 1] = lds_ld4<20480 + (S) * 4>(a1); \
    nb_[sl] = lds_ld4<8192 + (S) * 256>(a0);                \
    rr_[sl] = lds_ld4<16384 + (S) * 256>(a0);               \
  }
#define SC_WAIT(N, sl)                                                                          \
  asm volatile("s_waitcnt lgkmcnt(" #N ")"                                                      \
               : "+v"(dec_[sl]), "+v"(kkn_[sl]), "+v"(nb_[sl]), "+v"(km_[sl]), "+v"(rr_[sl]), "+v"(vq_[0]), "+v"(vq_[1]));
#define LO2(q) (v2f{(q).x, (q).y})
#define HI2(q) (v2f{(q).z, (q).w})
#define SC_STEP(S, N)                                                                       \
  {                                                                                         \
    if ((S) + 2 < 16) SC_ISSUE(((S) + 2) % 3, (S) + 2)                                      \
    SC_WAIT(N, (S) % 3)                                                                     \
    const f32x4 dec = dec_[(S) % 3], kkn = kkn_[(S) % 3], nb = nb_[(S) % 3], km = km_[(S) % 3], rr = rr_[(S) % 3]; \
    const float vv = vq_[((S) >> 2) & 1][(S) & 3];                                          \
    const v2f v2 = v2f{vv, vv};                                                             \
    const v2f Ta = Sa * LO2(dec) + v2 * LO2(km);                                            \
    const v2f Tb = Sb * HI2(dec) + v2 * HI2(km);                                            \
    const v2f dv = Sa * LO2(kkn) + Sb * HI2(kkn);                                           \
    float dot = dv.x + dv.y;                                                                \
    if ((S) > 0) {     \
      dot += DPP_ROR(dot, 8); ypend += DPP_ROR(ypend, 8);                                   \
      dot += DPP_ROR(dot, 4); ypend += DPP_ROR(ypend, 4);                                   \
      dot += DPP_ROR(dot, 2); ypend += DPP_ROR(ypend, 2);                                   \
      dot += DPP_ROR(dot, 1); ypend += DPP_ROR(ypend, 1);                                   \
      ykeep = (jl == (S) - 1) ? ypend : ykeep;                                              \
    } else {                                                                                \
      dot = row16_sum(dot);                                                                 \
    }                                                                                       \
    const v2f d2 = v2f{dot, dot};                                                           \
    Sa = Ta - d2 * LO2(nb);                                                                 \
    Sb = Tb - d2 * HI2(nb);                                                                 \
    const v2f yv = Sa * LO2(rr) + Sb * HI2(rr);                                             \
    ypend = yv.x + yv.y;                                                                    \
    if ((S) == 15) { ypend = row16_sum(ypend); ykeep = (jl == 15) ? ypend : ykeep; }        \
  }
#define SC_COMPUTE(c)                                                                       \
  {                                                                                         \
    const unsigned a0 = sbase + (unsigned)(((c) & 1) * SC_BUF + jl * 16);                   \
    const unsigned a1 = sbase + (unsigned)(((c) & 1) * SC_BUF + il * 64);                   \
    f32x4 dec_[3], kkn_[3], nb_[3], km_[3], rr_[3], vq_[2];                                 \
    float ykeep = 0.f, ypend = 0.f;                                                         \
    SC_ISSUE(0, 0)                                                                          \
    SC_ISSUE(1, 1)                                                                          \
    SC_STEP(0, 10) SC_STEP(1, 10) SC_STEP(2, 10) SC_STEP(3, 10) SC_STEP(4, 10) SC_STEP(5, 10) SC_STEP(6, 10) SC_STEP(7, 10) \
    SC_STEP(8, 10) SC_STEP(9, 10) SC_STEP(10, 10) SC_STEP(11, 10) SC_STEP(12, 10) SC_STEP(13, 10) SC_STEP(14, 5) SC_STEP(15, 0) \
    yp[(size_t)((c) * 16 + jl) * 512] = ykeep;                                              \
  }
    constexpr int NCH = SEQ / 16;
    float* yp = Y + (size_t)b * SEQ * 512 + h * 64 + il;
    __syncthreads();
    SC_GLOAD(gA, 0);
    SC_STORE(gA, 0);
    SC_GLOAD(gA, 16);
    SC_GLOAD(gB, 32);
    __syncthreads();
    for (int c = 0; c < NCH; c += 2) {
      SC_COMPUTE(c)
      SC_STORE(gA, 1)
      if (c + 3 < NCH) SC_GLOAD(gA, (c + 3) * 16);
      asm volatile("s_waitcnt lgkmcnt(0)\n\ts_barrier" ::: "memory");
      SC_COMPUTE(c + 1)
      if (c + 2 < NCH) {
        SC_STORE(gB, 0)
        if (c + 4 < NCH) SC_GLOAD(gB, (c + 4) * 16);
      }
      asm volatile("s_waitcnt lgkmcnt(0)\n\ts_barrier" ::: "memory");
    }
  }
  for (;;) {
    __syncthreads();
    if (tid == 0) sflag[3] = (int)atomicAdd(&qctr[32], 1u);
    __syncthreads();
    const int u = sflag[3];
    __syncthreads();
    if (u >= T / 128) break;
    mix_unit(p, u, smem);
  }
  for (;;) {
    __syncthreads();
    if (tid == 0) sflag[2] = (int)atomicAdd(&qctr[16], 1u);
    __syncthreads();
    const int ch = sflag[2];
    if (ch >= CVT_CHUNKS) break;
    cvt_chunk(p, ch);
  }
}

__device__ __forceinline__ void phase_post(const Params& p) {
  const float* Y = (const float*)(p.ws + OFF_Y);
  const u16* V = (const u16*)(p.ws + OFF_REGF + 96 * MB);
  const u16* GG = (const u16*)(p.ws + OFF_REGD + 32 * MB);
  const float* BONUS = (const float*)(p.ws + OFF_BONUS);
  u16* MIXIN = (u16*)(p.ws + OFF_REGB);
  const int tid = threadIdx.x;
  const int c = (tid & 127) * 4;
  const float4 gw = *(const float4*)(p.gn_w + c), gb = *(const float4*)(p.gn_b + c);
  for (int tp = blockIdx.x; tp < T / 2; tp += gridDim.x) {
    const int t = tp * 2 + (tid >> 7);
    const size_t o = (size_t)t * 512 + c;
    const float4 y = *(const float4*)(Y + o);
    float s = row16_sum(y.x + y.y + y.z + y.w);
    const float mean = s * (1.f / 64.f);
    const float d0 = y.x - mean, d1 = y.y - mean, d2 = y.z - mean, d3 = y.w - mean;
    const float var = row16_sum(d0 * d0 + d1 * d1 + d2 * d2 + d3 * d3) * (1.f / 64.f);
    const float rstd = rsqrtf(var + 64e-5f);
    const float bon = BONUS[(size_t)t * 8 + (c >> 6)];
    const uint2 vu = *(const uint2*)(V + o), gu = *(const uint2*)(GG + o);
    const float o0 = (d0 * rstd * gw.x + gb.x + bon * bflo(vu.x)) * bflo(gu.x);
    const float o1 = (d1 * rstd * gw.y + gb.y + bon * bfhi(vu.x)) * bfhi(gu.x);
    const float o2 = (d2 * rstd * gw.z + gb.z + bon * bflo(vu.y)) * bflo(gu.y);
    const float o3 = (d3 * rstd * gw.w + gb.w + bon * bfhi(vu.y)) * bfhi(gu.y);
    *(uint2*)(MIXIN + (size_t)t * D + 512 + c) = make_uint2(pack2(o0, o1), pack2(o2, o3));
  }
}

__device__ __forceinline__ void phase_gemm_out(const Params& p, char* smem) {
  const u16* MIXIN = (const u16*)(p.ws + OFF_REGB);
  const u16* WOUT = (const u16*)(p.ws + OFF_WOUT);
  const float* MOD = (const float*)(p.ws + OFF_MOD);
  constexpr int NT = D / 128, MT = T / 128;
  for (int tile = blockIdx.x; tile < NT * MT; tile += gridDim.x) {
    const int mt = tile / NT, nt = tile % NT;
    f32x16 acc[2][2];
    gemm128d(MIXIN, D, WOUT, D, D, mt * 128, nt * 128, smem, acc);
    const int b = (mt * 128) / SEQ;
    const float* gt = MOD + b * 6144 + 2048 + nt * 128;
    epi_staged(acc, smem, [&](int row, int c4, float4 v) {
      const size_t o = (size_t)(mt * 128 + row) * D + nt * 128 + c4;
      const float4 xv = *(const float4*)(p.x + o);
      const float4 g = *(const float4*)(gt + c4);
      *(float4*)(p.out + o) = make_float4(xv.x + g.x * v.x, xv.y + g.y * v.y, xv.z + g.z * v.z, xv.w + g.w * v.w);
    });
  }
}

__device__ __forceinline__ u32 f2ord(float f) {
  u32 u = __float_as_uint(f);
  return (u & 0x80000000u) ? ~u : (u | 0x80000000u);
}
__device__ __forceinline__ float ord2f(u32 u) {
  u = (u & 0x80000000u) ? (u & 0x7FFFFFFFu) : ~u;
  return __uint_as_float(u);
}
#define TOPK_INSERT(L, x)                       \
  {                                             \
    u32 _x = (x);                               \
    _Pragma("unroll") for (int _i = 0; _i < 16; ++_i) { \
      u32 _hi = max(L[_i], _x);                 \
      _x = min(L[_i], _x);                      \
      L[_i] = _hi;                              \
    }                                           \
  }

#define CMPEX_DESC(a, b) { const u32 _hi = max(a, b); const u32 _lo = min(a, b); a = _hi; b = _lo; }
__device__ __forceinline__ void sort16_desc(u32 (&v)[16]) {
#pragma unroll
  for (int k = 2; k <= 16; k <<= 1) {
#pragma unroll
    for (int j = k >> 1; j > 0; j >>= 1) {
#pragma unroll
      for (int i = 0; i < 16; ++i) {
        const int l = i ^ j;
        if (l > i) {
          if ((i & k) == 0) CMPEX_DESC(v[i], v[l]) else CMPEX_DESC(v[l], v[i])
        }
      }
    }
  }
}
__device__ __forceinline__ void merge16_desc(u32 (&a)[16], const u32 (&b)[16]) {
#pragma unroll
  for (int i = 0; i < 16; ++i) a[i] = max(a[i], b[15 - i]);
#pragma unroll
  for (int j = 8; j > 0; j >>= 1) {
#pragma unroll
    for (int i = 0; i < 16; ++i) {
      const int l = i ^ j;
      if (l > i) CMPEX_DESC(a[i], a[l])
    }
  }
}

__device__ __forceinline__ void phase_peer_route(const Params& p, char* smem) {
  const u16* U2 = (const u16*)(p.ws + OFF_REGB);
  const u16* WQ = (const u16*)(p.ws + OFF_WQ);
  const u16* KEYS = (const u16*)(p.ws + OFF_KEYS);
  int* EXPID = (int*)(p.ws + OFF_EXPID);
  float* GATE = (float*)(p.ws + OFF_GATE);
  const int tid = threadIdx.x, lane = tid & 63, wid = tid >> 6, wm = wid >> 1, wn = wid & 1, fr = lane & 15, fq = lane >> 4;
  constexpr int QROWB = 272;
  char* qs = smem;
  char* ks = smem + 128 * QROWB;
  float* sT = (float*)smem;
  for (int task = blockIdx.x; task < (T / 128) * PEER_H; task += gridDim.x) {
    const int mt = task / PEER_H, h = task % PEER_H;
    u32 L0[16], L1[16];
#pragma unroll
    for (int pp = 0; pp < 2; ++pp) {
      f32x16 acc[2][2];
      gemm128(U2, D, WQ, D, D, mt * 128, h * 256 + pp * 128, smem, acc);
      {
        const int fr32 = lane & 31, fh = lane >> 5;
#pragma unroll
        for (int mi = 0; mi < 2; ++mi)
#pragma unroll
          for (int ni = 0; ni < 2; ++ni)
#pragma unroll
            for (int g = 0; g < 4; ++g)
              *(uint2*)(qs + (wm * 64 + mi * 32 + fr32) * QROWB + (wn * 64 + ni * 32 + g * 8 + fh * 4) * 2) =
                  make_uint2(pack2(acc[mi][ni][g * 4 + 0], acc[mi][ni][g * 4 + 1]), pack2(acc[mi][ni][g * 4 + 2], acc[mi][ni][g * 4 + 3]));
      }
      {
        const uint4* kg = (const uint4*)(KEYS + (size_t)(h * 2 + pp) * 128 * 128);
#pragma unroll
        for (int i = 0; i < 8; ++i) {
          const int id = tid + i * 256;
          const int row = id >> 4, cc = id & 15;
          *(uint4*)(ks + row * QROWB + cc * 16) = kg[id];
        }
      }
      __syncthreads();
      f32x16 sc[2][2];
#pragma unroll
      for (int a = 0; a < 2; ++a)
#pragma unroll
        for (int b2 = 0; b2 < 2; ++b2)
#pragma unroll
          for (int r = 0; r < 16; ++r) sc[a][b2][r] = 0.f;
      {
        const int fr32 = lane & 31, fh = lane >> 5;
#pragma unroll
        for (int kstep = 0; kstep < 8; ++kstep) {
          bf16x8 af[2], bfr[2];
#pragma unroll
          for (int i2 = 0; i2 < 2; ++i2) {
            af[i2] = *(const bf16x8*)(qs + (wm * 64 + i2 * 32 + fr32) * QROWB + kstep * 32 + fh * 16);
            bfr[i2] = *(const bf16x8*)(ks + (wn * 64 + i2 * 32 + fr32) * QROWB + kstep * 32 + fh * 16);
          }
#pragma unroll
          for (int mi = 0; mi < 2; ++mi)
#pragma unroll
            for (int ni = 0; ni < 2; ++ni)
              sc[mi][ni] = __builtin_amdgcn_mfma_f32_32x32x16_bf16(af[mi], bfr[ni], sc[mi][ni], 0, 0, 0);
        }
        __syncthreads();
#pragma unroll
        for (int mi = 0; mi < 2; ++mi)
#pragma unroll
          for (int ni = 0; ni < 2; ++ni)
#pragma unroll
            for (int g = 0; g < 4; ++g)
              *(f32x4*)(sT + (wn * 64 + ni * 32 + fr32) * 132 + wm * 64 + mi * 32 + g * 8 + fh * 4) =
                  f32x4{sc[mi][ni][g * 4 + 0], sc[mi][ni][g * 4 + 1], sc[mi][ni][g * 4 + 2], sc[mi][ni][g * 4 + 3]};
      }
      __syncthreads();
      {
        const int trow = tid & 127, half = tid >> 7;
        u32 L[16];
#pragma unroll
        for (int i = 0; i < 16; ++i) L[i] = 0u;
#pragma unroll 1
        for (int g = 0; g < 4; ++g) {
          u32 grp[16];
          const int kb = half * 64 + g * 16;
#pragma unroll
          for (int i = 0; i < 16; ++i) grp[i] = (f2ord(sT[(kb + i) * 132 + trow]) & ~0x7Fu) | (u32)(127 - kb - i);
          sort16_desc(grp);
          merge16_desc(L, grp);
        }
        __syncthreads();
        u32* xl = (u32*)smem;
        if (half == 1) {
#pragma unroll
          for (int i = 0; i < 16; ++i) xl[trow * 17 + i] = L[i];
        }
        __syncthreads();
        if (half == 0) {
          u32 oth[16];
#pragma unroll
          for (int i = 0; i < 16; ++i) oth[i] = xl[trow * 17 + i];
          merge16_desc(L, oth);
#pragma unroll
          for (int i = 0; i < 16; ++i) {
            if (pp == 0) L0[i] = L[i]; else L1[i] = L[i];
          }
        }
      }
      __syncthreads();
    }
    if (tid < 128) {
      float s0[16], s1[16];
#pragma unroll
      for (int i = 0; i < 16; ++i) {
        s0[i] = ord2f(L0[i] & ~0x7Fu);
        s1[i] = ord2f(L1[i] & ~0x7Fu);
      }
#define CKEY(i, j) ((f2ord(s0[i] + s1[j]) & ~0xFFu) | (u32)(255 - ((i) * 16 + (j))))
      u32 B[16], Bk[16], Ck[16], Dk[16];
#pragma unroll
      for (int j = 0; j < 16; ++j) B[j] = CKEY(0, j);
#pragma unroll
      for (int j = 0; j < 8; ++j) Bk[j] = CKEY(1, j);
#pragma unroll
      for (int j = 0; j < 5; ++j) Bk[8 + j] = CKEY(2, j);
#pragma unroll
      for (int j = 0; j < 3; ++j) Bk[13 + j] = CKEY(4, j);
#pragma unroll
      for (int j = 0; j < 4; ++j) Ck[j] = CKEY(3, j);
#pragma unroll
      for (int j = 0; j < 2; ++j) { Ck[4 + j] = CKEY(5, j); Ck[6 + j] = CKEY(6, j); Ck[8 + j] = CKEY(7, j); }
#pragma unroll
      for (int i = 8; i < 14; ++i) Ck[10 + (i - 8)] = CKEY(i, 0);
      {
        const u32 d14 = CKEY(14, 0), d15 = CKEY(15, 0);
        Dk[0] = max(d14, d15);
        Dk[1] = min(d14, d15);
#pragma unroll
        for (int i = 2; i < 16; ++i) Dk[i] = 0u;
      }
#undef CKEY
      sort16_desc(Bk);
      sort16_desc(Ck);
      merge16_desc(B, Bk);
      merge16_desc(B, Ck);
      merge16_desc(B, Dk);
      float bv[16];
      int eid[16];
#pragma unroll
      for (int q = 0; q < 16; ++q) {
        const int pos = 255 - (int)(B[q] & 0xFFu);
        const int i = pos >> 4, j = pos & 15;
        u32 a = 0u, bq = 0u;
#pragma unroll
        for (int z = 0; z < 16; ++z) {
          a = (z == i) ? L0[z] : a;
          bq = (z == j) ? L1[z] : bq;
        }
        const int i0 = 127 - (int)(a & 0x7Fu), i1 = 127 - (int)(bq & 0x7Fu);
        eid[q] = i0 * NKEYS + i1;
        bv[q] = ord2f(a & ~0x7Fu) + ord2f(bq & ~0x7Fu);
      }
      float mx = bv[0];
#pragma unroll
      for (int q = 1; q < 16; ++q) mx = fmaxf(mx, bv[q]);
      float den = 0.f;
#pragma unroll
      for (int q = 0; q < 16; ++q) { bv[q] = __expf(bv[q] - mx); den += bv[q]; }
      const float rden = 1.0f / den;
      const size_t o = ((size_t)(mt * 128 + tid) * PEER_H + h) * 16;
#pragma unroll
      for (int q = 0; q < 16; q += 4) {
        *(int4*)(EXPID + o + q) = make_int4(eid[q], eid[q + 1], eid[q + 2], eid[q + 3]);
        *(float4*)(GATE + o + q) = make_float4(bv[q] * rden, bv[q + 1] * rden, bv[q + 2] * rden, bv[q + 3] * rden);
      }
    }
  }
}

#define CVT_LO(w) __builtin_amdgcn_cvt_pk_f32_fp8((int)(w), false)
#define CVT_HI(w) __builtin_amdgcn_cvt_pk_f32_fp8((int)(w), true)
__device__ __forceinline__ void phase_peer_gather(const Params& p) {
  const u16* U2 = (const u16*)(p.ws + OFF_REGB);
  const uint4* EU = (const uint4*)(p.ws + OFF_EU8);
  const uint4* EV = (const uint4*)(p.ws + OFF_EV8);
  const int* EXPID = (const int*)(p.ws + OFF_EXPID);
  const float* GATE = (const float*)(p.ws + OFF_GATE);
  const float* MOD = (const float*)(p.ws + OFF_MOD);
  const int lane = threadIdx.x & 63;
  const int gw = blockIdx.x * 4 + (threadIdx.x >> 6), nw = gridDim.x * 4;
  for (int t = gw; t < T; t += nw) {
    const int b = t / SEQ;
    const uint4 xa = *(const uint4*)(U2 + (size_t)t * D + lane * 16);
    const uint4 xb = *(const uint4*)(U2 + (size_t)t * D + lane * 16 + 8);
    v2f x2[8];
    x2[0] = v2f{bflo(xa.x), bfhi(xa.x)}; x2[1] = v2f{bflo(xa.y), bfhi(xa.y)};
    x2[2] = v2f{bflo(xa.z), bfhi(xa.z)}; x2[3] = v2f{bflo(xa.w), bfhi(xa.w)};
    x2[4] = v2f{bflo(xb.x), bfhi(xb.x)}; x2[5] = v2f{bflo(xb.y), bfhi(xb.y)};
    x2[6] = v2f{bflo(xb.z), bfhi(xb.z)}; x2[7] = v2f{bflo(xb.w), bfhi(xb.w)};
    v2f o2[8];
#pragma unroll
    for (int i = 0; i < 8; ++i) o2[i] = v2f{0.f, 0.f};
    const int idA = EXPID[(size_t)t * 128 + lane], idB = EXPID[(size_t)t * 128 + 64 + lane];
    const float gA = GATE[(size_t)t * 128 + lane], gB = GATE[(size_t)t * 128 + 64 + lane];
    for (int h = 0; h < PEER_H; ++h) {
      const int idv = (h < 4) ? idA : idB;
      const float gtv = (h < 4) ? gA : gB;
      const int lb = (h & 3) * 16;
      float part[16];
#pragma unroll
      for (int e = 0; e < 16; ++e) {
        const int id = __builtin_amdgcn_readlane(idv, lb + e);
        const uint4 a = EU[(size_t)id * 64 + lane];
        v2f acc = CVT_LO(a.x) * x2[0];
        acc = CVT_HI(a.x) * x2[1] + acc;
        acc = CVT_LO(a.y) * x2[2] + acc;
        acc = CVT_HI(a.y) * x2[3] + acc;
        acc = CVT_LO(a.z) * x2[4] + acc;
        acc = CVT_HI(a.z) * x2[5] + acc;
        acc = CVT_LO(a.w) * x2[6] + acc;
        acc = CVT_HI(a.w) * x2[7] + acc;
        part[e] = acc.x + acc.y;
      }
      float p8[8], p4[4], p2[2], p1;
      {
        const bool up = (lane & 32) != 0;
#pragma unroll
        for (int e = 0; e < 8; ++e) {
          const float mine = up ? part[e + 8] : part[e];
          const float oth = up ? part[e] : part[e + 8];
          p8[e] = mine + __shfl_xor(oth, 32);
        }
      }
      {
        const bool up = (lane & 16) != 0;
#pragma unroll
        for (int e = 0; e < 4; ++e) {
          const float mine = up ? p8[e + 4] : p8[e];
          const float oth = up ? p8[e] : p8[e + 4];
          p4[e] = mine + __shfl_xor(oth, 16);
        }
      }
      {
        const bool up = (lane & 8) != 0;
#pragma unroll
        for (int e = 0; e < 2; ++e) {
          const float mine = up ? p4[e + 2] : p4[e];
          const float oth = up ? p4[e] : p4[e + 2];
          p2[e] = mine + __shfl_xor(oth, 8);
        }
      }
      {
        const bool up = (lane & 4) != 0;
        const float mine = up ? p2[1] : p2[0];
        const float oth = up ? p2[0] : p2[1];
        p1 = mine + __shfl_xor(oth, 4);
      }
      p1 += __shfl_xor(p1, 2);
      p1 += __shfl_xor(p1, 1);
      p1 *= (1.0f / 512.f);
      const int myE = ((lane >> 5) & 1) * 8 + ((lane >> 4) & 1) * 4 + ((lane >> 3) & 1) * 2 + ((lane >> 2) & 1);
      const float gmine = __shfl(gtv, lb + myE);
      const float hv = 0.5f * p1 * (1.0f + erff(p1 * 0.70710678118654752f));
      const float coef = gmine * hv * (1.0f / 128.f);
#pragma unroll
      for (int e = 0; e < 16; ++e) {
        const int srcLane = ((e >> 3) & 1) * 32 + ((e >> 2) & 1) * 16 + ((e >> 1) & 1) * 8 + (e & 1) * 4;
        const float ce = __builtin_bit_cast(float, __builtin_amdgcn_readlane(__builtin_bit_cast(int, coef), srcLane));
        const int id = __builtin_amdgcn_readlane(idv, lb + e);
        const uint4 a = EV[(size_t)id * 64 + lane];
        const v2f c2 = v2f{ce, ce};
        o2[0] = CVT_LO(a.x) * c2 + o2[0];
        o2[1] = CVT_HI(a.x) * c2 + o2[1];
        o2[2] = CVT_LO(a.y) * c2 + o2[2];
        o2[3] = CVT_HI(a.y) * c2 + o2[3];
        o2[4] = CVT_LO(a.z) * c2 + o2[4];
        o2[5] = CVT_HI(a.z) * c2 + o2[5];
        o2[6] = CVT_LO(a.w) * c2 + o2[6];
        o2[7] = CVT_HI(a.w) * c2 + o2[7];
      }
    }
    float* orow = p.out + (size_t)t * D + lane * 16;
    const float* gt = MOD + b * 6144 + 5120 + lane * 16;
    float xf[16];
    float ss = 0.f;
#pragma unroll
    for (int q = 0; q < 4; ++q) {
      const float4 x0 = *(const float4*)(orow + q * 4);
      const float4 g0 = *(const float4*)(gt + q * 4);
      xf[q * 4 + 0] = x0.x + g0.x * o2[q * 2].x;
      xf[q * 4 + 1] = x0.y + g0.y * o2[q * 2].y;
      xf[q * 4 + 2] = x0.z + g0.z * o2[q * 2 + 1].x;
      xf[q * 4 + 3] = x0.w + g0.w * o2[q * 2 + 1].y;
    }
#pragma unroll
    for (int i = 0; i < 16; ++i) ss += xf[i] * xf[i];
    ss = wave_sum(ss);
    const float rstd = rsqrtf(ss * (1.0f / D) + 1e-6f);
#pragma unroll
    for (int q = 0; q < 4; ++q) {
      const float4 f0 = *(const float4*)(p.final_g + lane * 16 + q * 4);
      *(float4*)(orow + q * 4) =
          make_float4(xf[q * 4 + 0] * rstd * f0.x, xf[q * 4 + 1] * rstd * f0.y, xf[q * 4 + 2] * rstd * f0.z, xf[q * 4 + 3] * rstd * f0.w);
    }
  }
}

#ifndef PROBE_MASK
#define PROBE_MASK 0
#endif
__global__ void __launch_bounds__(NTHREADS, 2) hymba_mega(Params p) {
  __shared__ __attribute__((aligned(16))) char smem[SMEM_BYTES];
  __shared__ uint4 xb_words;
  cg::grid_group grid = cg::this_grid();
  if (threadIdx.x == 0) xb_words = make_uint4(0u, 0u, 0u, 0u);
  __syncthreads();
  const XcdBarrier xb = xcd_barrier_post((unsigned*)(p.ws + OFF_BAR), (volatile LAS unsigned*)&xb_words);
#define RUN_PHASE(N, CALL)                          \
  {                                                 \
    CALL;                                           \
    if ((PROBE_MASK >> (N)) & 1) { xcd_barrier(xb); CALL; } \
  }
  RUN_PHASE(0, phase_prep(p, smem))
  grid.sync();
  RUN_PHASE(1, phase_normmod(p.x, p.norm_mix_g, (const float*)(p.ws + OFF_MOD), 0, 1024, (u16*)(p.ws + OFF_REGB)))
  xcd_barrier(xb);
  RUN_PHASE(2, phase_gemm_in(p, smem))
  xcd_barrier(xb);
  RUN_PHASE(3, phase_act(p))
  xcd_barrier(xb);
  RUN_PHASE(4, phase_lora_conv(p, smem))
  xcd_barrier(xb);
  RUN_PHASE(5, phase_scanprep(p))
  xcd_barrier(xb);
  phase_scan(p, smem, 0);
  if ((PROBE_MASK >> 6) & 1) { xcd_barrier(xb); phase_scan(p, smem, 1); }
  xcd_barrier(xb);
  RUN_PHASE(7, phase_post(p))
  xcd_barrier(xb);
  RUN_PHASE(8, phase_gemm_out(p, smem))
  xcd_barrier(xb);
  RUN_PHASE(9, phase_normmod(p.out, p.norm_ffn_g, (const float*)(p.ws + OFF_MOD), 3072, 4096, (u16*)(p.ws + OFF_REGB)))
  xcd_barrier(xb);
  RUN_PHASE(10, phase_peer_route(p, smem))
  xcd_barrier(xb);
  phase_peer_gather(p);
#ifdef PROBE_TIME
  xcd_barrier(xb);
  if (blockIdx.x == 0 && threadIdx.x == 0) p.out[0] += *(const float*)(p.ws + OFF_BAR + 32768);
#endif
}

extern "C" void kernel_launch(void* const* d_in, const int* in_sizes, int n_in, void* d_out, int out_size, void* d_ws,
                              size_t ws_size, hipStream_t stream) {
  static int grid_blocks = 0;
  if (!grid_blocks) {
    int dev = 0, cus = 0, per_cu = 0;
    (void)hipGetDevice(&dev);
    (void)hipDeviceGetAttribute(&cus, hipDeviceAttributeMultiprocessorCount, dev);
    (void)hipOccupancyMaxActiveBlocksPerMultiprocessor(&per_cu, hymba_mega, NTHREADS, 0);
    if (per_cu > 2) per_cu = 2;
    grid_blocks = cus * per_cu;
  }
  if (ws_size < WS_NEEDED) {
    fprintf(stderr, "workspace too small: %zu < %zu\n", ws_size, (size_t)WS_NEEDED);
    return;
  }
  Params p{};
  const float** pf = (const float**)&p;
  for (int i = 0; i < 28; ++i) pf[i] = (const float*)d_in[i];
  p.out = (float*)d_out;
  p.ws = (char*)d_ws;
  (void)hipMemsetAsync((char*)d_ws + OFF_BAR, 0, (XCD_BAR_WORDS + 2 * (2048 + 64)) * 4, stream);
  void* args[] = {&p};
  hipError_t e = hipLaunchCooperativeKernel((void*)hymba_mega, dim3(grid_blocks), dim3(NTHREADS), args, 0, stream);
  if (e != hipSuccess) fprintf(stderr, "cooperative launch failed: %s (grid %d)\n", hipGetErrorString(e), grid_blocks);
}
```

```cpp
#include <hip/hip_runtime.h>
#include <hip/hip_cooperative_groups.h>
#include <cstdio>
#include <cstdint>
namespace cg = cooperative_groups;

typedef unsigned short u16;
typedef unsigned int u32;
using bf16x8 = __attribute__((ext_vector_type(8))) short;
using f32x4 = __attribute__((ext_vector_type(4))) float;
using f32x16 = __attribute__((ext_vector_type(16))) float;
typedef __attribute__((ext_vector_type(2))) __bf16 bf2_t;
typedef float v2f __attribute__((ext_vector_type(2)));

constexpr int D = 1024, NBATCH = 8, SEQ = 4096, T = NBATCH * SEQ;
constexpr int CONV_CH = 512, RW = 512, NPROJ = 2816, RWKV_PROJ = 1792;
constexpr int CONV_W = 31;
constexpr int NHEAD = 8;
constexpr int PEER_H = 8, PEER_K = 16, NKEYS = 128;
constexpr int NTHREADS = 256;
constexpr int SMEM_BYTES = 79872;

constexpr size_t MB = 1ull << 20;
constexpr size_t OFF_WIN = 0;
constexpr size_t OFF_WOUT = OFF_WIN + (size_t)NPROJ * D * 2;
constexpr size_t OFF_WQ = OFF_WOUT + (size_t)D * D * 2;
constexpr size_t OFF_WLORA = OFF_WQ + (size_t)2048 * D * 2;
constexpr size_t OFF_KEYS = OFF_WLORA + (size_t)1536 * 256 * 2;
constexpr size_t OFF_MOD = OFF_KEYS + (size_t)16 * 128 * 128 * 2;
constexpr size_t OFF_BONUS = OFF_MOD + (size_t)8 * 6144 * 4;
constexpr size_t OFF_BAR = OFF_BONUS + (size_t)T * 8 * 4;
constexpr size_t OFF_REGB = 16 * MB;
constexpr size_t OFF_REGC = OFF_REGB + 64 * MB;
constexpr size_t SZ_P = (size_t)T * NPROJ * 2;
constexpr size_t OFF_PC = OFF_REGC;
constexpr size_t OFF_PR = OFF_REGC + 64 * MB;
constexpr size_t OFF_Y = OFF_REGC + 64 * MB;
constexpr size_t OFF_EXPID = OFF_REGC + 160 * MB;
constexpr size_t OFF_GATE = OFF_REGC + 176 * MB;
constexpr size_t OFF_REGD = OFF_REGC + 176 * MB + 16 * MB;
constexpr size_t OFF_REGF = OFF_REGD + 64 * MB;
constexpr size_t WS_NEEDED = OFF_REGF + 160 * MB;
static_assert(OFF_BAR + (3456 + 2 * (2048 + 64)) * 4 <= OFF_REGB, "small region overflow");
static_assert(SZ_P <= 192 * MB, "P overflow");

struct Params {
  const float *x, *c, *ada_w, *ada_b, *norm_mix_g, *w_in, *conv_w, *conv_b, *ln_w, *ln_b;
  const float *mu, *w0, *w2, *a0, *a2, *g2, *k_k, *k_a, *r_k, *gn_w, *gn_b, *w_out, *norm_ffn_g;
  const float *w_q, *sub_keys, *peer_u, *peer_v, *final_g;
  float* out;
  char* ws;
};

__device__ __forceinline__ u16 f2bf(float f) {
  u32 u = __float_as_uint(f);
  u += 0x7FFFu + ((u >> 16) & 1u);
  return (u16)(u >> 16);
}
__device__ __forceinline__ float bf2f(u16 h) { return __uint_as_float(((u32)h) << 16); }
__device__ __forceinline__ u32 pack2(float a, float b) { return (u32)f2bf(a) | ((u32)f2bf(b) << 16); }
__device__ __forceinline__ float bflo(u32 v) { return __uint_as_float(v << 16); }
__device__ __forceinline__ float bfhi(u32 v) { return __uint_as_float(v & 0xFFFF0000u); }
__device__ __forceinline__ float sigmoidf_(float x) { return 1.0f / (1.0f + __expf(-x)); }
__device__ __forceinline__ float siluf_(float x) { return x * sigmoidf_(x); }
__device__ __forceinline__ float wave_sum(float v) {
#pragma unroll
  for (int o = 32; o > 0; o >>= 1) v += __shfl_xor(v, o);
  return v;
}
__device__ __forceinline__ float dpp_ror_add(float x, int) { return x; }
#define DPP_ROR(x, N) __builtin_bit_cast(float, __builtin_amdgcn_update_dpp(0, __builtin_bit_cast(int, (x)), 0x120 + (N), 0xF, 0xF, false))
__device__ __forceinline__ float row16_sum(float x) {
  x += DPP_ROR(x, 8);
  x += DPP_ROR(x, 4);
  x += DPP_ROR(x, 2);
  x += DPP_ROR(x, 1);
  return x;
}

#define XB_TMO      128
#define XB_XCNT(j)  (256  + 64 * (j))
#define XB_XSUB(j)  (1280 + 64 * (j))
#define XB_XGEN(j)  (2304 + 64 * (j))
#define XB_TOP      3328
#define XB_TOPGEN   3392
#define XCD_BAR_WORDS 3456
#define XB_SPIN_CAP (1u << 18)
#define LAS __attribute__((address_space(3)))
__device__ __forceinline__ unsigned xb_ld(unsigned* p)              { return __hip_atomic_load(p, __ATOMIC_RELAXED, __HIP_MEMORY_SCOPE_AGENT); }
__device__ __forceinline__ unsigned xb_add(unsigned* p, unsigned v) { return __hip_atomic_fetch_add(p, v, __ATOMIC_RELAXED, __HIP_MEMORY_SCOPE_AGENT); }
__device__ __forceinline__ unsigned xb_xcc_id() { return (unsigned)__builtin_amdgcn_s_getreg((3 << 11) | 20) & 0xFu; }
#define XB_SPIN(cond, bar) do { unsigned _sp = 0; while (cond) { __builtin_amdgcn_s_sleep(1); \
    if ((++_sp & 255u) == 0u) { if (xb_ld(&(bar)[XB_TMO])) break; if (_sp > XB_SPIN_CAP) { atomicAdd(&(bar)[XB_TMO], 1u); break; } } } } while (0)
struct XcdBarrier { unsigned* bar; unsigned x; volatile LAS unsigned* st; };
__device__ __forceinline__ XcdBarrier xcd_barrier_post(unsigned* bar, volatile LAS unsigned* st) {
    XcdBarrier b; b.bar = bar; b.x = xb_xcc_id(); b.st = st;
    if (threadIdx.x == 0) (void)xb_add(&bar[XB_XCNT(b.x)], 1u);
    return b;
}
__device__ __forceinline__ void xcd_barrier_complete(unsigned* bar, unsigned x, unsigned& nloc, unsigned& nx) {
    const unsigned G = gridDim.x * gridDim.y * gridDim.z;
    unsigned sum, cnt, mine, sp = 0u;
    for (;;) {
        sum = 0u; cnt = 0u; mine = 0u;
#pragma unroll
        for (unsigned j = 0; j < 16; ++j) { const unsigned c = xb_ld(&bar[XB_XCNT(j)]); sum += c; cnt += (c > 0u) ? 1u : 0u; mine = (j == x) ? c : mine; }
        if (sum == G) break;
        __builtin_amdgcn_s_sleep(1);
        if ((++sp & 255u) == 0u) { if (xb_ld(&bar[XB_TMO])) break; if (sp > XB_SPIN_CAP) { atomicAdd(&bar[XB_TMO], 1u); break; } }
    }
    nloc = mine > 0u ? mine : 1u; nx = cnt > 0u ? cnt : 1u;
}
__device__ __forceinline__ void xcd_barrier(const XcdBarrier& b) {
    asm volatile("s_waitcnt vmcnt(0)" ::: "memory");
    __syncthreads();
    if (threadIdx.x == 0) {
        unsigned* bar = b.bar;
        __builtin_amdgcn_s_waitcnt(0);
        unsigned nloc = b.st[0], nx = b.st[1];
        if (nloc == 0u) { xcd_barrier_complete(bar, b.x, nloc, nx); b.st[0] = nloc; b.st[1] = nx; }
        const unsigned old = xb_add(&bar[XB_XSUB(b.x)], 1u);
        const unsigned gen = old / nloc;
        if (old + 1u == (gen + 1u) * nloc) {
            __builtin_amdgcn_fence(__ATOMIC_RELEASE, "agent");
            asm volatile("s_waitcnt vmcnt(0)" ::: "memory");
            const unsigned og = xb_add(&bar[XB_TOP], 1u);
            const unsigned tg = og / nx;
            if (og + 1u == (tg + 1u) * nx) xb_add(&bar[XB_TOPGEN], 1u);
            else XB_SPIN(xb_ld(&bar[XB_TOPGEN]) == tg, bar);
            __builtin_amdgcn_fence(__ATOMIC_ACQUIRE, "agent");
            xb_add(&bar[XB_XGEN(b.x)], 1u);
            asm volatile("s_waitcnt vmcnt(0)" ::: "memory");
        } else {
            XB_SPIN(xb_ld(&bar[XB_XGEN(b.x)]) == gen, bar);
            __builtin_amdgcn_fence(__ATOMIC_ACQUIRE, "agent");
            asm volatile("s_waitcnt vmcnt(0)" ::: "memory");
        }
    }
    __syncthreads();
}

constexpr int G_ROWB = 144;
constexpr int G_TILEB = 128 * G_ROWB;
template <bool SWAP = true>
__device__ __forceinline__ void gemm128(const u16* __restrict__ A, int lda, const u16* __restrict__ B, int ldb, int K,
                                        int m0, int n0, char* smem, f32x16 (&acc)[2][2]) {
  const int tid = threadIdx.x, lane = tid & 63, wid = tid >> 6, wm = wid >> 1, wn = wid & 1;
  const int fr = lane & 15, fq = lane >> 4;
  const int ldrow = tid >> 3, ldc = tid & 7;
#pragma unroll
  for (int i = 0; i < 2; ++i)
#pragma unroll
    for (int j = 0; j < 2; ++j)
#pragma unroll
      for (int r = 0; r < 16; ++r) acc[i][j][r] = 0.f;
  const int fr32 = lane & 31, fh = lane >> 5;
  uint4 ra[4], rb[4];
  const u16* ga = A + (size_t)(m0 + ldrow) * lda + ldc * 8;
  const u16* gb = B + (size_t)(n0 + ldrow) * ldb + ldc * 8;
  const int nk = K >> 6;
#pragma unroll
  for (int i = 0; i < 4; ++i) {
    ra[i] = *(const uint4*)(ga + (size_t)(32 * i) * lda);
    rb[i] = *(const uint4*)(gb + (size_t)(32 * i) * ldb);
  }
  {
    char* sa = smem + ldrow * G_ROWB + ldc * 16;
#pragma unroll
    for (int i = 0; i < 4; ++i) {
      *(uint4*)(sa + 32 * i * G_ROWB) = ra[i];
      *(uint4*)(sa + G_TILEB + 32 * i * G_ROWB) = rb[i];
    }
  }
  __syncthreads();
  for (int kt = 0; kt < nk; ++kt) {
    const bool more = (kt + 1 < nk);
    if (more) {
      const int k0 = (kt + 1) << 6;
#pragma unroll
      for (int i = 0; i < 4; ++i) {
        ra[i] = *(const uint4*)(ga + (size_t)(32 * i) * lda + k0);
        rb[i] = *(const uint4*)(gb + (size_t)(32 * i) * ldb + k0);
      }
    }
    const char* cur = smem + (kt & 1) * 2 * G_TILEB;
    const char* sa = cur + (wm * 64 + fr32) * G_ROWB + fh * 16;
    const char* sb = cur + G_TILEB + (wn * 64 + fr32) * G_ROWB + fh * 16;
#pragma unroll
    for (int ks = 0; ks < 4; ++ks) {
      bf16x8 af[2], bfr[2];
#pragma unroll
      for (int i = 0; i < 2; ++i) {
        af[i] = *(const bf16x8*)(sa + i * 32 * G_ROWB + ks * 32);
        bfr[i] = *(const bf16x8*)(sb + i * 32 * G_ROWB + ks * 32);
      }
#pragma unroll
      for (int mi = 0; mi < 2; ++mi)
#pragma unroll
        for (int ni = 0; ni < 2; ++ni)
          acc[mi][ni] = SWAP ? __builtin_amdgcn_mfma_f32_32x32x16_bf16(bfr[ni], af[mi], acc[mi][ni], 0, 0, 0)
                             : __builtin_amdgcn_mfma_f32_32x32x16_bf16(af[mi], bfr[ni], acc[mi][ni], 0, 0, 0);
    }
    if (more) {
      char* nxt = smem + ((kt + 1) & 1) * 2 * G_TILEB + ldrow * G_ROWB + ldc * 16;
#pragma unroll
      for (int i = 0; i < 4; ++i) {
        *(uint4*)(nxt + 32 * i * G_ROWB) = ra[i];
        *(uint4*)(nxt + G_TILEB + 32 * i * G_ROWB) = rb[i];
      }
    }
    __syncthreads();
  }
}

__device__ __forceinline__ void gemm128d(const u16* __restrict__ A, int lda, const u16* __restrict__ B, int ldb, int K,
                                        int m0, int n0, char* smem, f32x16 (&acc)[2][2]) {
  const int tid = threadIdx.x, lane = tid & 63, wid = tid >> 6, wm = wid >> 1, wn = wid & 1;
  const int fr = lane & 15, fq = lane >> 4;
  const int ldrow = tid >> 3, ldc = tid & 7;
#pragma unroll
  for (int i = 0; i < 2; ++i)
#pragma unroll
    for (int j = 0; j < 2; ++j)
#pragma unroll
      for (int r = 0; r < 16; ++r) acc[i][j][r] = 0.f;
  const int fr32 = lane & 31, fh = lane >> 5;
  uint4 ra0_0, ra0_1, ra0_2, ra0_3, rb0_0, rb0_1, rb0_2, rb0_3;
  uint4 ra1_0, ra1_1, ra1_2, ra1_3, rb1_0, rb1_1, rb1_2, rb1_3;
  const u16* ga = A + (size_t)(m0 + ldrow) * lda + ldc * 8;
  const u16* gb = B + (size_t)(n0 + ldrow) * ldb + ldc * 8;
  const int nk = K >> 6;
  char* const sw = smem + ldrow * G_ROWB + ldc * 16;
#define G_LOAD1(RA, RB, I, k0)                                          \
  RA##_##I = *(const uint4*)(ga + (size_t)(32 * I) * lda + k0);         \
  RB##_##I = *(const uint4*)(gb + (size_t)(32 * I) * ldb + k0);
#define G_LOAD(RA, RB, KT)                                              \
  {                                                                     \
    const int k0 = (KT) << 6;                                           \
    G_LOAD1(RA, RB, 0, k0) G_LOAD1(RA, RB, 1, k0) G_LOAD1(RA, RB, 2, k0) G_LOAD1(RA, RB, 3, k0) \
  }
#define G_STORE1(RA, RB, I)                                             \
  *(uint4*)(d + 32 * I * G_ROWB) = RA##_##I;                            \
  *(uint4*)(d + G_TILEB + 32 * I * G_ROWB) = RB##_##I;
#define G_STORE(RA, RB, BUF)                                            \
  {                                                                     \
    char* d = sw + (BUF) * 2 * G_TILEB;                                 \
    G_STORE1(RA, RB, 0) G_STORE1(RA, RB, 1) G_STORE1(RA, RB, 2) G_STORE1(RA, RB, 3) \
  }
#define G_COMPUTE(BUF)                                                                          \
  {                                                                                             \
    const char* cur = smem + (BUF) * 2 * G_TILEB;                                               \
    const char* sa = cur + (wm * 64 + fr32) * G_ROWB + fh * 16;                                 \
    const char* sb = cur + G_TILEB + (wn * 64 + fr32) * G_ROWB + fh * 16;                       \
    _Pragma("unroll") for (int ks = 0; ks < 4; ++ks) {                                          \
      bf16x8 af[2], bfr[2];                                                                     \
      _Pragma("unroll") for (int i = 0; i < 2; ++i) {                                           \
        af[i] = *(const bf16x8*)(sa + i * 32 * G_ROWB + ks * 32);                               \
        bfr[i] = *(const bf16x8*)(sb + i * 32 * G_ROWB + ks * 32);                              \
      }                                                                                         \
      _Pragma("unroll") for (int mi = 0; mi < 2; ++mi)                                          \
      _Pragma("unroll") for (int ni = 0; ni < 2; ++ni)                                          \
        acc[mi][ni] = __builtin_amdgcn_mfma_f32_32x32x16_bf16(bfr[ni], af[mi], acc[mi][ni], 0, 0, 0); \
    }                                                                                           \
  }
  G_LOAD(ra0, rb0, 0)
  G_STORE(ra0, rb0, 0)
  G_LOAD(ra0, rb0, 1)
  if (nk > 2) G_LOAD(ra1, rb1, 2)
  __syncthreads();
  for (int kt = 0; kt < nk; kt += 2) {
    G_COMPUTE(0)
    G_STORE(ra0, rb0, 1)
    if (kt + 3 < nk) G_LOAD(ra0, rb0, kt + 3)
    __syncthreads();
    G_COMPUTE(1)
    if (kt + 2 < nk) {
      G_STORE(ra1, rb1, 0)
      if (kt + 4 < nk) G_LOAD(ra1, rb1, kt + 4)
    }
    __syncthreads();
  }
#undef G_LOAD
#undef G_LOAD1
#undef G_STORE
#undef G_STORE1
#undef G_COMPUTE
}

#define ACC_FOREACH(BODY)                                                            \
  {                                                                                  \
    const int _lane = threadIdx.x & 63, _wid = threadIdx.x >> 6;                     \
    const int _wm = _wid >> 1, _wn = _wid & 1, _fr = _lane & 15, _fq = _lane >> 4;   \
    _Pragma("unroll") for (int mi = 0; mi < 4; ++mi)                                 \
    _Pragma("unroll") for (int ni = 0; ni < 4; ++ni)                                 \
    _Pragma("unroll") for (int j = 0; j < 4; ++j) {                                  \
      const int lrow = _wm * 64 + mi * 16 + _fq * 4 + j;                             \
      const int lcol = _wn * 64 + ni * 16 + _fr;                                     \
      const float v = acc[mi][ni][j];                                                \
      BODY                                                                           \
    }                                                                                \
  }

template <class F>
__device__ __forceinline__ void epi_staged(f32x16 (&acc)[2][2], char* smem, F f) {
  float* st = (float*)smem;
  {
    const int lane = threadIdx.x & 63, wid = threadIdx.x >> 6, wm = wid >> 1, wn = wid & 1, fr32 = lane & 31, fh = lane >> 5;
#pragma unroll
    for (int mi = 0; mi < 2; ++mi)
#pragma unroll
      for (int ni = 0; ni < 2; ++ni)
#pragma unroll
        for (int g = 0; g < 4; ++g)
          *(f32x4*)(st + (wm * 64 + mi * 32 + fr32) * 132 + wn * 64 + ni * 32 + g * 8 + fh * 4) =
              f32x4{acc[mi][ni][g * 4 + 0], acc[mi][ni][g * 4 + 1], acc[mi][ni][g * 4 + 2], acc[mi][ni][g * 4 + 3]};
  }
  __syncthreads();
#pragma unroll 4
  for (int i = threadIdx.x; i < 128 * 32; i += NTHREADS) {
    const int row = i >> 5, c4 = (i & 31) << 2;
    const float4 v = *(const float4*)(st + row * 132 + c4);
    f(row, c4, v);
  }
  __syncthreads();
}

constexpr int H_ROWB = 80;
constexpr int H_A = 256 * H_ROWB, H_B = 128 * H_ROWB, H_STAGE = H_A + H_B;
__device__ __forceinline__ void gemm256(const u16* __restrict__ A, int lda, const u16* __restrict__ B, int ldb, int K,
                                        int m0, int n0, char* smem, f32x16 (&acc)[4][2]) {
  const int tid = threadIdx.x, lane = tid & 63, wid = tid >> 6, wm = wid >> 1, wn = wid & 1;
  const int fr32 = lane & 31, fh = lane >> 5;
#pragma unroll
  for (int i = 0; i < 4; ++i)
#pragma unroll
    for (int j = 0; j < 2; ++j)
#pragma unroll
      for (int r = 0; r < 16; ++r) acc[i][j][r] = 0.f;
  const int ldrow = tid >> 2, ldc = tid & 3;
  const u16* ga = A + (size_t)(m0 + ldrow) * lda + ldc * 8;
  const u16* gb = B + (size_t)(n0 + ldrow) * ldb + ldc * 8;
  uint4 a0, a1, a2, a3, b0, b1;
  uint4 c0, c1, c2, c3, d0, d1;
  const int nk = K >> 5;
  char* const swa = smem + ldrow * H_ROWB + ldc * 16;
  char* const swb = smem + H_A + ldrow * H_ROWB + ldc * 16;
#define H_LOAD(k0, A0, A1, A2, A3, B0, B1)                      \
  A0 = *(const uint4*)(ga + (k0));                              \
  A1 = *(const uint4*)(ga + (size_t)64 * lda + (k0));           \
  A2 = *(const uint4*)(ga + (size_t)128 * lda + (k0));          \
  A3 = *(const uint4*)(ga + (size_t)192 * lda + (k0));          \
  B0 = *(const uint4*)(gb + (k0));                              \
  B1 = *(const uint4*)(gb + (size_t)64 * ldb + (k0));
#define H_STORE(BUF, A0, A1, A2, A3, B0, B1)                    \
  *(uint4*)(swa + (BUF) * H_STAGE) = A0;                        \
  *(uint4*)(swa + (BUF) * H_STAGE + 64 * H_ROWB) = A1;          \
  *(uint4*)(swa + (BUF) * H_STAGE + 128 * H_ROWB) = A2;         \
  *(uint4*)(swa + (BUF) * H_STAGE + 192 * H_ROWB) = A3;         \
  *(uint4*)(swb + (BUF) * H_STAGE) = B0;                        \
  *(uint4*)(swb + (BUF) * H_STAGE + 64 * H_ROWB) = B1;
#define H_COMPUTE(BUF)                                                                          \
  {                                                                                             \
    const char* cur = smem + (BUF) * H_STAGE;                                                   \
    const char* sa = cur + (wm * 128 + fr32) * H_ROWB + fh * 16;                                \
    const char* sb = cur + H_A + (wn * 64 + fr32) * H_ROWB + fh * 16;                           \
    _Pragma("unroll") for (int ks = 0; ks < 2; ++ks) {                                          \
      bf16x8 af[4], bfr[2];                                                                     \
      _Pragma("unroll") for (int i = 0; i < 4; ++i) af[i] = *(const bf16x8*)(sa + i * 32 * H_ROWB + ks * 32); \
      _Pragma("unroll") for (int i = 0; i < 2; ++i) bfr[i] = *(const bf16x8*)(sb + i * 32 * H_ROWB + ks * 32); \
      _Pragma("unroll") for (int mi = 0; mi < 4; ++mi)                                          \
      _Pragma("unroll") for (int ni = 0; ni < 2; ++ni)                                          \
        acc[mi][ni] = __builtin_amdgcn_mfma_f32_32x32x16_bf16(bfr[ni], af[mi], acc[mi][ni], 0, 0, 0); \
    }                                                                                           \
  }
  H_LOAD(0, a0, a1, a2, a3, b0, b1)
  H_STORE(0, a0, a1, a2, a3, b0, b1)
  H_LOAD(32, a0, a1, a2, a3, b0, b1)
  if (nk > 2) { H_LOAD(64, c0, c1, c2, c3, d0, d1) }
  __syncthreads();
  for (int kt = 0; kt < nk; kt += 2) {
    H_COMPUTE(0)
    H_STORE(1, a0, a1, a2, a3, b0, b1)
    if (kt + 3 < nk) { const int k0 = (kt + 3) << 5; H_LOAD(k0, a0, a1, a2, a3, b0, b1) }
    __syncthreads();
    H_COMPUTE(1)
    if (kt + 2 < nk) {
      H_STORE(0, c0, c1, c2, c3, d0, d1)
      if (kt + 4 < nk) { const int k0 = (kt + 4) << 5; H_LOAD(k0, c0, c1, c2, c3, d0, d1) }
    }
    __syncthreads();
  }
#undef H_COMPUTE
#undef H_LOAD
#undef H_STORE
}
template <class F>
__device__ __forceinline__ void epi_staged256(f32x16 (&acc)[4][2], char* smem, F f) {
  float* st = (float*)smem;
  const int lane = threadIdx.x & 63, wid = threadIdx.x >> 6, wm = wid >> 1, wn = wid & 1, fr32 = lane & 31, fh = lane >> 5;
#pragma unroll
  for (int half = 0; half < 2; ++half) {
    if (wm == half) {
#pragma unroll
      for (int mi = 0; mi < 4; ++mi)
#pragma unroll
        for (int ni = 0; ni < 2; ++ni)
#pragma unroll
          for (int g = 0; g < 4; ++g)
            *(f32x4*)(st + (mi * 32 + fr32) * 132 + wn * 64 + ni * 32 + g * 8 + fh * 4) =
                f32x4{acc[mi][ni][g * 4 + 0], acc[mi][ni][g * 4 + 1], acc[mi][ni][g * 4 + 2], acc[mi][ni][g * 4 + 3]};
    }
    __syncthreads();
#pragma unroll 4
    for (int i = threadIdx.x; i < 128 * 32; i += NTHREADS) {
      const int row = i >> 5, c4 = (i & 31) << 2;
      const float4 v = *(const float4*)(st + row * 132 + c4);
      f(half * 128 + row, c4, v);
    }
    __syncthreads();
  }
}

__device__ __forceinline__ void transpose_tile(const float* __restrict__ W, int N, u16* __restrict__ Wt, int K, int k0, int n0, float* lds) {
  const int tid = threadIdx.x;
  __syncthreads();
#pragma unroll
  for (int i = 0; i < 16; ++i) {
    int k = i * 4 + (tid >> 6), n = tid & 63;
    lds[k * 65 + n] = W[(size_t)(k0 + k) * N + n0 + n];
  }
  __syncthreads();
#pragma unroll
  for (int i = 0; i < 16; ++i) {
    int n = i * 4 + (tid >> 6), k = tid & 63;
    Wt[(size_t)(n0 + n) * K + k0 + k] = f2bf(lds[k * 65 + n]);
  }
}

__device__ __forceinline__ void phase_prep(const Params& p, char* smem) {
  const int tid = threadIdx.x;
  float* lds = (float*)smem;
  u16* WIN = (u16*)(p.ws + OFF_WIN);
  u16* WOUT = (u16*)(p.ws + OFF_WOUT);
  u16* WLORA = (u16*)(p.ws + OFF_WLORA);
  u16* KEYS = (u16*)(p.ws + OFF_KEYS);
  float* MOD = (float*)(p.ws + OFF_MOD);
  constexpr int N_MOD = 96, N_T1 = 44 * 16, N_T2 = 16 * 16, N_T3 = 0;
  constexpr int N_TASK = N_MOD + N_T1 + N_T2 + N_T3;
  for (int task = blockIdx.x; task < N_TASK; task += gridDim.x) {
    if (task < N_MOD) {
      __syncthreads();
      for (int i = tid; i < 8 * 1024; i += NTHREADS) lds[i] = siluf_(p.c[i]);
      __syncthreads();
      const int lane = tid & 63, w = tid >> 6;
      const int col = task * 64 + lane;
      float a[8];
#pragma unroll
      for (int b = 0; b < 8; ++b) a[b] = 0.f;
      const float* wp = p.ada_w + (size_t)(w * 256) * 6144 + col;
#pragma unroll 8
      for (int k = 0; k < 256; ++k) {
        float wv = wp[(size_t)k * 6144];
#pragma unroll
        for (int b = 0; b < 8; ++b) a[b] += lds[b * 1024 + w * 256 + k] * wv;
      }
      __syncthreads();
#pragma unroll
      for (int b = 0; b < 8; ++b) lds[8192 + (w * 8 + b) * 64 + lane] = a[b];
      __syncthreads();
      for (int i = tid; i < 512; i += NTHREADS) {
        int b = i >> 6, l = i & 63;
        float s = lds[8192 + (0 * 8 + b) * 64 + l] + lds[8192 + (1 * 8 + b) * 64 + l] + lds[8192 + (2 * 8 + b) * 64 + l] +
                  lds[8192 + (3 * 8 + b) * 64 + l];
        MOD[b * 6144 + task * 64 + l] = s + p.ada_b[task * 64 + l];
      }
    } else {
      int t = task - N_MOD;
      if (t < N_T1) {
        transpose_tile(p.w_in, NPROJ, WIN, D, (t & 15) * 64, (t >> 4) * 64, lds);
      } else if (t < N_T1 + N_T2) {
        t -= N_T1;
        transpose_tile(p.w_out, D, WOUT, D, (t & 15) * 64, (t >> 4) * 64, lds);
      }
    }
  }
  const size_t gtid = (size_t)blockIdx.x * NTHREADS + tid, gn = (size_t)gridDim.x * NTHREADS;
  for (size_t i = gtid; i < (size_t)1536 * 256; i += gn) {
    int n = (int)(i >> 8), k = (int)(i & 255);
    float v = 0.f;
    if (n < 512) { if (k < 64) v = p.w2[k * 512 + n]; }
    else if (n < 1024) { if (k >= 64 && k < 128) v = p.a2[(k - 64) * 512 + (n - 512)]; }
    else { if (k >= 128) v = p.g2[(k - 128) * 512 + (n - 1024)]; }
    WLORA[i] = f2bf(v);
  }
  for (size_t i = gtid; i < (size_t)16 * 128 * 128; i += gn) KEYS[i] = f2bf(p.sub_keys[i]);
  {
    uint2* WQB = (uint2*)(p.ws + OFF_REGF);
    const float4* wq4 = (const float4*)p.w_q;
    for (size_t i = gtid; i < (size_t)1024 * 2048 / 4; i += gn) {
      const float4 v = wq4[i];
      WQB[i] = make_uint2(pack2(v.x, v.y), pack2(v.z, v.w));
    }
  }
}

__device__ __forceinline__ void phase_peer_fold(const Params& p, char* smem) {
  const u16* KEYS = (const u16*)(p.ws + OFF_KEYS);
  const u16* WQB = (const u16*)(p.ws + OFF_REGF);
  u16* MT = (u16*)(p.ws + OFF_WQ);
  for (int tile = blockIdx.x; tile < 16 * 8; tile += gridDim.x) {
    const int hp = tile >> 3, dt = tile & 7;
    f32x16 acc[2][2];
    gemm128(KEYS + (size_t)hp * 128 * 128, 128, WQB + hp * 128, 2048, 128, 0, dt * 128, smem, acc);
    epi_staged(acc, smem, [&](int row, int c4, float4 v) {
      *(uint2*)(MT + (size_t)(hp * 128 + row) * D + dt * 128 + c4) = make_uint2(pack2(v.x, v.y), pack2(v.z, v.w));
    });
  }
}

__device__ __forceinline__ void phase_normmod(const float* __restrict__ X, const float* __restrict__ g, const float* __restrict__ MOD,
                              int sh_off, int sc_off, u16* __restrict__ U) {
  const int lane = threadIdx.x & 63;
  const int gw = blockIdx.x * 4 + (threadIdx.x >> 6), nw = gridDim.x * 4;
  for (int t = gw; t < T; t += nw) {
    const int b = t / SEQ;
    const float4* xr = (const float4*)(X + (size_t)t * D);
    float4 v[4];
    float ss = 0.f;
#pragma unroll
    for (int i = 0; i < 4; ++i) {
      v[i] = xr[i * 64 + lane];
      ss += v[i].x * v[i].x + v[i].y * v[i].y + v[i].z * v[i].z + v[i].w * v[i].w;
    }
    ss = wave_sum(ss);
    const float rstd = rsqrtf(ss * (1.0f / D) + 1e-6f);
    const float4* gp = (const float4*)g;
    const float4* shp = (const float4*)(MOD + b * 6144 + sh_off);
    const float4* scp = (const float4*)(MOD + b * 6144 + sc_off);
    uint2* up = (uint2*)(U + (size_t)t * D);
#pragma unroll
    for (int i = 0; i < 4; ++i) {
      float4 gg = gp[i * 64 + lane], sh = shp[i * 64 + lane], sc = scp[i * 64 + lane];
      float o0 = v[i].x * rstd * gg.x * (1.f + sc.x) + sh.x;
      float o1 = v[i].y * rstd * gg.y * (1.f + sc.y) + sh.y;
      float o2 = v[i].z * rstd * gg.z * (1.f + sc.z) + sh.z;
      float o3 = v[i].w * rstd * gg.w * (1.f + sc.w) + sh.w;
      up[i * 64 + lane] = make_uint2(pack2(o0, o1), pack2(o2, o3));
    }
  }
}

__device__ __forceinline__ void phase_gemm_in(const Params& p, char* smem) {
  const u16* U1 = (const u16*)(p.ws + OFF_REGB);
  const u16* WIN = (const u16*)(p.ws + OFF_WIN);
  u16* P = (u16*)(p.ws + OFF_REGC);
  constexpr int NT = NPROJ / 128, MT = T / 256;
  for (int tile = blockIdx.x; tile < NT * MT; tile += gridDim.x) {
    const int mt = tile / NT, nt = tile % NT;
    f32x16 acc[4][2];
    gemm256(U1, D, WIN, D, D, mt * 256, nt * 128, smem, acc);
    epi_staged256(acc, smem, [&](int row, int c4, float4 v) {
      u16* dst = (nt < 8) ? (P + (size_t)(mt * 256 + row) * 1024 + nt * 128 + c4)
                          : (P + (size_t)32 * MB + (size_t)(mt * 256 + row) * 1792 + (nt - 8) * 128 + c4);
      *(uint2*)dst = make_uint2(pack2(v.x, v.y), pack2(v.z, v.w));
    });
  }
}

__device__ __forceinline__ void phase_act(const Params& p) {
  const u16* P = (const u16*)(p.ws + OFF_PR);
  u16* ACT = (u16*)(p.ws + OFF_REGF + 128 * MB);
  const size_t gtid = (size_t)blockIdx.x * NTHREADS + threadIdx.x, gn = (size_t)gridDim.x * NTHREADS;
  for (size_t i = gtid; i < (size_t)T * 64; i += gn) {
    const int t = (int)(i >> 6), c = (int)(i & 63) * 4;
    const u16* pr = P + (size_t)t * 1792 + 1536 + c;
    uint2 cur = *(const uint2*)pr;
    uint2 prv = make_uint2(0u, 0u);
    if ((t % SEQ) != 0) prv = *(const uint2*)(pr - 1792);
    float4 m = *(const float4*)(p.mu + 1536 + c);
    float x0 = bflo(cur.x), x1 = bfhi(cur.x), x2 = bflo(cur.y), x3 = bfhi(cur.y);
    x0 += m.x * (bflo(prv.x) - x0);
    x1 += m.y * (bfhi(prv.x) - x1);
    x2 += m.z * (bflo(prv.y) - x2);
    x3 += m.w * (bfhi(prv.y) - x3);
    if (c < 64) { x0 = tanhf(x0); x1 = tanhf(x1); x2 = tanhf(x2); x3 = tanhf(x3); }
    else if (c >= 128) { x0 = sigmoidf_(x0); x1 = sigmoidf_(x1); x2 = sigmoidf_(x2); x3 = sigmoidf_(x3); }
    *(uint2*)(ACT + (size_t)t * 256 + c) = make_uint2(pack2(x0, x1), pack2(x2, x3));
  }
}

__device__ __forceinline__ void conv_tile(const Params& p, int tile, char* smem) {
  const u16* P = (const u16*)(p.ws + OFF_PC);
  u16* MIXIN = (u16*)(p.ws + OFF_REGB);
  const int tid = threadIdx.x, lane = tid & 63, wid = tid >> 6;
  u32* ylds = (u32*)smem;
  float* olds = (float*)(smem + 62 * 1024);
  const int tok0 = tile * 32;
  const int s0 = tok0 % SEQ;
  __syncthreads();
  for (int r = 0; r < 62; ++r) {
    const int s = s0 - 30 + r;
    u32 val = 0u;
    if (s >= 0) {
      const u16* pr = P + (size_t)(tok0 - 30 + r) * 1024;
      u32 a = *(const u32*)(pr + 2 * tid);
      u32 bq = *(const u32*)(pr + 512 + 2 * tid);
      val = pack2(bflo(a) * sigmoidf_(bflo(bq)), bfhi(a) * sigmoidf_(bfhi(bq)));
    }
    ylds[r * 256 + tid] = val;
  }
  __syncthreads();
  float w0[31], w1[31];
#pragma unroll
  for (int j = 0; j < 31; ++j) {
    const float2 wv = *(const float2*)(p.conv_w + j * 512 + 2 * tid);
    w0[j] = wv.x; w1[j] = wv.y;
  }
  const float2 bias = *(const float2*)(p.conv_b + 2 * tid);
  for (int sub = 0; sub < 4; ++sub) {
    float a0[8], a1[8];
#pragma unroll
    for (int q = 0; q < 8; ++q) { a0[q] = bias.x; a1[q] = bias.y; }
#pragma unroll
    for (int rr = 0; rr < 38; ++rr) {
      const u32 yv = ylds[(sub * 8 + rr) * 256 + tid];
      const float y0 = bflo(yv), y1 = bfhi(yv);
#pragma unroll
      for (int q = 0; q < 8; ++q) {
        const int j = rr - q;
        if (j >= 0 && j < 31) { a0[q] += w0[j] * y0; a1[q] += w1[j] * y1; }
      }
    }
#pragma unroll
    for (int q = 0; q < 8; ++q) *(float2*)(olds + q * 512 + 2 * tid) = make_float2(a0[q], a1[q]);
    __syncthreads();
#pragma unroll
    for (int q2 = 0; q2 < 2; ++q2) {
      const int q = wid * 2 + q2;
      const float4 va = *(const float4*)(olds + q * 512 + lane * 8);
      const float4 vb = *(const float4*)(olds + q * 512 + lane * 8 + 4);
      float s = va.x + va.y + va.z + va.w + vb.x + vb.y + vb.z + vb.w;
      s = wave_sum(s);
      const float mean = s * (1.0f / 512.f);
      float d[8] = {va.x - mean, va.y - mean, va.z - mean, va.w - mean, vb.x - mean, vb.y - mean, vb.z - mean, vb.w - mean};
      float vs = 0.f;
#pragma unroll
      for (int e = 0; e < 8; ++e) vs += d[e] * d[e];
      vs = wave_sum(vs);
      const float rstd = rsqrtf(vs * (1.0f / 512.f) + 1e-5f);
      const float4 lw0 = *(const float4*)(p.ln_w + lane * 8), lw1 = *(const float4*)(p.ln_w + lane * 8 + 4);
      const float4 lb0 = *(const float4*)(p.ln_b + lane * 8), lb1 = *(const float4*)(p.ln_b + lane * 8 + 4);
      const float lw[8] = {lw0.x, lw0.y, lw0.z, lw0.w, lw1.x, lw1.y, lw1.z, lw1.w};
      const float lb[8] = {lb0.x, lb0.y, lb0.z, lb0.w, lb1.x, lb1.y, lb1.z, lb1.w};
      float o[8];
#pragma unroll
      for (int e = 0; e < 8; ++e) o[e] = siluf_(d[e] * rstd * lw[e] + lb[e]);
      uint4 pk = make_uint4(pack2(o[0], o[1]), pack2(o[2], o[3]), pack2(o[4], o[5]), pack2(o[6], o[7]));
      *(uint4*)(MIXIN + (size_t)(tok0 + sub * 8 + q) * D + lane * 8) = pk;
    }
    __syncthreads();
  }
}

__device__ __forceinline__ void phase_lora_conv(const Params& p, char* smem) {
  const u16* ACT = (const u16*)(p.ws + OFF_REGF + 128 * MB);
  const u16* WLORA = (const u16*)(p.ws + OFF_WLORA);
  u16* LW = (u16*)(p.ws + OFF_REGF);
  u16* AA = (u16*)(p.ws + OFF_REGD);
  u16* GG = (u16*)(p.ws + OFF_REGD + 32 * MB);
  constexpr int NT = 12, MT = T / 128, NG = NT * MT, NC = T / 32;
  for (int task = blockIdx.x; task < NG; task += gridDim.x) {
    {
      const int mt = task / NT, nt = task % NT;
      f32x16 acc[2][2];
      gemm128d(ACT, 256, WLORA, 256, 256, mt * 128, nt * 128, smem, acc);
      if (nt < 4) {
        epi_staged(acc, smem, [&](int row, int c4, float4 v) {
          const int n = nt * 128 + c4;
          const float4 w0 = *(const float4*)(p.w0 + n);
          const float vv[4] = {v.x + w0.x, v.y + w0.y, v.z + w0.z, v.w + w0.w};
          float o[4];
#pragma unroll
          for (int e = 0; e < 4; ++e) {
            const float z = -vv[e];
            const float sp = fmaxf(z, 0.f) + log1pf(__expf(-fabsf(z)));
            o[e] = -__expf(-sp - 0.5f);
          }
          *(uint2*)(LW + (size_t)(mt * 128 + row) * 512 + n) = make_uint2(pack2(o[0], o[1]), pack2(o[2], o[3]));
        });
      } else if (nt < 8) {
        epi_staged(acc, smem, [&](int row, int c4, float4 v) {
          const int n = (nt - 4) * 128 + c4;
          const float4 a0 = *(const float4*)(p.a0 + n);
          *(uint2*)(AA + (size_t)(mt * 128 + row) * 512 + n) =
              make_uint2(pack2(sigmoidf_(a0.x + v.x), sigmoidf_(a0.y + v.y)), pack2(sigmoidf_(a0.z + v.z), sigmoidf_(a0.w + v.w)));
        });
      } else {
        epi_staged(acc, smem, [&](int row, int c4, float4 v) {
          const int n = (nt - 8) * 128 + c4;
          *(uint2*)(GG + (size_t)(mt * 128 + row) * 512 + n) = make_uint2(pack2(v.x, v.y), pack2(v.z, v.w));
        });
      }
    }
  }
}

__device__ __forceinline__ void phase_scanprep(const Params& p) {
  const u16* P = (const u16*)(p.ws + OFF_PR);
  const u16* AA = (const u16*)(p.ws + OFF_REGD);
  u16* R = (u16*)(p.ws + OFF_REGF + 32 * MB);
  u16* KM = (u16*)(p.ws + OFF_REGF + 64 * MB);
  u16* V = (u16*)(p.ws + OFF_REGF + 96 * MB);
  u16* KKN = (u16*)(p.ws + OFF_REGF + 128 * MB);
  float* BONUS = (float*)(p.ws + OFF_BONUS);
  const int tid = threadIdx.x;
  const int c = (tid & 127) * 4;
  const float4 mur = *(const float4*)(p.mu + c), muk = *(const float4*)(p.mu + 512 + c), muv = *(const float4*)(p.mu + 1024 + c);
  const float4 kk_ = *(const float4*)(p.k_k + c), ka_ = *(const float4*)(p.k_a + c), rk_ = *(const float4*)(p.r_k + c);
  for (int tp = blockIdx.x; tp < T / 2; tp += gridDim.x) {
    const int t = tp * 2 + (tid >> 7);
    const bool first = (t % SEQ) == 0;
    const u16* pr = P + (size_t)t * 1792 + c;
    float r[4], k[4], v[4];
    {
      uint2 cu = *(const uint2*)pr, pv = first ? make_uint2(0u, 0u) : *(const uint2*)(pr - 1792);
      r[0] = bflo(cu.x); r[1] = bfhi(cu.x); r[2] = bflo(cu.y); r[3] = bfhi(cu.y);
      r[0] += mur.x * (bflo(pv.x) - r[0]); r[1] += mur.y * (bfhi(pv.x) - r[1]);
      r[2] += mur.z * (bflo(pv.y) - r[2]); r[3] += mur.w * (bfhi(pv.y) - r[3]);
    }
    {
      uint2 cu = *(const uint2*)(pr + 512), pv = first ? make_uint2(0u, 0u) : *(const uint2*)(pr + 512 - 1792);
      k[0] = bflo(cu.x); k[1] = bfhi(cu.x); k[2] = bflo(cu.y); k[3] = bfhi(cu.y);
      k[0] += muk.x * (bflo(pv.x) - k[0]); k[1] += muk.y * (bfhi(pv.x) - k[1]);
      k[2] += muk.z * (bflo(pv.y) - k[2]); k[3] += muk.w * (bfhi(pv.y) - k[3]);
    }
    {
      uint2 cu = *(const uint2*)(pr + 1024), pv = first ? make_uint2(0u, 0u) : *(const uint2*)(pr + 1024 - 1792);
      v[0] = bflo(cu.x); v[1] = bfhi(cu.x); v[2] = bflo(cu.y); v[3] = bfhi(cu.y);
      v[0] += muv.x * (bflo(pv.x) - v[0]); v[1] += muv.y * (bfhi(pv.x) - v[1]);
      v[2] += muv.z * (bflo(pv.y) - v[2]); v[3] += muv.w * (bfhi(pv.y) - v[3]);
    }
    const uint2 au = *(const uint2*)(AA + (size_t)t * 512 + c);
    const float a[4] = {bflo(au.x), bfhi(au.x), bflo(au.y), bfhi(au.y)};
    const float kkc[4] = {kk_.x, kk_.y, kk_.z, kk_.w}, kac[4] = {ka_.x, ka_.y, ka_.z, ka_.w}, rkc[4] = {rk_.x, rk_.y, rk_.z, rk_.w};
    float kk[4], km[4];
    float n2 = 0.f, bs = 0.f;
#pragma unroll
    for (int e = 0; e < 4; ++e) {
      kk[e] = k[e] * kkc[e];
      km[e] = k[e] * (1.f + (a[e] - 1.f) * kac[e]);
      n2 += kk[e] * kk[e];
      bs += r[e] * km[e] * rkc[e];
    }
    n2 = row16_sum(n2);
    bs = row16_sum(bs);
    const float inv = 1.0f / fmaxf(sqrtf(n2), 1e-12f);
    const size_t o = (size_t)t * 512 + c;
    *(uint2*)(R + o) = make_uint2(pack2(r[0], r[1]), pack2(r[2], r[3]));
    *(uint2*)(KM + o) = make_uint2(pack2(km[0], km[1]), pack2(km[2], km[3]));
    *(uint2*)(V + o) = make_uint2(pack2(v[0], v[1]), pack2(v[2], v[3]));
    *(uint2*)(KKN + o) = make_uint2(pack2(kk[0] * inv, kk[1] * inv), pack2(kk[2] * inv, kk[3] * inv));
    if ((tid & 15) == 0) BONUS[(size_t)t * 8 + (c >> 6)] = bs;
  }
}

constexpr size_t OFF_EU8 = OFF_REGC + 128 * MB;
constexpr size_t OFF_EV8 = OFF_REGC + 144 * MB;
constexpr int CVT_CHUNKS = 256;
__device__ __forceinline__ void cvt_chunk(const Params& p, int chunk) {
  u32* EU = (u32*)(p.ws + OFF_EU8);
  u32* EV = (u32*)(p.ws + OFF_EV8);
  const float4* su = (const float4*)p.peer_u;
  const float4* sv = (const float4*)p.peer_v;
  const size_t base = (size_t)chunk * 16384;
#pragma unroll 4
  for (int q = 0; q < 64; ++q) {
    const size_t i = base + q * 256 + threadIdx.x;
    const float4 a = su[i], b = sv[i];
    int va = 0, vb = 0;
    va = __builtin_amdgcn_cvt_pk_fp8_f32(a.x * 512.f, a.y * 512.f, va, false);
    va = __builtin_amdgcn_cvt_pk_fp8_f32(a.z * 512.f, a.w * 512.f, va, true);
    vb = __builtin_amdgcn_cvt_pk_fp8_f32(b.x * 128.f, b.y * 128.f, vb, false);
    vb = __builtin_amdgcn_cvt_pk_fp8_f32(b.z * 128.f, b.w * 128.f, vb, true);
    EU[i] = (u32)va;
    EV[i] = (u32)vb;
  }
}

__device__ __forceinline__ void mix_unit(const Params& p, int u, char* smem) {
  for (int ci = 0; ci < 4; ++ci) conv_tile(p, u * 4 + ci, smem);
}

template <int OFF>
__device__ __forceinline__ f32x4 lds_ld4(unsigned addr) {
  f32x4 r;
  asm volatile("ds_read_b128 %0, %1 offset:%2" : "=v"(r) : "v"(addr), "n"(OFF));
  return r;
}
template <int OFF>
__device__ __forceinline__ float lds_ld1(unsigned addr) {
  float r;
  asm volatile("ds_read_b32 %0, %1 offset:%2" : "=v"(r) : "v"(addr), "n"(OFF));
  return r;
}
constexpr int SC_BUF = 27648;
template <int OFF>
__device__ __forceinline__ v2f lds_ld2(unsigned addr) {
  v2f r;
  asm volatile("ds_read_b64 %0, %1 offset:%2" : "=v"(r) : "v"(addr), "n"(OFF));
  return r;
}
__device__ __forceinline__ void phase_scan(const Params& p, char* smem, int rep) {
  const u16* LW = (const u16*)(p.ws + OFF_REGF);
  const u16* R = (const u16*)(p.ws + OFF_REGF + 32 * MB);
  const u16* KM = (const u16*)(p.ws + OFF_REGF + 64 * MB);
  const u16* V = (const u16*)(p.ws + OFF_REGF + 96 * MB);
  const u16* KKN = (const u16*)(p.ws + OFF_REGF + 128 * MB);
  const u16* AA = (const u16*)(p.ws + OFF_REGD);
  float* Y = (float*)(p.ws + OFF_Y);
  const int tid = threadIdx.x, lane = tid & 63, w = tid >> 6;
  const int jl = lane & 15;
  const int ss = tid >> 4, sg = tid & 15;
  unsigned* claim = (unsigned*)(p.ws + OFF_BAR) + XCD_BAR_WORDS + rep * (2048 + 64);
  unsigned* qctr = claim + 2048;
  int* sflag = (int*)(smem + 2 * SC_BUF);
  float* ypw = (float*)(smem + 56320) + w * 1024;
  const unsigned sbase = (unsigned)(size_t)(LAS char*)smem;
  if (tid == 0) {
    const unsigned key = (xb_xcc_id() & 7u) * 256u + (((unsigned)__builtin_amdgcn_s_getreg(63492) >> 8) & 0xffu);
    sflag[0] = (atomicAdd(&claim[key], 1u) == 0u) ? 1 : 0;
  }
  __syncthreads();
  const bool scan_role = sflag[0] != 0;
  for (;;) {
    if (!scan_role) break;
    __syncthreads();
    if (tid == 0) sflag[1] = (int)atomicAdd(&qctr[0], 1u);
    __syncthreads();
    const int task = sflag[1];
    if (task >= 256) break;
    const int bh = task >> 2, rg = task & 3, b = bh >> 3, h = bh & 7;
    const int il = rg * 16 + w * 4 + (lane >> 4);
    v2f Sa = v2f{0.f, 0.f}, Sb = v2f{0.f, 0.f};
    const size_t base = (size_t)b * SEQ * 512 + h * 64 + sg * 4;
    uint2 gA_lw, gA_r, gA_km, gA_v, gA_kkn, gA_a;
    uint2 gB_lw, gB_r, gB_km, gB_v, gB_kkn, gB_a;
#define SC_GLOAD(X, t0)                                      \
  {                                                          \
    const size_t o = base + (size_t)((t0) + ss) * 512;       \
    X##_lw = *(const uint2*)(LW + o); X##_r = *(const uint2*)(R + o);   \
    X##_km = *(const uint2*)(KM + o); X##_v = *(const uint2*)(V + o);   \
    X##_kkn = *(const uint2*)(KKN + o); X##_a = *(const uint2*)(AA + o); \
  }
#define SC_STORE(X, bi)                                                                                \
  {                                                                                                    \
    float* d = (float*)(smem + (bi) * SC_BUF) + ss * 64 + sg * 4;                                      \
    const float4 kq = make_float4(bflo(X##_kkn.x), bfhi(X##_kkn.x), bflo(X##_kkn.y), bfhi(X##_kkn.y)); \
    *(float4*)(d) = make_float4(__expf(bflo(X##_lw.x)), __expf(bfhi(X##_lw.x)), __expf(bflo(X##_lw.y)), __expf(bfhi(X##_lw.y))); \
    *(float4*)(d + 1024) = kq;                                                                         \
    *(float4*)(d + 2048) = make_float4(kq.x * bflo(X##_a.x), kq.y * bfhi(X##_a.x), kq.z * bflo(X##_a.y), kq.w * bfhi(X##_a.y)); \
    *(float4*)(d + 3072) = make_float4(bflo(X##_km.x), bfhi(X##_km.x), bflo(X##_km.y), bfhi(X##_km.y)); \
    *(float4*)(d + 4096) = make_float4(bflo(X##_r.x), bfhi(X##_r.x), bflo(X##_r.y), bfhi(X##_r.y));    \
    float* vt = (float*)(smem + (bi) * SC_BUF) + 5120 + (sg * 4) * 16 + ss;     \
    vt[0] = bflo(X##_v.x); vt[16] = bfhi(X##_v.x); vt[32] = bflo(X##_v.y); vt[48] = bfhi(X##_v.y);     \
  }
#define SC_ISSUE(sl, S)                                     \
  {                                                         \
    dec_[sl] = lds_ld4<(S) * 256>(a0);                      \
    kkn_[sl] = lds_ld4<4096 + (S) * 256>(a0);               \
    km_[sl] = lds_ld4<12288 + (S) * 256>(a0);               \
    if (((S) & 3) == 0) vq_[((S) >> 2) & 1] = lds_ld4<20480 + (S) * 4>(a1); \
    nb_[sl] = lds_ld4<8192 + (S) * 256>(a0);                \
    rr_[sl] = lds_ld4<16384 + (S) * 256>(a0);               \
  }
#define SC_WAIT(N, sl)                                                                          \
  asm volatile("s_waitcnt lgkmcnt(" #N ")"                                                      \
               : "+v"(dec_[sl]), "+v"(kkn_[sl]), "+v"(nb_[sl]), "+v"(km_[sl]), "+v"(rr_[sl]), "+v"(vq_[0]), "+v"(vq_[1]));
#define LO2(q) (v2f{(q).x, (q).y})
#define HI2(q) (v2f{(q).z, (q).w})
#define SC_STEP(S, N)                                                                       \
  {                                                                                         \
    if ((S) + 2 < 16) SC_ISSUE(((S) + 2) % 3, (S) + 2)                                      \
    SC_WAIT(N, (S) % 3)                                                                     \
    const f32x4 dec = dec_[(S) % 3], kkn = kkn_[(S) % 3], nb = nb_[(S) % 3], km = km_[(S) % 3], rr = rr_[(S) % 3]; \
    const float vv = vq_[((S) >> 2) & 1][(S) & 3];                                          \
    const v2f v2 = v2f{vv, vv};                                                             \
    const v2f Ta = Sa * LO2(dec) + v2 * LO2(km);                                            \
    const v2f Tb = Sb * HI2(dec) + v2 * HI2(km);                                            \
    const v2f dv = Sa * LO2(kkn) + Sb * HI2(kkn);                                           \
    float dot = dv.x + dv.y;                                                                \
    if ((S) > 0) {     \
      dot += DPP_ROR(dot, 8); ypend += DPP_ROR(ypend, 8);                                   \
      dot += DPP_ROR(dot, 4); ypend += DPP_ROR(ypend, 4);                                   \
      dot += DPP_ROR(dot, 2); ypend += DPP_ROR(ypend, 2);                                   \
      dot += DPP_ROR(dot, 1); ypend += DPP_ROR(ypend, 1);                                   \
      ykeep = (jl == (S) - 1) ? ypend : ykeep;                                              \
    } else {                                                                                \
      dot = row16_sum(dot);                                                                 \
    }                                                                                       \
    const v2f d2 = v2f{dot, dot};                                                           \
    Sa = Ta - d2 * LO2(nb);                                                                 \
    Sb = Tb - d2 * HI2(nb);                                                                 \
    const v2f yv = Sa * LO2(rr) + Sb * HI2(rr);                                             \
    ypend = yv.x + yv.y;                                                                    \
    if ((S) == 15) { ypend = row16_sum(ypend); ykeep = (jl == 15) ? ypend : ykeep; }        \
  }
#define SC_COMPUTE(c)                                                                       \
  {                                                                                         \
    const unsigned a0 = sbase + (unsigned)(((c) & 1) * SC_BUF + jl * 16);                   \
    const unsigned a1 = sbase + (unsigned)(((c) & 1) * SC_BUF + il * 64);                   \
    f32x4 dec_[3], kkn_[3], nb_[3], km_[3], rr_[3], vq_[2];                                 \
    float ykeep = 0.f, ypend = 0.f;                                                         \
    SC_ISSUE(0, 0)                                                                          \
    SC_ISSUE(1, 1)                                                                          \
    SC_STEP(0, 10) SC_STEP(1, 10) SC_STEP(2, 10) SC_STEP(3, 10) SC_STEP(4, 10) SC_STEP(5, 10) SC_STEP(6, 10) SC_STEP(7, 10) \
    SC_STEP(8, 10) SC_STEP(9, 10) SC_STEP(10, 10) SC_STEP(11, 10) SC_STEP(12, 10) SC_STEP(13, 10) SC_STEP(14, 5) SC_STEP(15, 0) \
    yp[(size_t)((c) * 16 + jl) * 512] = ykeep;                                              \
  }
    constexpr int NCH = SEQ / 16;
    float* yp = Y + (size_t)b * SEQ * 512 + h * 64 + il;
    __syncthreads();
    SC_GLOAD(gA, 0);
    SC_STORE(gA, 0);
    SC_GLOAD(gA, 16);
    SC_GLOAD(gB, 32);
    __syncthreads();
    for (int c = 0; c < NCH; c += 2) {
      SC_COMPUTE(c)
      SC_STORE(gA, 1)
      if (c + 3 < NCH) SC_GLOAD(gA, (c + 3) * 16);
      asm volatile("s_waitcnt lgkmcnt(0)\n\ts_barrier" ::: "memory");
      SC_COMPUTE(c + 1)
      if (c + 2 < NCH) {
        SC_STORE(gB, 0)
        if (c + 4 < NCH) SC_GLOAD(gB, (c + 4) * 16);
      }
      asm volatile("s_waitcnt lgkmcnt(0)\n\ts_barrier" ::: "memory");
    }
  }
  for (;;) {
    __syncthreads();
    if (tid == 0) sflag[3] = (int)atomicAdd(&qctr[32], 1u);
    __syncthreads();
    const int u = sflag[3];
    __syncthreads();
    if (u >= T / 128) break;
    mix_unit(p, u, smem);
  }
  for (;;) {
    __syncthreads();
    if (tid == 0) sflag[2] = (int)atomicAdd(&qctr[16], 1u);
    __syncthreads();
    const int ch = sflag[2];
    if (ch >= CVT_CHUNKS) break;
    cvt_chunk(p, ch);
  }
}

__device__ __forceinline__ void phase_post(const Params& p) {
  const float* Y = (const float*)(p.ws + OFF_Y);
  const u16* V = (const u16*)(p.ws + OFF_REGF + 96 * MB);
  const u16* GG = (const u16*)(p.ws + OFF_REGD + 32 * MB);
  const float* BONUS = (const float*)(p.ws + OFF_BONUS);
  u16* MIXIN = (u16*)(p.ws + OFF_REGB);
  const int tid = threadIdx.x;
  const int c = (tid & 127) * 4;
  const float4 gw = *(const float4*)(p.gn_w + c), gb = *(const float4*)(p.gn_b + c);
  for (int tp = blockIdx.x; tp < T / 2; tp += gridDim.x) {
    const int t = tp * 2 + (tid >> 7);
    const size_t o = (size_t)t * 512 + c;
    const float4 y = *(const float4*)(Y + o);
    float s = row16_sum(y.x + y.y + y.z + y.w);
    const float mean = s * (1.f / 64.f);
    const float d0 = y.x - mean, d1 = y.y - mean, d2 = y.z - mean, d3 = y.w - mean;
    const float var = row16_sum(d0 * d0 + d1 * d1 + d2 * d2 + d3 * d3) * (1.f / 64.f);
    const float rstd = rsqrtf(var + 64e-5f);
    const float bon = BONUS[(size_t)t * 8 + (c >> 6)];
    const uint2 vu = *(const uint2*)(V + o), gu = *(const uint2*)(GG + o);
    const float o0 = (d0 * rstd * gw.x + gb.x + bon * bflo(vu.x)) * bflo(gu.x);
    const float o1 = (d1 * rstd * gw.y + gb.y + bon * bfhi(vu.x)) * bfhi(gu.x);
    const float o2 = (d2 * rstd * gw.z + gb.z + bon * bflo(vu.y)) * bflo(gu.y);
    const float o3 = (d3 * rstd * gw.w + gb.w + bon * bfhi(vu.y)) * bfhi(gu.y);
    *(uint2*)(MIXIN + (size_t)t * D + 512 + c) = make_uint2(pack2(o0, o1), pack2(o2, o3));
  }
}

__device__ __forceinline__ void phase_gemm_out(const Params& p, char* smem) {
  const u16* MIXIN = (const u16*)(p.ws + OFF_REGB);
  const u16* WOUT = (const u16*)(p.ws + OFF_WOUT);
  const float* MOD = (const float*)(p.ws + OFF_MOD);
  constexpr int NT = D / 128, MT = T / 128;
  for (int tile = blockIdx.x; tile < NT * MT; tile += gridDim.x) {
    const int mt = tile / NT, nt = tile % NT;
    f32x16 acc[2][2];
    gemm128d(MIXIN, D, WOUT, D, D, mt * 128, nt * 128, smem, acc);
    const int b = (mt * 128) / SEQ;
    const float* gt = MOD + b * 6144 + 2048 + nt * 128;
    epi_staged(acc, smem, [&](int row, int c4, float4 v) {
      const size_t o = (size_t)(mt * 128 + row) * D + nt * 128 + c4;
      const float4 xv = *(const float4*)(p.x + o);
      const float4 g = *(const float4*)(gt + c4);
      *(float4*)(p.out + o) = make_float4(xv.x + g.x * v.x, xv.y + g.y * v.y, xv.z + g.z * v.z, xv.w + g.w * v.w);
    });
  }
}

__device__ __forceinline__ u32 f2ord(float f) {
  u32 u = __float_as_uint(f);
  return (u & 0x80000000u) ? ~u : (u | 0x80000000u);
}
__device__ __forceinline__ float ord2f(u32 u) {
  u = (u & 0x80000000u) ? (u & 0x7FFFFFFFu) : ~u;
  return __uint_as_float(u);
}
#define TOPK_INSERT(L, x)                       \
  {                                             \
    u32 _x = (x);                               \
    _Pragma("unroll") for (int _i = 0; _i < 16; ++_i) { \
      u32 _hi = max(L[_i], _x);                 \
      _x = min(L[_i], _x);                      \
      L[_i] = _hi;                              \
    }                                           \
  }

#define CMPEX_DESC(a, b) { const u32 _hi = max(a, b); const u32 _lo = min(a, b); a = _hi; b = _lo; }
__device__ __forceinline__ void sort16_desc(u32 (&v)[16]) {
#pragma unroll
  for (int k = 2; k <= 16; k <<= 1) {
#pragma unroll
    for (int j = k >> 1; j > 0; j >>= 1) {
#pragma unroll
      for (int i = 0; i < 16; ++i) {
        const int l = i ^ j;
        if (l > i) {
          if ((i & k) == 0) CMPEX_DESC(v[i], v[l]) else CMPEX_DESC(v[l], v[i])
        }
      }
    }
  }
}
__device__ __forceinline__ void merge16_desc(u32 (&a)[16], const u32 (&b)[16]) {
#pragma unroll
  for (int i = 0; i < 16; ++i) a[i] = max(a[i], b[15 - i]);
#pragma unroll
  for (int j = 8; j > 0; j >>= 1) {
#pragma unroll
    for (int i = 0; i < 16; ++i) {
      const int l = i ^ j;
      if (l > i) CMPEX_DESC(a[i], a[l])
    }
  }
}

__device__ __forceinline__ void phase_peer_route(const Params& p, char* smem) {
  const u16* U2 = (const u16*)(p.ws + OFF_REGB);
  const u16* WQ = (const u16*)(p.ws + OFF_WQ);
  const u16* KEYS = (const u16*)(p.ws + OFF_KEYS);
  int* EXPID = (int*)(p.ws + OFF_EXPID);
  float* GATE = (float*)(p.ws + OFF_GATE);
  const int tid = threadIdx.x, lane = tid & 63, wid = tid >> 6, wm = wid >> 1, wn = wid & 1, fr = lane & 15, fq = lane >> 4;
  constexpr int QROWB = 272;
  char* qs = smem;
  char* ks = smem + 128 * QROWB;
  float* sT = (float*)smem;
  for (int task = blockIdx.x; task < (T / 128) * PEER_H; task += gridDim.x) {
    const int mt = task / PEER_H, h = task % PEER_H;
    u32 L0[16], L1[16];
#pragma unroll
    for (int pp = 0; pp < 2; ++pp) {
      f32x16 sc[2][2];
      gemm128<false>(U2, D, WQ, D, D, mt * 128, h * 256 + pp * 128, smem, sc);
      {
        const int fr32 = lane & 31, fh = lane >> 5;
#pragma unroll
        for (int mi = 0; mi < 2; ++mi)
#pragma unroll
          for (int ni = 0; ni < 2; ++ni)
#pragma unroll
            for (int g = 0; g < 4; ++g)
              *(f32x4*)(sT + (wn * 64 + ni * 32 + fr32) * 132 + wm * 64 + mi * 32 + g * 8 + fh * 4) =
                  f32x4{sc[mi][ni][g * 4 + 0], sc[mi][ni][g * 4 + 1], sc[mi][ni][g * 4 + 2], sc[mi][ni][g * 4 + 3]};
      }
      __syncthreads();
      {
        const int trow = tid & 127, half = tid >> 7;
        u32 L[16];
#pragma unroll
        for (int i = 0; i < 16; ++i) L[i] = 0u;
#pragma unroll 1
        for (int g = 0; g < 4; ++g) {
          u32 grp[16];
          const int kb = half * 64 + g * 16;
#pragma unroll
          for (int i = 0; i < 16; ++i) grp[i] = (f2ord(sT[(kb + i) * 132 + trow]) & ~0x7Fu) | (u32)(127 - kb - i);
          sort16_desc(grp);
          merge16_desc(L, grp);
        }
        __syncthreads();
        u32* xl = (u32*)smem;
        if (half == 1) {
#pragma unroll
          for (int i = 0; i < 16; ++i) xl[trow * 17 + i] = L[i];
        }
        __syncthreads();
        if (half == 0) {
          u32 oth[16];
#pragma unroll
          for (int i = 0; i < 16; ++i) oth[i] = xl[trow * 17 + i];
          merge16_desc(L, oth);
#pragma unroll
          for (int i = 0; i < 16; ++i) {
            if (pp == 0) L0[i] = L[i]; else L1[i] = L[i];
          }
        }
      }
      __syncthreads();
    }
    if (tid < 128) {
      float s0[16], s1[16];
#pragma unroll
      for (int i = 0; i < 16; ++i) {
        s0[i] = ord2f(L0[i] & ~0x7Fu);
        s1[i] = ord2f(L1[i] & ~0x7Fu);
      }
#define CKEY(i, j) ((f2ord(s0[i] + s1[j]) & ~0xFFu) | (u32)(255 - ((i) * 16 + (j))))
      u32 B[16], Bk[16], Ck[16], Dk[16];
#pragma unroll
      for (int j = 0; j < 16; ++j) B[j] = CKEY(0, j);
#pragma unroll
      for (int j = 0; j < 8; ++j) Bk[j] = CKEY(1, j);
#pragma unroll
      for (int j = 0; j < 5; ++j) Bk[8 + j] = CKEY(2, j);
#pragma unroll
      for (int j = 0; j < 3; ++j) Bk[13 + j] = CKEY(4, j);
#pragma unroll
      for (int j = 0; j < 4; ++j) Ck[j] = CKEY(3, j);
#pragma unroll
      for (int j = 0; j < 2; ++j) { Ck[4 + j] = CKEY(5, j); Ck[6 + j] = CKEY(6, j); Ck[8 + j] = CKEY(7, j); }
#pragma unroll
      for (int i = 8; i < 14; ++i) Ck[10 + (i - 8)] = CKEY(i, 0);
      {
        const u32 d14 = CKEY(14, 0), d15 = CKEY(15, 0);
        Dk[0] = max(d14, d15);
        Dk[1] = min(d14, d15);
#pragma unroll
        for (int i = 2; i < 16; ++i) Dk[i] = 0u;
      }
#undef CKEY
      sort16_desc(Bk);
      sort16_desc(Ck);
      merge16_desc(B, Bk);
      merge16_desc(B, Ck);
      merge16_desc(B, Dk);
      float bv[16];
      int eid[16];
#pragma unroll
      for (int q = 0; q < 16; ++q) {
        const int pos = 255 - (int)(B[q] & 0xFFu);
        const int i = pos >> 4, j = pos & 15;
        u32 a = 0u, bq = 0u;
#pragma unroll
        for (int z = 0; z < 16; ++z) {
          a = (z == i) ? L0[z] : a;
          bq = (z == j) ? L1[z] : bq;
        }
        const int i0 = 127 - (int)(a & 0x7Fu), i1 = 127 - (int)(bq & 0x7Fu);
        eid[q] = i0 * NKEYS + i1;
        bv[q] = ord2f(a & ~0x7Fu) + ord2f(bq & ~0x7Fu);
      }
      float mx = bv[0];
#pragma unroll
      for (int q = 1; q < 16; ++q) mx = fmaxf(mx, bv[q]);
      float den = 0.f;
#pragma unroll
      for (int q = 0; q < 16; ++q) { bv[q] = __expf(bv[q] - mx); den += bv[q]; }
      const float rden = 1.0f / den;
      const size_t o = ((size_t)(mt * 128 + tid) * PEER_H + h) * 16;
#pragma unroll
      for (int q = 0; q < 16; q += 4) {
        *(int4*)(EXPID + o + q) = make_int4(eid[q], eid[q + 1], eid[q + 2], eid[q + 3]);
        *(float4*)(GATE + o + q) = make_float4(bv[q] * rden, bv[q + 1] * rden, bv[q + 2] * rden, bv[q + 3] * rden);
      }
    }
  }
}

#define CVT_LO(w) __builtin_amdgcn_cvt_pk_f32_fp8((int)(w), false)
#define CVT_HI(w) __builtin_amdgcn_cvt_pk_f32_fp8((int)(w), true)
__device__ __forceinline__ void phase_peer_gather(const Params& p) {
  const u16* U2 = (const u16*)(p.ws + OFF_REGB);
  const uint4* EU = (const uint4*)(p.ws + OFF_EU8);
  const uint4* EV = (const uint4*)(p.ws + OFF_EV8);
  const int* EXPID = (const int*)(p.ws + OFF_EXPID);
  const float* GATE = (const float*)(p.ws + OFF_GATE);
  const float* MOD = (const float*)(p.ws + OFF_MOD);
  const int lane = threadIdx.x & 63;
  const int gw = blockIdx.x * 4 + (threadIdx.x >> 6), nw = gridDim.x * 4;
  for (int t = gw; t < T; t += nw) {
    const int b = t / SEQ;
    const uint4 xa = *(const uint4*)(U2 + (size_t)t * D + lane * 16);
    const uint4 xb = *(const uint4*)(U2 + (size_t)t * D + lane * 16 + 8);
    v2f x2[8];
    x2[0] = v2f{bflo(xa.x), bfhi(xa.x)}; x2[1] = v2f{bflo(xa.y), bfhi(xa.y)};
    x2[2] = v2f{bflo(xa.z), bfhi(xa.z)}; x2[3] = v2f{bflo(xa.w), bfhi(xa.w)};
    x2[4] = v2f{bflo(xb.x), bfhi(xb.x)}; x2[5] = v2f{bflo(xb.y), bfhi(xb.y)};
    x2[6] = v2f{bflo(xb.z), bfhi(xb.z)}; x2[7] = v2f{bflo(xb.w), bfhi(xb.w)};
    v2f o2[8];
#pragma unroll
    for (int i = 0; i < 8; ++i) o2[i] = v2f{0.f, 0.f};
    const int idA = EXPID[(size_t)t * 128 + lane], idB = EXPID[(size_t)t * 128 + 64 + lane];
    const float gA = GATE[(size_t)t * 128 + lane], gB = GATE[(size_t)t * 128 + 64 + lane];
    for (int h = 0; h < PEER_H; ++h) {
      const int idv = (h < 4) ? idA : idB;
      const float gtv = (h < 4) ? gA : gB;
      const int lb = (h & 3) * 16;
      float part[16];
#pragma unroll
      for (int e = 0; e < 16; ++e) {
        const int id = __builtin_amdgcn_readlane(idv, lb + e);
        const uint4 a = EU[(size_t)id * 64 + lane];
        v2f acc = CVT_LO(a.x) * x2[0];
        acc = CVT_HI(a.x) * x2[1] + acc;
        acc = CVT_LO(a.y) * x2[2] + acc;
        acc = CVT_HI(a.y) * x2[3] + acc;
        acc = CVT_LO(a.z) * x2[4] + acc;
        acc = CVT_HI(a.z) * x2[5] + acc;
        acc = CVT_LO(a.w) * x2[6] + acc;
        acc = CVT_HI(a.w) * x2[7] + acc;
        part[e] = acc.x + acc.y;
      }
      float p8[8], p4[4], p2[2], p1;
      {
        const bool up = (lane & 32) != 0;
#pragma unroll
        for (int e = 0; e < 8; ++e) {
          const float mine = up ? part[e + 8] : part[e];
          const float oth = up ? part[e] : part[e + 8];
          p8[e] = mine + __shfl_xor(oth, 32);
        }
      }
      {
        const bool up = (lane & 16) != 0;
#pragma unroll
        for (int e = 0; e < 4; ++e) {
          const float mine = up ? p8[e + 4] : p8[e];
          const float oth = up ? p8[e] : p8[e + 4];
          p4[e] = mine + __shfl_xor(oth, 16);
        }
      }
      {
        const bool up = (lane & 8) != 0;
#pragma unroll
        for (int e = 0; e < 2; ++e) {
          const float mine = up ? p4[e + 2] : p4[e];
          const float oth = up ? p4[e] : p4[e + 2];
          p2[e] = mine + __shfl_xor(oth, 8);
        }
      }
      {
        const bool up = (lane & 4) != 0;
        const float mine = up ? p2[1] : p2[0];
        const float oth = up ? p2[0] : p2[1];
        p1 = mine + __shfl_xor(oth, 4);
      }
      p1 += __shfl_xor(p1, 2);
      p1 += __shfl_xor(p1, 1);
      p1 *= (1.0f / 512.f);
      const int myE = ((lane >> 5) & 1) * 8 + ((lane >> 4) & 1) * 4 + ((lane >> 3) & 1) * 2 + ((lane >> 2) & 1);
      const float gmine = __shfl(gtv, lb + myE);
      const float hv = 0.5f * p1 * (1.0f + erff(p1 * 0.70710678118654752f));
      const float coef = gmine * hv * (1.0f / 128.f);
#pragma unroll
      for (int e = 0; e < 16; ++e) {
        const int srcLane = ((e >> 3) & 1) * 32 + ((e >> 2) & 1) * 16 + ((e >> 1) & 1) * 8 + (e & 1) * 4;
        const float ce = __builtin_bit_cast(float, __builtin_amdgcn_readlane(__builtin_bit_cast(int, coef), srcLane));
        const int id = __builtin_amdgcn_readlane(idv, lb + e);
        const uint4 a = EV[(size_t)id * 64 + lane];
        const v2f c2 = v2f{ce, ce};
        o2[0] = CVT_LO(a.x) * c2 + o2[0];
        o2[1] = CVT_HI(a.x) * c2 + o2[1];
        o2[2] = CVT_LO(a.y) * c2 + o2[2];
        o2[3] = CVT_HI(a.y) * c2 + o2[3];
        o2[4] = CVT_LO(a.z) * c2 + o2[4];
        o2[5] = CVT_HI(a.z) * c2 + o2[5];
        o2[6] = CVT_LO(a.w) * c2 + o2[6];
        o2[7] = CVT_HI(a.w) * c2 + o2[7];
      }
    }
    float* orow = p.out + (size_t)t * D + lane * 16;
    const float* gt = MOD + b * 6144 + 5120 + lane * 16;
    float xf[16];
    float ss = 0.f;
#pragma unroll
    for (int q = 0; q < 4; ++q) {
      const float4 x0 = *(const float4*)(orow + q * 4);
      const float4 g0 = *(const float4*)(gt + q * 4);
      xf[q * 4 + 0] = x0.x + g0.x * o2[q * 2].x;
      xf[q * 4 + 1] = x0.y + g0.y * o2[q * 2].y;
      xf[q * 4 + 2] = x0.z + g0.z * o2[q * 2 + 1].x;
      xf[q * 4 + 3] = x0.w + g0.w * o2[q * 2 + 1].y;
    }
#pragma unroll
    for (int i = 0; i < 16; ++i) ss += xf[i] * xf[i];
    ss = wave_sum(ss);
    const float rstd = rsqrtf(ss * (1.0f / D) + 1e-6f);
#pragma unroll
    for (int q = 0; q < 4; ++q) {
      const float4 f0 = *(const float4*)(p.final_g + lane * 16 + q * 4);
      *(float4*)(orow + q * 4) =
          make_float4(xf[q * 4 + 0] * rstd * f0.x, xf[q * 4 + 1] * rstd * f0.y, xf[q * 4 + 2] * rstd * f0.z, xf[q * 4 + 3] * rstd * f0.w);
    }
  }
}

#ifndef PROBE_MASK
#define PROBE_MASK 0
#endif
__global__ void __launch_bounds__(NTHREADS, 2) hymba_mega(Params p) {
  __shared__ __attribute__((aligned(16))) char smem[SMEM_BYTES];
  __shared__ uint4 xb_words;
  cg::grid_group grid = cg::this_grid();
  if (threadIdx.x == 0) xb_words = make_uint4(0u, 0u, 0u, 0u);
  __syncthreads();
  const XcdBarrier xb = xcd_barrier_post((unsigned*)(p.ws + OFF_BAR), (volatile LAS unsigned*)&xb_words);
#define RUN_PHASE(N, CALL)                          \
  {                                                 \
    CALL;                                           \
    if ((PROBE_MASK >> (N)) & 1) { xcd_barrier(xb); CALL; } \
  }
  RUN_PHASE(0, phase_prep(p, smem))
  grid.sync();
  phase_peer_fold(p, smem);
  RUN_PHASE(1, phase_normmod(p.x, p.norm_mix_g, (const float*)(p.ws + OFF_MOD), 0, 1024, (u16*)(p.ws + OFF_REGB)))
  xcd_barrier(xb);
  RUN_PHASE(2, phase_gemm_in(p, smem))
  xcd_barrier(xb);
  RUN_PHASE(3, phase_act(p))
  xcd_barrier(xb);
  RUN_PHASE(4, phase_lora_conv(p, smem))
  xcd_barrier(xb);
  RUN_PHASE(5, phase_scanprep(p))
  xcd_barrier(xb);
  phase_scan(p, smem, 0);
  if ((PROBE_MASK >> 6) & 1) { xcd_barrier(xb); phase_scan(p, smem, 1); }
  xcd_barrier(xb);
  RUN_PHASE(7, phase_post(p))
  xcd_barrier(xb);
  RUN_PHASE(8, phase_gemm_out(p, smem))
  xcd_barrier(xb);
  RUN_PHASE(9, phase_normmod(p.out, p.norm_ffn_g, (const float*)(p.ws + OFF_MOD), 3072, 4096, (u16*)(p.ws + OFF_REGB)))
  xcd_barrier(xb);
  RUN_PHASE(10, phase_peer_route(p, smem))
  xcd_barrier(xb);
  phase_peer_gather(p);
#ifdef PROBE_TIME
  xcd_barrier(xb);
  if (blockIdx.x == 0 && threadIdx.x == 0) p.out[0] += *(const float*)(p.ws + OFF_BAR + 32768);
#endif
}

extern "C" void kernel_launch(void* const* d_in, const int* in_sizes, int n_in, void* d_out, int out_size, void* d_ws,
                              size_t ws_size, hipStream_t stream) {
  static int grid_blocks = 0;
  if (!grid_blocks) {
    int dev = 0, cus = 0, per_cu = 0;
    (void)hipGetDevice(&dev);
    (void)hipDeviceGetAttribute(&cus, hipDeviceAttributeMultiprocessorCount, dev);
    (void)hipOccupancyMaxActiveBlocksPerMultiprocessor(&per_cu, hymba_mega, NTHREADS, 0);
    if (per_cu > 2) per_cu = 2;
    grid_blocks = cus * per_cu;
  }
  if (ws_size < WS_NEEDED) {
    fprintf(stderr, "workspace too small: %zu < %zu\n", ws_size, (size_t)WS_NEEDED);
    return;
  }
  Params p{};
  const float** pf = (const float**)&p;
  for (int i = 0; i < 28; ++i) pf[i] = (const float*)d_in[i];
  p.out = (float*)d_out;
  p.ws = (char*)d_ws;
  (void)hipMemsetAsync((char*)d_ws + OFF_BAR, 0, (XCD_BAR_WORDS + 2 * (2048 + 64)) * 4, stream);
  void* args[] = {&p};
  hipError_t e = hipLaunchCooperativeKernel((void*)hymba_mega, dim3(grid_blocks), dim3(NTHREADS), args, 0, stream);
  if (e != hipSuccess) fprintf(stderr, "cooperative launch failed: %s (grid %d)\n", hipGetErrorString(e), grid_blocks);
}
```

```cpp
#include <hip/hip_runtime.h>
#include <hip/hip_cooperative_groups.h>
#include <cstdio>
#include <cstdint>
namespace cg = cooperative_groups;

typedef unsigned short u16;
typedef unsigned int u32;
using bf16x8 = __attribute__((ext_vector_type(8))) short;
using f32x4 = __attribute__((ext_vector_type(4))) float;
using f32x16 = __attribute__((ext_vector_type(16))) float;
typedef __attribute__((ext_vector_type(2))) __bf16 bf2_t;
typedef float v2f __attribute__((ext_vector_type(2)));

constexpr int D = 1024, NBATCH = 8, SEQ = 4096, T = NBATCH * SEQ;
constexpr int CONV_CH = 512, RW = 512, NPROJ = 2816, RWKV_PROJ = 1792;
constexpr int CONV_W = 31;
constexpr int NHEAD = 8;
constexpr int PEER_H = 8, PEER_K = 16, NKEYS = 128;
constexpr int NTHREADS = 256;
constexpr int SMEM_BYTES = 79872;

constexpr size_t MB = 1ull << 20;
constexpr size_t OFF_WIN = 0;
constexpr size_t OFF_WOUT = OFF_WIN + (size_t)NPROJ * D * 2;
constexpr size_t OFF_WQ = OFF_WOUT + (size_t)D * D * 2;
constexpr size_t OFF_WLORA = OFF_WQ + (size_t)2048 * D * 2;
constexpr size_t OFF_KEYS = OFF_WLORA + (size_t)1536 * 256 * 2;
constexpr size_t OFF_MOD = OFF_KEYS + (size_t)16 * 128 * 128 * 2;
constexpr size_t OFF_BONUS = OFF_MOD + (size_t)8 * 6144 * 4;
constexpr size_t OFF_BAR = OFF_BONUS + (size_t)T * 8 * 4;
constexpr size_t OFF_REGB = 16 * MB;
constexpr size_t OFF_REGC = OFF_REGB + 64 * MB;
constexpr size_t SZ_P = (size_t)T * NPROJ * 2;
constexpr size_t OFF_PC = OFF_REGC;
constexpr size_t OFF_PR = OFF_REGC + 64 * MB;
constexpr size_t OFF_Y = OFF_REGC + 64 * MB;
constexpr size_t OFF_EXPID = OFF_REGC + 160 * MB;
constexpr size_t OFF_GATE = OFF_REGC + 176 * MB;
constexpr size_t OFF_REGD = OFF_REGC + 176 * MB + 16 * MB;
constexpr size_t OFF_REGF = OFF_REGD + 64 * MB;
constexpr size_t WS_NEEDED = OFF_REGF + 160 * MB;
static_assert(OFF_BAR + (3456 + 2 * (2048 + 64)) * 4 <= OFF_REGB, "small region overflow");
static_assert(SZ_P <= 192 * MB, "P overflow");

struct Params {
  const float *x, *c, *ada_w, *ada_b, *norm_mix_g, *w_in, *conv_w, *conv_b, *ln_w, *ln_b;
  const float *mu, *w0, *w2, *a0, *a2, *g2, *k_k, *k_a, *r_k, *gn_w, *gn_b, *w_out, *norm_ffn_g;
  const float *w_q, *sub_keys, *peer_u, *peer_v, *final_g;
  float* out;
  char* ws;
};

__device__ __forceinline__ u16 f2bf(float f) {
  u32 u = __float_as_uint(f);
  u += 0x7FFFu + ((u >> 16) & 1u);
  return (u16)(u >> 16);
}
__device__ __forceinline__ float bf2f(u16 h) { return __uint_as_float(((u32)h) << 16); }
__device__ __forceinline__ u32 pack2(float a, float b) { return (u32)f2bf(a) | ((u32)f2bf(b) << 16); }
__device__ __forceinline__ float bflo(u32 v) { return __uint_as_float(v << 16); }
__device__ __forceinline__ float bfhi(u32 v) { return __uint_as_float(v & 0xFFFF0000u); }
__device__ __forceinline__ float sigmoidf_(float x) { return 1.0f / (1.0f + __expf(-x)); }
__device__ __forceinline__ float siluf_(float x) { return x * sigmoidf_(x); }
__device__ __forceinline__ float wave_sum(float v) {
#pragma unroll
  for (int o = 32; o > 0; o >>= 1) v += __shfl_xor(v, o);
  return v;
}
__device__ __forceinline__ float dpp_ror_add(float x, int) { return x; }
#define DPP_ROR(x, N) __builtin_bit_cast(float, __builtin_amdgcn_update_dpp(0, __builtin_bit_cast(int, (x)), 0x120 + (N), 0xF, 0xF, false))
__device__ __forceinline__ float row16_sum(float x) {
  x += DPP_ROR(x, 8);
  x += DPP_ROR(x, 4);
  x += DPP_ROR(x, 2);
  x += DPP_ROR(x, 1);
  return x;
}

#define XB_TMO      128
#define XB_XCNT(j)  (256  + 64 * (j))
#define XB_XSUB(j)  (1280 + 64 * (j))
#define XB_XGEN(j)  (2304 + 64 * (j))
#define XB_TOP      3328
#define XB_TOPGEN   3392
#define XCD_BAR_WORDS 3456
#define XB_SPIN_CAP (1u << 18)
#define LAS __attribute__((address_space(3)))
__device__ __forceinline__ unsigned xb_ld(unsigned* p)              { return __hip_atomic_load(p, __ATOMIC_RELAXED, __HIP_MEMORY_SCOPE_AGENT); }
__device__ __forceinline__ unsigned xb_add(unsigned* p, unsigned v) { return __hip_atomic_fetch_add(p, v, __ATOMIC_RELAXED, __HIP_MEMORY_SCOPE_AGENT); }
__device__ __forceinline__ unsigned xb_xcc_id() { return (unsigned)__builtin_amdgcn_s_getreg((3 << 11) | 20) & 0xFu; }
#define XB_SPIN(cond, bar) do { unsigned _sp = 0; while (cond) { __builtin_amdgcn_s_sleep(1); \
    if ((++_sp & 255u) == 0u) { if (xb_ld(&(bar)[XB_TMO])) break; if (_sp > XB_SPIN_CAP) { atomicAdd(&(bar)[XB_TMO], 1u); break; } } } } while (0)
struct XcdBarrier { unsigned* bar; unsigned x; volatile LAS unsigned* st; };
__device__ __forceinline__ XcdBarrier xcd_barrier_post(unsigned* bar, volatile LAS unsigned* st) {
    XcdBarrier b; b.bar = bar; b.x = xb_xcc_id(); b.st = st;
    if (threadIdx.x == 0) (void)xb_add(&bar[XB_XCNT(b.x)], 1u);
    return b;
}
__device__ __forceinline__ void xcd_barrier_complete(unsigned* bar, unsigned x, unsigned& nloc, unsigned& nx) {
    const unsigned G = gridDim.x * gridDim.y * gridDim.z;
    unsigned sum, cnt, mine, sp = 0u;
    for (;;) {
        sum = 0u; cnt = 0u; mine = 0u;
#pragma unroll
        for (unsigned j = 0; j < 16; ++j) { const unsigned c = xb_ld(&bar[XB_XCNT(j)]); sum += c; cnt += (c > 0u) ? 1u : 0u; mine = (j == x) ? c : mine; }
        if (sum == G) break;
        __builtin_amdgcn_s_sleep(1);
        if ((++sp & 255u) == 0u) { if (xb_ld(&bar[XB_TMO])) break; if (sp > XB_SPIN_CAP) { atomicAdd(&bar[XB_TMO], 1u); break; } }
    }
    nloc = mine > 0u ? mine : 1u; nx = cnt > 0u ? cnt : 1u;
}
__device__ __forceinline__ void xcd_barrier(const XcdBarrier& b) {
    asm volatile("s_waitcnt vmcnt(0)" ::: "memory");
    __syncthreads();
    if (threadIdx.x == 0) {
        unsigned* bar = b.bar;
        __builtin_amdgcn_s_waitcnt(0);
        unsigned nloc = b.st[0], nx = b.st[1];
        if (nloc == 0u) { xcd_barrier_complete(bar, b.x, nloc, nx); b.st[0] = nloc; b.st[1] = nx; }
        const unsigned old = xb_add(&bar[XB_XSUB(b.x)], 1u);
        const unsigned gen = old / nloc;
        if (old + 1u == (gen + 1u) * nloc) {
            __builtin_amdgcn_fence(__ATOMIC_RELEASE, "agent");
            asm volatile("s_waitcnt vmcnt(0)" ::: "memory");
            const unsigned og = xb_add(&bar[XB_TOP], 1u);
            const unsigned tg = og / nx;
            if (og + 1u == (tg + 1u) * nx) xb_add(&bar[XB_TOPGEN], 1u);
            else XB_SPIN(xb_ld(&bar[XB_TOPGEN]) == tg, bar);
            __builtin_amdgcn_fence(__ATOMIC_ACQUIRE, "agent");
            xb_add(&bar[XB_XGEN(b.x)], 1u);
            asm volatile("s_waitcnt vmcnt(0)" ::: "memory");
        } else {
            XB_SPIN(xb_ld(&bar[XB_XGEN(b.x)]) == gen, bar);
            __builtin_amdgcn_fence(__ATOMIC_ACQUIRE, "agent");
            asm volatile("s_waitcnt vmcnt(0)" ::: "memory");
        }
    }
    __syncthreads();
}

constexpr int G_ROWB = 144;
constexpr int G_TILEB = 128 * G_ROWB;
template <bool SWAP = true>
__device__ __forceinline__ void gemm128(const u16* __restrict__ A, int lda, const u16* __restrict__ B, int ldb, int K,
                                        int m0, int n0, char* smem, f32x16 (&acc)[2][2]) {
  const int tid = threadIdx.x, lane = tid & 63, wid = tid >> 6, wm = wid >> 1, wn = wid & 1;
  const int fr = lane & 15, fq = lane >> 4;
  const int ldrow = tid >> 3, ldc = tid & 7;
#pragma unroll
  for (int i = 0; i < 2; ++i)
#pragma unroll
    for (int j = 0; j < 2; ++j)
#pragma unroll
      for (int r = 0; r < 16; ++r) acc[i][j][r] = 0.f;
  const int fr32 = lane & 31, fh = lane >> 5;
  uint4 ra[4], rb[4];
  const u16* ga = A + (size_t)(m0 + ldrow) * lda + ldc * 8;
  const u16* gb = B + (size_t)(n0 + ldrow) * ldb + ldc * 8;
  const int nk = K >> 6;
#pragma unroll
  for (int i = 0; i < 4; ++i) {
    ra[i] = *(const uint4*)(ga + (size_t)(32 * i) * lda);
    rb[i] = *(const uint4*)(gb + (size_t)(32 * i) * ldb);
  }
  {
    char* sa = smem + ldrow * G_ROWB + ldc * 16;
#pragma unroll
    for (int i = 0; i < 4; ++i) {
      *(uint4*)(sa + 32 * i * G_ROWB) = ra[i];
      *(uint4*)(sa + G_TILEB + 32 * i * G_ROWB) = rb[i];
    }
  }
  __syncthreads();
  for (int kt = 0; kt < nk; ++kt) {
    const bool more = (kt + 1 < nk);
    if (more) {
      const int k0 = (kt + 1) << 6;
#pragma unroll
      for (int i = 0; i < 4; ++i) {
        ra[i] = *(const uint4*)(ga + (size_t)(32 * i) * lda + k0);
        rb[i] = *(const uint4*)(gb + (size_t)(32 * i) * ldb + k0);
      }
    }
    const char* cur = smem + (kt & 1) * 2 * G_TILEB;
    const char* sa = cur + (wm * 64 + fr32) * G_ROWB + fh * 16;
    const char* sb = cur + G_TILEB + (wn * 64 + fr32) * G_ROWB + fh * 16;
#pragma unroll
    for (int ks = 0; ks < 4; ++ks) {
      bf16x8 af[2], bfr[2];
#pragma unroll
      for (int i = 0; i < 2; ++i) {
        af[i] = *(const bf16x8*)(sa + i * 32 * G_ROWB + ks * 32);
        bfr[i] = *(const bf16x8*)(sb + i * 32 * G_ROWB + ks * 32);
      }
#pragma unroll
      for (int mi = 0; mi < 2; ++mi)
#pragma unroll
        for (int ni = 0; ni < 2; ++ni)
          acc[mi][ni] = SWAP ? __builtin_amdgcn_mfma_f32_32x32x16_bf16(bfr[ni], af[mi], acc[mi][ni], 0, 0, 0)
                             : __builtin_amdgcn_mfma_f32_32x32x16_bf16(af[mi], bfr[ni], acc[mi][ni], 0, 0, 0);
    }
    if (more) {
      char* nxt = smem + ((kt + 1) & 1) * 2 * G_TILEB + ldrow * G_ROWB + ldc * 16;
#pragma unroll
      for (int i = 0; i < 4; ++i) {
        *(uint4*)(nxt + 32 * i * G_ROWB) = ra[i];
        *(uint4*)(nxt + G_TILEB + 32 * i * G_ROWB) = rb[i];
      }
    }
    __syncthreads();
  }
}

__device__ __forceinline__ void gemm128d(const u16* __restrict__ A, int lda, const u16* __restrict__ B, int ldb, int K,
                                        int m0, int n0, char* smem, f32x16 (&acc)[2][2]) {
  const int tid = threadIdx.x, lane = tid & 63, wid = tid >> 6, wm = wid >> 1, wn = wid & 1;
  const int fr = lane & 15, fq = lane >> 4;
  const int ldrow = tid >> 3, ldc = tid & 7;
#pragma unroll
  for (int i = 0; i < 2; ++i)
#pragma unroll
    for (int j = 0; j < 2; ++j)
#pragma unroll
      for (int r = 0; r < 16; ++r) acc[i][j][r] = 0.f;
  const int fr32 = lane & 31, fh = lane >> 5;
  uint4 ra0_0, ra0_1, ra0_2, ra0_3, rb0_0, rb0_1, rb0_2, rb0_3;
  uint4 ra1_0, ra1_1, ra1_2, ra1_3, rb1_0, rb1_1, rb1_2, rb1_3;
  const u16* ga = A + (size_t)(m0 + ldrow) * lda + ldc * 8;
  const u16* gb = B + (size_t)(n0 + ldrow) * ldb + ldc * 8;
  const int nk = K >> 6;
  char* const sw = smem + ldrow * G_ROWB + ldc * 16;
#define G_LOAD1(RA, RB, I, k0)                                          \
  RA##_##I = *(const uint4*)(ga + (size_t)(32 * I) * lda + k0);         \
  RB##_##I = *(const uint4*)(gb + (size_t)(32 * I) * ldb + k0);
#define G_LOAD(RA, RB, KT)                                              \
  {                                                                     \
    const int k0 = (KT) << 6;                                           \
    G_LOAD1(RA, RB, 0, k0) G_LOAD1(RA, RB, 1, k0) G_LOAD1(RA, RB, 2, k0) G_LOAD1(RA, RB, 3, k0) \
  }
#define G_STORE1(RA, RB, I)                                             \
  *(uint4*)(d + 32 * I * G_ROWB) = RA##_##I;                            \
  *(uint4*)(d + G_TILEB + 32 * I * G_ROWB) = RB##_##I;
#define G_STORE(RA, RB, BUF)                                            \
  {                                                                     \
    char* d = sw + (BUF) * 2 * G_TILEB;                                 \
    G_STORE1(RA, RB, 0) G_STORE1(RA, RB, 1) G_STORE1(RA, RB, 2) G_STORE1(RA, RB, 3) \
  }
#define G_COMPUTE(BUF)                                                                          \
  {                                                                                             \
    const char* cur = smem + (BUF) * 2 * G_TILEB;                                               \
    const char* sa = cur + (wm * 64 + fr32) * G_ROWB + fh * 16;                                 \
    const char* sb = cur + G_TILEB + (wn * 64 + fr32) * G_ROWB + fh * 16;                       \
    _Pragma("unroll") for (int ks = 0; ks < 4; ++ks) {                                          \
      bf16x8 af[2], bfr[2];                                                                     \
      _Pragma("unroll") for (int i = 0; i < 2; ++i) {                                           \
        af[i] = *(const bf16x8*)(sa + i * 32 * G_ROWB + ks * 32);                               \
        bfr[i] = *(const bf16x8*)(sb + i * 32 * G_ROWB + ks * 32);                              \
      }                                                                                         \
      _Pragma("unroll") for (int mi = 0; mi < 2; ++mi)                                          \
      _Pragma("unroll") for (int ni = 0; ni < 2; ++ni)                                          \
        acc[mi][ni] = __builtin_amdgcn_mfma_f32_32x32x16_bf16(bfr[ni], af[mi], acc[mi][ni], 0, 0, 0); \
    }                                                                                           \
  }
  G_LOAD(ra0, rb0, 0)
  G_STORE(ra0, rb0, 0)
  G_LOAD(ra0, rb0, 1)
  if (nk > 2) G_LOAD(ra1, rb1, 2)
  __syncthreads();
  for (int kt = 0; kt < nk; kt += 2) {
    G_COMPUTE(0)
    G_STORE(ra0, rb0, 1)
    if (kt + 3 < nk) G_LOAD(ra0, rb0, kt + 3)
    __syncthreads();
    G_COMPUTE(1)
    if (kt + 2 < nk) {
      G_STORE(ra1, rb1, 0)
      if (kt + 4 < nk) G_LOAD(ra1, rb1, kt + 4)
    }
    __syncthreads();
  }
#undef G_LOAD
#undef G_LOAD1
#undef G_STORE
#undef G_STORE1
#undef G_COMPUTE
}

#define ACC_FOREACH(BODY)                                                            \
  {                                                                                  \
    const int _lane = threadIdx.x & 63, _wid = threadIdx.x >> 6;                     \
    const int _wm = _wid >> 1, _wn = _wid & 1, _fr = _lane & 15, _fq = _lane >> 4;   \
    _Pragma("unroll") for (int mi = 0; mi < 4; ++mi)                                 \
    _Pragma("unroll") for (int ni = 0; ni < 4; ++ni)                                 \
    _Pragma("unroll") for (int j = 0; j < 4; ++j) {                                  \
      const int lrow = _wm * 64 + mi * 16 + _fq * 4 + j;                             \
      const int lcol = _wn * 64 + ni * 16 + _fr;                                     \
      const float v = acc[mi][ni][j];                                                \
      BODY                                                                           \
    }                                                                                \
  }

template <class F>
__device__ __forceinline__ void epi_staged(f32x16 (&acc)[2][2], char* smem, F f) {
  float* st = (float*)smem;
  {
    const int lane = threadIdx.x & 63, wid = threadIdx.x >> 6, wm = wid >> 1, wn = wid & 1, fr32 = lane & 31, fh = lane >> 5;
#pragma unroll
    for (int mi = 0; mi < 2; ++mi)
#pragma unroll
      for (int ni = 0; ni < 2; ++ni)
#pragma unroll
        for (int g = 0; g < 4; ++g)
          *(f32x4*)(st + (wm * 64 + mi * 32 + fr32) * 132 + wn * 64 + ni * 32 + g * 8 + fh * 4) =
              f32x4{acc[mi][ni][g * 4 + 0], acc[mi][ni][g * 4 + 1], acc[mi][ni][g * 4 + 2], acc[mi][ni][g * 4 + 3]};
  }
  __syncthreads();
#pragma unroll 4
  for (int i = threadIdx.x; i < 128 * 32; i += NTHREADS) {
    const int row = i >> 5, c4 = (i & 31) << 2;
    const float4 v = *(const float4*)(st + row * 132 + c4);
    f(row, c4, v);
  }
  __syncthreads();
}

constexpr int H_ROWB = 80;
constexpr int H_A = 256 * H_ROWB, H_B = 128 * H_ROWB, H_STAGE = H_A + H_B;
__device__ __forceinline__ void gemm256(const u16* __restrict__ A, int lda, const u16* __restrict__ B, int ldb, int K,
                                        int m0, int n0, char* smem, f32x16 (&acc)[4][2]) {
  const int tid = threadIdx.x, lane = tid & 63, wid = tid >> 6, wm = wid >> 1, wn = wid & 1;
  const int fr32 = lane & 31, fh = lane >> 5;
#pragma unroll
  for (int i = 0; i < 4; ++i)
#pragma unroll
    for (int j = 0; j < 2; ++j)
#pragma unroll
      for (int r = 0; r < 16; ++r) acc[i][j][r] = 0.f;
  const int ldrow = tid >> 2, ldc = tid & 3;
  const u16* ga = A + (size_t)(m0 + ldrow) * lda + ldc * 8;
  const u16* gb = B + (size_t)(n0 + ldrow) * ldb + ldc * 8;
  uint4 a0, a1, a2, a3, b0, b1;
  uint4 c0, c1, c2, c3, d0, d1;
  const int nk = K >> 5;
  char* const swa = smem + ldrow * H_ROWB + ldc * 16;
  char* const swb = smem + H_A + ldrow * H_ROWB + ldc * 16;
#define H_LOAD(k0, A0, A1, A2, A3, B0, B1)                      \
  A0 = *(const uint4*)(ga + (k0));                              \
  A1 = *(const uint4*)(ga + (size_t)64 * lda + (k0));           \
  A2 = *(const uint4*)(ga + (size_t)128 * lda + (k0));          \
  A3 = *(const uint4*)(ga + (size_t)192 * lda + (k0));          \
  B0 = *(const uint4*)(gb + (k0));                              \
  B1 = *(const uint4*)(gb + (size_t)64 * ldb + (k0));
#define H_STORE(BUF, A0, A1, A2, A3, B0, B1)                    \
  *(uint4*)(swa + (BUF) * H_STAGE) = A0;                        \
  *(uint4*)(swa + (BUF) * H_STAGE + 64 * H_ROWB) = A1;          \
  *(uint4*)(swa + (BUF) * H_STAGE + 128 * H_ROWB) = A2;         \
  *(uint4*)(swa + (BUF) * H_STAGE + 192 * H_ROWB) = A3;         \
  *(uint4*)(swb + (BUF) * H_STAGE) = B0;                        \
  *(uint4*)(swb + (BUF) * H_STAGE + 64 * H_ROWB) = B1;
#define H_COMPUTE(BUF)                                                                          \
  {                                                                                             \
    const char* cur = smem + (BUF) * H_STAGE;                                                   \
    const char* sa = cur + (wm * 128 + fr32) * H_ROWB + fh * 16;                                \
    const char* sb = cur + H_A + (wn * 64 + fr32) * H_ROWB + fh * 16;                           \
    _Pragma("unroll") for (int ks = 0; ks < 2; ++ks) {                                          \
      bf16x8 af[4], bfr[2];                                                                     \
      _Pragma("unroll") for (int i = 0; i < 4; ++i) af[i] = *(const bf16x8*)(sa + i * 32 * H_ROWB + ks * 32); \
      _Pragma("unroll") for (int i = 0; i < 2; ++i) bfr[i] = *(const bf16x8*)(sb + i * 32 * H_ROWB + ks * 32); \
      _Pragma("unroll") for (int mi = 0; mi < 4; ++mi)                                          \
      _Pragma("unroll") for (int ni = 0; ni < 2; ++ni)                                          \
        acc[mi][ni] = __builtin_amdgcn_mfma_f32_32x32x16_bf16(bfr[ni], af[mi], acc[mi][ni], 0, 0, 0); \
    }                                                                                           \
  }
  H_LOAD(0, a0, a1, a2, a3, b0, b1)
  H_STORE(0, a0, a1, a2, a3, b0, b1)
  H_LOAD(32, a0, a1, a2, a3, b0, b1)
  if (nk > 2) { H_LOAD(64, c0, c1, c2, c3, d0, d1) }
  __syncthreads();
  for (int kt = 0; kt < nk; kt += 2) {
    H_COMPUTE(0)
    H_STORE(1, a0, a1, a2, a3, b0, b1)
    if (kt + 3 < nk) { const int k0 = (kt + 3) << 5; H_LOAD(k0, a0, a1, a2, a3, b0, b1) }
    __syncthreads();
    H_COMPUTE(1)
    if (kt + 2 < nk) {
      H_STORE(0, c0, c1, c2, c3, d0, d1)
      if (kt + 4 < nk) { const int k0 = (kt + 4) << 5; H_LOAD(k0, c0, c1, c2, c3, d0, d1) }
    }
    __syncthreads();
  }
#undef H_COMPUTE
#undef H_LOAD
#undef H_STORE
}
template <class F>
__device__ __forceinline__ void epi_staged256(f32x16 (&acc)[4][2], char* smem, F f) {
  float* st = (float*)smem;
  const int lane = threadIdx.x & 63, wid = threadIdx.x >> 6, wm = wid >> 1, wn = wid & 1, fr32 = lane & 31, fh = lane >> 5;
#pragma unroll
  for (int half = 0; half < 2; ++half) {
    if (wm == half) {
#pragma unroll
      for (int mi = 0; mi < 4; ++mi)
#pragma unroll
        for (int ni = 0; ni < 2; ++ni)
#pragma unroll
          for (int g = 0; g < 4; ++g)
            *(f32x4*)(st + (mi * 32 + fr32) * 132 + wn * 64 + ni * 32 + g * 8 + fh * 4) =
                f32x4{acc[mi][ni][g * 4 + 0], acc[mi][ni][g * 4 + 1], acc[mi][ni][g * 4 + 2], acc[mi][ni][g * 4 + 3]};
    }
    __syncthreads();
#pragma unroll 4
    for (int i = threadIdx.x; i < 128 * 32; i += NTHREADS) {
      const int row = i >> 5, c4 = (i & 31) << 2;
      const float4 v = *(const float4*)(st + row * 132 + c4);
      f(half * 128 + row, c4, v);
    }
    __syncthreads();
  }
}

__device__ __forceinline__ void transpose_tile(const float* __restrict__ W, int N, u16* __restrict__ Wt, int K, int k0, int n0, float* lds) {
  const int tid = threadIdx.x;
  __syncthreads();
#pragma unroll
  for (int i = 0; i < 16; ++i) {
    int k = i * 4 + (tid >> 6), n = tid & 63;
    lds[k * 65 + n] = W[(size_t)(k0 + k) * N + n0 + n];
  }
  __syncthreads();
#pragma unroll
  for (int i = 0; i < 16; ++i) {
    int n = i * 4 + (tid >> 6), k = tid & 63;
    Wt[(size_t)(n0 + n) * K + k0 + k] = f2bf(lds[k * 65 + n]);
  }
}

__device__ __forceinline__ void phase_prep(const Params& p, char* smem) {
  const int tid = threadIdx.x;
  float* lds = (float*)smem;
  u16* WIN = (u16*)(p.ws + OFF_WIN);
  u16* WOUT = (u16*)(p.ws + OFF_WOUT);
  u16* WLORA = (u16*)(p.ws + OFF_WLORA);
  u16* KEYS = (u16*)(p.ws + OFF_KEYS);
  float* MOD = (float*)(p.ws + OFF_MOD);
  constexpr int N_MOD = 96, N_T1 = 44 * 16, N_T2 = 16 * 16, N_T3 = 0;
  constexpr int N_TASK = N_MOD + N_T1 + N_T2 + N_T3;
  for (int task = blockIdx.x; task < N_TASK; task += gridDim.x) {
    if (task < N_MOD) {
      __syncthreads();
      for (int i = tid; i < 8 * 1024; i += NTHREADS) lds[i] = siluf_(p.c[i]);
      __syncthreads();
      const int lane = tid & 63, w = tid >> 6;
      const int col = task * 64 + lane;
      float a[8];
#pragma unroll
      for (int b = 0; b < 8; ++b) a[b] = 0.f;
      const float* wp = p.ada_w + (size_t)(w * 256) * 6144 + col;
#pragma unroll 8
      for (int k = 0; k < 256; ++k) {
        float wv = wp[(size_t)k * 6144];
#pragma unroll
        for (int b = 0; b < 8; ++b) a[b] += lds[b * 1024 + w * 256 + k] * wv;
      }
      __syncthreads();
#pragma unroll
      for (int b = 0; b < 8; ++b) lds[8192 + (w * 8 + b) * 64 + lane] = a[b];
      __syncthreads();
      for (int i = tid; i < 512; i += NTHREADS) {
        int b = i >> 6, l = i & 63;
        float s = lds[8192 + (0 * 8 + b) * 64 + l] + lds[8192 + (1 * 8 + b) * 64 + l] + lds[8192 + (2 * 8 + b) * 64 + l] +
                  lds[8192 + (3 * 8 + b) * 64 + l];
        MOD[b * 6144 + task * 64 + l] = s + p.ada_b[task * 64 + l];
      }
    } else {
      int t = task - N_MOD;
      if (t < N_T1) {
        transpose_tile(p.w_in, NPROJ, WIN, D, (t & 15) * 64, (t >> 4) * 64, lds);
      } else if (t < N_T1 + N_T2) {
        t -= N_T1;
        transpose_tile(p.w_out, D, WOUT, D, (t & 15) * 64, (t >> 4) * 64, lds);
      }
    }
  }
  const size_t gtid = (size_t)blockIdx.x * NTHREADS + tid, gn = (size_t)gridDim.x * NTHREADS;
  for (size_t i = gtid; i < (size_t)1536 * 256; i += gn) {
    int n = (int)(i >> 8), k = (int)(i & 255);
    float v = 0.f;
    if (n < 512) { if (k < 64) v = p.w2[k * 512 + n]; }
    else if (n < 1024) { if (k >= 64 && k < 128) v = p.a2[(k - 64) * 512 + (n - 512)]; }
    else { if (k >= 128) v = p.g2[(k - 128) * 512 + (n - 1024)]; }
    WLORA[i] = f2bf(v);
  }
  for (size_t i = gtid; i < (size_t)16 * 128 * 128; i += gn) KEYS[i] = f2bf(p.sub_keys[i]);
  {
    uint2* WQB = (uint2*)(p.ws + OFF_REGF);
    const float4* wq4 = (const float4*)p.w_q;
    for (size_t i = gtid; i < (size_t)1024 * 2048 / 4; i += gn) {
      const float4 v = wq4[i];
      WQB[i] = make_uint2(pack2(v.x, v.y), pack2(v.z, v.w));
    }
  }
}

__device__ __forceinline__ void phase_peer_fold(const Params& p, char* smem) {
  const u16* KEYS = (const u16*)(p.ws + OFF_KEYS);
  const u16* WQB = (const u16*)(p.ws + OFF_REGF);
  u16* MT = (u16*)(p.ws + OFF_WQ);
  for (int tile = blockIdx.x; tile < 16 * 8; tile += gridDim.x) {
    const int hp = tile >> 3, dt = tile & 7;
    f32x16 acc[2][2];
    gemm128(KEYS + (size_t)hp * 128 * 128, 128, WQB + hp * 128, 2048, 128, 0, dt * 128, smem, acc);
    epi_staged(acc, smem, [&](int row, int c4, float4 v) {
      *(uint2*)(MT + (size_t)(hp * 128 + row) * D + dt * 128 + c4) = make_uint2(pack2(v.x, v.y), pack2(v.z, v.w));
    });
  }
}

__device__ __forceinline__ void phase_normmod(const float* __restrict__ X, const float* __restrict__ g, const float* __restrict__ MOD,
                              int sh_off, int sc_off, u16* __restrict__ U) {
  const int lane = threadIdx.x & 63;
  const int gw = blockIdx.x * 4 + (threadIdx.x >> 6), nw = gridDim.x * 4;
  for (int t = gw; t < T; t += nw) {
    const int b = t / SEQ;
    const float4* xr = (const float4*)(X + (size_t)t * D);
    float4 v[4];
    float ss = 0.f;
#pragma unroll
    for (int i = 0; i < 4; ++i) {
      v[i] = xr[i * 64 + lane];
      ss += v[i].x * v[i].x + v[i].y * v[i].y + v[i].z * v[i].z + v[i].w * v[i].w;
    }
    ss = wave_sum(ss);
    const float rstd = rsqrtf(ss * (1.0f / D) + 1e-6f);
    const float4* gp = (const float4*)g;
    const float4* shp = (const float4*)(MOD + b * 6144 + sh_off);
    const float4* scp = (const float4*)(MOD + b * 6144 + sc_off);
    uint2* up = (uint2*)(U + (size_t)t * D);
#pragma unroll
    for (int i = 0; i < 4; ++i) {
      float4 gg = gp[i * 64 + lane], sh = shp[i * 64 + lane], sc = scp[i * 64 + lane];
      float o0 = v[i].x * rstd * gg.x * (1.f + sc.x) + sh.x;
      float o1 = v[i].y * rstd * gg.y * (1.f + sc.y) + sh.y;
      float o2 = v[i].z * rstd * gg.z * (1.f + sc.z) + sh.z;
      float o3 = v[i].w * rstd * gg.w * (1.f + sc.w) + sh.w;
      up[i * 64 + lane] = make_uint2(pack2(o0, o1), pack2(o2, o3));
    }
  }
}

__device__ __forceinline__ void phase_gemm_in(const Params& p, char* smem) {
  const u16* U1 = (const u16*)(p.ws + OFF_REGB);
  const u16* WIN = (const u16*)(p.ws + OFF_WIN);
  u16* P = (u16*)(p.ws + OFF_REGC);
  constexpr int NT = NPROJ / 128, MT = T / 256;
  for (int tile = blockIdx.x; tile < NT * MT; tile += gridDim.x) {
    const int mt = tile / NT, nt = tile % NT;
    f32x16 acc[4][2];
    gemm256(U1, D, WIN, D, D, mt * 256, nt * 128, smem, acc);
    epi_staged256(acc, smem, [&](int row, int c4, float4 v) {
      u16* dst = (nt < 8) ? (P + (size_t)(mt * 256 + row) * 1024 + nt * 128 + c4)
                          : (P + (size_t)32 * MB + (size_t)(mt * 256 + row) * 1792 + (nt - 8) * 128 + c4);
      *(uint2*)dst = make_uint2(pack2(v.x, v.y), pack2(v.z, v.w));
    });
  }
}

__device__ __forceinline__ void phase_act(const Params& p) {
  const u16* P = (const u16*)(p.ws + OFF_PR);
  u16* ACT = (u16*)(p.ws + OFF_REGF + 128 * MB);
  const size_t gtid = (size_t)blockIdx.x * NTHREADS + threadIdx.x, gn = (size_t)gridDim.x * NTHREADS;
  for (size_t i = gtid; i < (size_t)T * 64; i += gn) {
    const int t = (int)(i >> 6), c = (int)(i & 63) * 4;
    const u16* pr = P + (size_t)t * 1792 + 1536 + c;
    uint2 cur = *(const uint2*)pr;
    uint2 prv = make_uint2(0u, 0u);
    if ((t % SEQ) != 0) prv = *(const uint2*)(pr - 1792);
    float4 m = *(const float4*)(p.mu + 1536 + c);
    float x0 = bflo(cur.x), x1 = bfhi(cur.x), x2 = bflo(cur.y), x3 = bfhi(cur.y);
    x0 += m.x * (bflo(prv.x) - x0);
    x1 += m.y * (bfhi(prv.x) - x1);
    x2 += m.z * (bflo(prv.y) - x2);
    x3 += m.w * (bfhi(prv.y) - x3);
    if (c < 64) { x0 = tanhf(x0); x1 = tanhf(x1); x2 = tanhf(x2); x3 = tanhf(x3); }
    else if (c >= 128) { x0 = sigmoidf_(x0); x1 = sigmoidf_(x1); x2 = sigmoidf_(x2); x3 = sigmoidf_(x3); }
    *(uint2*)(ACT + (size_t)t * 256 + c) = make_uint2(pack2(x0, x1), pack2(x2, x3));
  }
}

__device__ __forceinline__ void conv_tile(const Params& p, int tile, char* smem) {
  const u16* P = (const u16*)(p.ws + OFF_PC);
  u16* MIXIN = (u16*)(p.ws + OFF_REGB);
  const int tid = threadIdx.x, lane = tid & 63, wid = tid >> 6;
  u32* ylds = (u32*)smem;
  float* olds = (float*)(smem + 62 * 1024);
  const int tok0 = tile * 32;
  const int s0 = tok0 % SEQ;
  __syncthreads();
  for (int r = 0; r < 62; ++r) {
    const int s = s0 - 30 + r;
    u32 val = 0u;
    if (s >= 0) {
      const u16* pr = P + (size_t)(tok0 - 30 + r) * 1024;
      u32 a = *(const u32*)(pr + 2 * tid);
      u32 bq = *(const u32*)(pr + 512 + 2 * tid);
      val = pack2(bflo(a) * sigmoidf_(bflo(bq)), bfhi(a) * sigmoidf_(bfhi(bq)));
    }
    ylds[r * 256 + tid] = val;
  }
  __syncthreads();
  float w0[31], w1[31];
#pragma unroll
  for (int j = 0; j < 31; ++j) {
    const float2 wv = *(const float2*)(p.conv_w + j * 512 + 2 * tid);
    w0[j] = wv.x; w1[j] = wv.y;
  }
  const float2 bias = *(const float2*)(p.conv_b + 2 * tid);
  for (int sub = 0; sub < 4; ++sub) {
    float a0[8], a1[8];
#pragma unroll
    for (int q = 0; q < 8; ++q) { a0[q] = bias.x; a1[q] = bias.y; }
#pragma unroll
    for (int rr = 0; rr < 38; ++rr) {
      const u32 yv = ylds[(sub * 8 + rr) * 256 + tid];
      const float y0 = bflo(yv), y1 = bfhi(yv);
#pragma unroll
      for (int q = 0; q < 8; ++q) {
        const int j = rr - q;
        if (j >= 0 && j < 31) { a0[q] += w0[j] * y0; a1[q] += w1[j] * y1; }
      }
    }
#pragma unroll
    for (int q = 0; q < 8; ++q) *(float2*)(olds + q * 512 + 2 * tid) = make_float2(a0[q], a1[q]);
    __syncthreads();
#pragma unroll
    for (int q2 = 0; q2 < 2; ++q2) {
      const int q = wid * 2 + q2;
      const float4 va = *(const float4*)(olds + q * 512 + lane * 8);
      const float4 vb = *(const float4*)(olds + q * 512 + lane * 8 + 4);
      float s = va.x + va.y + va.z + va.w + vb.x + vb.y + vb.z + vb.w;
      s = wave_sum(s);
      const float mean = s * (1.0f / 512.f);
      float d[8] = {va.x - mean, va.y - mean, va.z - mean, va.w - mean, vb.x - mean, vb.y - mean, vb.z - mean, vb.w - mean};
      float vs = 0.f;
#pragma unroll
      for (int e = 0; e < 8; ++e) vs += d[e] * d[e];
      vs = wave_sum(vs);
      const float rstd = rsqrtf(vs * (1.0f / 512.f) + 1e-5f);
      const float4 lw0 = *(const float4*)(p.ln_w + lane * 8), lw1 = *(const float4*)(p.ln_w + lane * 8 + 4);
      const float4 lb0 = *(const float4*)(p.ln_b + lane * 8), lb1 = *(const float4*)(p.ln_b + lane * 8 + 4);
      const float lw[8] = {lw0.x, lw0.y, lw0.z, lw0.w, lw1.x, lw1.y, lw1.z, lw1.w};
      const float lb[8] = {lb0.x, lb0.y, lb0.z, lb0.w, lb1.x, lb1.y, lb1.z, lb1.w};
      float o[8];
#pragma unroll
      for (int e = 0; e < 8; ++e) o[e] = siluf_(d[e] * rstd * lw[e] + lb[e]);
      uint4 pk = make_uint4(pack2(o[0], o[1]), pack2(o[2], o[3]), pack2(o[4], o[5]), pack2(o[6], o[7]));
      *(uint4*)(MIXIN + (size_t)(tok0 + sub * 8 + q) * D + lane * 8) = pk;
    }
    __syncthreads();
  }
}

__device__ __forceinline__ void phase_lora_conv(const Params& p, char* smem) {
  const u16* ACT = (const u16*)(p.ws + OFF_REGF + 128 * MB);
  const u16* WLORA = (const u16*)(p.ws + OFF_WLORA);
  u16* LW = (u16*)(p.ws + OFF_REGF);
  u16* AA = (u16*)(p.ws + OFF_REGD);
  u16* GG = (u16*)(p.ws + OFF_REGD + 32 * MB);
  constexpr int NT = 12, MT = T / 128, NG = NT * MT, NC = T / 32;
  for (int task = blockIdx.x; task < NG; task += gridDim.x) {
    {
      const int mt = task / NT, nt = task % NT;
      f32x16 acc[2][2];
      gemm128d(ACT, 256, WLORA, 256, 256, mt * 128, nt * 128, smem, acc);
      if (nt < 4) {
        epi_staged(acc, smem, [&](int row, int c4, float4 v) {
          const int n = nt * 128 + c4;
          const float4 w0 = *(const float4*)(p.w0 + n);
          const float vv[4] = {v.x + w0.x, v.y + w0.y, v.z + w0.z, v.w + w0.w};
          float o[4];
#pragma unroll
          for (int e = 0; e < 4; ++e) {
            const float z = -vv[e];
            const float sp = fmaxf(z, 0.f) + log1pf(__expf(-fabsf(z)));
            o[e] = -__expf(-sp - 0.5f);
          }
          *(uint2*)(LW + (size_t)(mt * 128 + row) * 512 + n) = make_uint2(pack2(o[0], o[1]), pack2(o[2], o[3]));
        });
      } else if (nt < 8) {
        epi_staged(acc, smem, [&](int row, int c4, float4 v) {
          const int n = (nt - 4) * 128 + c4;
          const float4 a0 = *(const float4*)(p.a0 + n);
          *(uint2*)(AA + (size_t)(mt * 128 + row) * 512 + n) =
              make_uint2(pack2(sigmoidf_(a0.x + v.x), sigmoidf_(a0.y + v.y)), pack2(sigmoidf_(a0.z + v.z), sigmoidf_(a0.w + v.w)));
        });
      } else {
        epi_staged(acc, smem, [&](int row, int c4, float4 v) {
          const int n = (nt - 8) * 128 + c4;
          *(uint2*)(GG + (size_t)(mt * 128 + row) * 512 + n) = make_uint2(pack2(v.x, v.y), pack2(v.z, v.w));
        });
      }
    }
  }
}

__device__ __forceinline__ void phase_scanprep(const Params& p) {
  const u16* P = (const u16*)(p.ws + OFF_PR);
  const u16* AA = (const u16*)(p.ws + OFF_REGD);
  u16* R = (u16*)(p.ws + OFF_REGF + 32 * MB);
  u16* KM = (u16*)(p.ws + OFF_REGF + 64 * MB);
  u16* V = (u16*)(p.ws + OFF_REGF + 96 * MB);
  u16* KKN = (u16*)(p.ws + OFF_REGF + 128 * MB);
  float* BONUS = (float*)(p.ws + OFF_BONUS);
  const int tid = threadIdx.x;
  const int c = (tid & 127) * 4;
  const float4 mur = *(const float4*)(p.mu + c), muk = *(const float4*)(p.mu + 512 + c), muv = *(const float4*)(p.mu + 1024 + c);
  const float4 kk_ = *(const float4*)(p.k_k + c), ka_ = *(const float4*)(p.k_a + c), rk_ = *(const float4*)(p.r_k + c);
  for (int tp = blockIdx.x; tp < T / 2; tp += gridDim.x) {
    const int t = tp * 2 + (tid >> 7);
    const bool first = (t % SEQ) == 0;
    const u16* pr = P + (size_t)t * 1792 + c;
    float r[4], k[4], v[4];
    {
      uint2 cu = *(const uint2*)pr, pv = first ? make_uint2(0u, 0u) : *(const uint2*)(pr - 1792);
      r[0] = bflo(cu.x); r[1] = bfhi(cu.x); r[2] = bflo(cu.y); r[3] = bfhi(cu.y);
      r[0] += mur.x * (bflo(pv.x) - r[0]); r[1] += mur.y * (bfhi(pv.x) - r[1]);
      r[2] += mur.z * (bflo(pv.y) - r[2]); r[3] += mur.w * (bfhi(pv.y) - r[3]);
    }
    {
      uint2 cu = *(const uint2*)(pr + 512), pv = first ? make_uint2(0u, 0u) : *(const uint2*)(pr + 512 - 1792);
      k[0] = bflo(cu.x); k[1] = bfhi(cu.x); k[2] = bflo(cu.y); k[3] = bfhi(cu.y);
      k[0] += muk.x * (bflo(pv.x) - k[0]); k[1] += muk.y * (bfhi(pv.x) - k[1]);
      k[2] += muk.z * (bflo(pv.y) - k[2]); k[3] += muk.w * (bfhi(pv.y) - k[3]);
    }
    {
      uint2 cu = *(const uint2*)(pr + 1024), pv = first ? make_uint2(0u, 0u) : *(const uint2*)(pr + 1024 - 1792);
      v[0] = bflo(cu.x); v[1] = bfhi(cu.x); v[2] = bflo(cu.y); v[3] = bfhi(cu.y);
      v[0] += muv.x * (bflo(pv.x) - v[0]); v[1] += muv.y * (bfhi(pv.x) - v[1]);
      v[2] += muv.z * (bflo(pv.y) - v[2]); v[3] += muv.w * (bfhi(pv.y) - v[3]);
    }
    const uint2 au = *(const uint2*)(AA + (size_t)t * 512 + c);
    const float a[4] = {bflo(au.x), bfhi(au.x), bflo(au.y), bfhi(au.y)};
    const float kkc[4] = {kk_.x, kk_.y, kk_.z, kk_.w}, kac[4] = {ka_.x, ka_.y, ka_.z, ka_.w}, rkc[4] = {rk_.x, rk_.y, rk_.z, rk_.w};
    float kk[4], km[4];
    float n2 = 0.f, bs = 0.f;
#pragma unroll
    for (int e = 0; e < 4; ++e) {
      kk[e] = k[e] * kkc[e];
      km[e] = k[e] * (1.f + (a[e] - 1.f) * kac[e]);
      n2 += kk[e] * kk[e];
      bs += r[e] * km[e] * rkc[e];
    }
    n2 = row16_sum(n2);
    bs = row16_sum(bs);
    const float inv = 1.0f / fmaxf(sqrtf(n2), 1e-12f);
    const size_t o = (size_t)t * 512 + c;
    *(uint2*)(R + o) = make_uint2(pack2(r[0], r[1]), pack2(r[2], r[3]));
    *(uint2*)(KM + o) = make_uint2(pack2(km[0], km[1]), pack2(km[2], km[3]));
    *(uint2*)(V + o) = make_uint2(pack2(v[0], v[1]), pack2(v[2], v[3]));
    *(uint2*)(KKN + o) = make_uint2(pack2(kk[0] * inv, kk[1] * inv), pack2(kk[2] * inv, kk[3] * inv));
    if ((tid & 15) == 0) BONUS[(size_t)t * 8 + (c >> 6)] = bs;
  }
}

constexpr size_t OFF_EU8 = OFF_REGC + 128 * MB;
constexpr size_t OFF_EV8 = OFF_REGC + 144 * MB;
constexpr int CVT_CHUNKS = 256;
__device__ __forceinline__ void cvt_chunk(const Params& p, int chunk) {
  u32* EU = (u32*)(p.ws + OFF_EU8);
  u32* EV = (u32*)(p.ws + OFF_EV8);
  const float4* su = (const float4*)p.peer_u;
  const float4* sv = (const float4*)p.peer_v;
  const size_t base = (size_t)chunk * 16384;
#pragma unroll 4
  for (int q = 0; q < 64; ++q) {
    const size_t i = base + q * 256 + threadIdx.x;
    const float4 a = su[i], b = sv[i];
    int va = 0, vb = 0;
    va = __builtin_amdgcn_cvt_pk_fp8_f32(a.x * 512.f, a.y * 512.f, va, false);
    va = __builtin_amdgcn_cvt_pk_fp8_f32(a.z * 512.f, a.w * 512.f, va, true);
    vb = __builtin_amdgcn_cvt_pk_fp8_f32(b.x * 128.f, b.y * 128.f, vb, false);
    vb = __builtin_amdgcn_cvt_pk_fp8_f32(b.z * 128.f, b.w * 128.f, vb, true);
    EU[i] = (u32)va;
    EV[i] = (u32)vb;
  }
}

__device__ __forceinline__ void mix_unit(const Params& p, int u, char* smem) {
  for (int ci = 0; ci < 4; ++ci) conv_tile(p, u * 4 + ci, smem);
}

template <int OFF>
__device__ __forceinline__ f32x4 lds_ld4(unsigned addr) {
  f32x4 r;
  asm volatile("ds_read_b128 %0, %1 offset:%2" : "=v"(r) : "v"(addr), "n"(OFF));
  return r;
}
template <int OFF>
__device__ __forceinline__ float lds_ld1(unsigned addr) {
  float r;
  asm volatile("ds_read_b32 %0, %1 offset:%2" : "=v"(r) : "v"(addr), "n"(OFF));
  return r;
}
constexpr int SC_BUF = 27648;
template <int OFF>
__device__ __forceinline__ v2f lds_ld2(unsigned addr) {
  v2f r;
  asm volatile("ds_read_b64 %0, %1 offset:%2" : "=v"(r) : "v"(addr), "n"(OFF));
  return r;
}
__device__ __forceinline__ void phase_scan(const Params& p, char* smem, int rep) {
  const u16* LW = (const u16*)(p.ws + OFF_REGF);
  const u16* R = (const u16*)(p.ws + OFF_REGF + 32 * MB);
  const u16* KM = (const u16*)(p.ws + OFF_REGF + 64 * MB);
  const u16* V = (const u16*)(p.ws + OFF_REGF + 96 * MB);
  const u16* KKN = (const u16*)(p.ws + OFF_REGF + 128 * MB);
  const u16* AA = (const u16*)(p.ws + OFF_REGD);
  float* Y = (float*)(p.ws + OFF_Y);
  const int tid = threadIdx.x, lane = tid & 63, w = tid >> 6;
  const int jl = lane & 15;
  const int ss = tid >> 4, sg = tid & 15;
  unsigned* claim = (unsigned*)(p.ws + OFF_BAR) + XCD_BAR_WORDS + rep * (2048 + 64);
  unsigned* qctr = claim + 2048;
  int* sflag = (int*)(smem + 2 * SC_BUF);
  float* ypw = (float*)(smem + 56320) + w * 1024;
  const unsigned sbase = (unsigned)(size_t)(LAS char*)smem;
  if (tid == 0) {
    const unsigned key = (xb_xcc_id() & 7u) * 256u + (((unsigned)__builtin_amdgcn_s_getreg(63492) >> 8) & 0xffu);
    sflag[0] = (atomicAdd(&claim[key], 1u) == 0u) ? 1 : 0;
  }
  __syncthreads();
  const bool scan_role = sflag[0] != 0;
  for (;;) {
    if (!scan_role) break;
    __syncthreads();
    if (tid == 0) sflag[1] = (int)atomicAdd(&qctr[0], 1u);
    __syncthreads();
    const int task = sflag[1];
    if (task >= 256) break;
    const int bh = task >> 2, rg = task & 3, b = bh >> 3, h = bh & 7;
    const int il = rg * 16 + w * 4 + (lane >> 4);
    v2f Sa = v2f{0.f, 0.f}, Sb = v2f{0.f, 0.f};
    const size_t base = (size_t)b * SEQ * 512 + h * 64 + sg * 4;
    uint2 gA_lw, gA_r, gA_km, gA_v, gA_kkn, gA_a;
    uint2 gB_lw, gB_r, gB_km, gB_v, gB_kkn, gB_a;
#define SC_GLOAD(X, t0)                                      \
  {                                                          \
    const size_t o = base + (size_t)((t0) + ss) * 512;       \
    X##_lw = *(const uint2*)(LW + o); X##_r = *(const uint2*)(R + o);   \
    X##_km = *(const uint2*)(KM + o); X##_v = *(const uint2*)(V + o);   \
    X##_kkn = *(const uint2*)(KKN + o); X##_a = *(const uint2*)(AA + o); \
  }
#define SC_STORE(X, bi)                                                                                \
  {                                                                                                    \
    float* d = (float*)(smem + (bi) * SC_BUF) + ss * 64 + sg * 4;                                      \
    const float4 kq = make_float4(bflo(X##_kkn.x), bfhi(X##_kkn.x), bflo(X##_kkn.y), bfhi(X##_kkn.y)); \
    *(float4*)(d) = make_float4(__expf(bflo(X##_lw.x)), __expf(bfhi(X##_lw.x)), __expf(bflo(X##_lw.y)), __expf(bfhi(X##_lw.y))); \
    *(float4*)(d + 1024) = kq;                                                                         \
    *(float4*)(d + 2048) = make_float4(kq.x * bflo(X##_a.x), kq.y * bfhi(X##_a.x), kq.z * bflo(X##_a.y), kq.w * bfhi(X##_a.y)); \
    *(float4*)(d + 3072) = make_float4(bflo(X##_km.x), bfhi(X##_km.x), bflo(X##_km.y), bfhi(X##_km.y)); \
    *(float4*)(d + 4096) = make_float4(bflo(X##_r.x), bfhi(X##_r.x), bflo(X##_r.y), bfhi(X##_r.y));    \
    float* vt = (float*)(smem + (bi) * SC_BUF) + 5120 + (sg * 4) * 16 + ss;     \
    vt[0] = bflo(X##_v.x); vt[16] = bfhi(X##_v.x); vt[32] = bflo(X##_v.y); vt[48] = bfhi(X##_v.y);     \
  }
#define SC_ISSUE(sl, S)                                     \
  {                                                         \
    dec_[sl] = lds_ld4<(S) * 256>(a0);                      \
    kkn_[sl] = lds_ld4<4096 + (S) * 256>(a0);               \
    km_[sl] = lds_ld4<12288 + (S) * 256>(a0);               \
    if (((S) & 3) == 0) vq_[((S) >> 2) & 1] = lds_ld4<20480 + (S) * 4>(a1); \
    nb_[sl] = lds_ld4<8192 + (S) * 256>(a0);                \
    rr_[sl] = lds_ld4<16384 + (S) * 256>(a0);               \
  }
#define SC_WAIT(N, sl)                                                                          \
  asm volatile("s_waitcnt lgkmcnt(" #N ")"                                                      \
               : "+v"(dec_[sl]), "+v"(kkn_[sl]), "+v"(nb_[sl]), "+v"(km_[sl]), "+v"(rr_[sl]), "+v"(vq_[0]), "+v"(vq_[1]));
#define LO2(q) (v2f{(q).x, (q).y})
#define HI2(q) (v2f{(q).z, (q).w})
#define SC_STEP(S, N)                                                                       \
  {                                                                                         \
    if ((S) + 2 < 16) SC_ISSUE(((S) + 2) % 3, (S) + 2)                                      \
    SC_WAIT(N, (S) % 3)                                                                     \
    const f32x4 dec = dec_[(S) % 3], kkn = kkn_[(S) % 3], nb = nb_[(S) % 3], km = km_[(S) % 3], rr = rr_[(S) % 3]; \
    const float vv = vq_[((S) >> 2) & 1][(S) & 3];                                          \
    const v2f v2 = v2f{vv, vv};                                                             \
    const v2f Ta = Sa * LO2(dec) + v2 * LO2(km);                                            \
    const v2f Tb = Sb * HI2(dec) + v2 * HI2(km);                                            \
    const v2f dv = Sa * LO2(kkn) + Sb * HI2(kkn);                                           \
    float dot = dv.x + dv.y;                                                                \
    if ((S) > 0) {     \
      dot += DPP_ROR(dot, 8); ypend += DPP_ROR(ypend, 8);                                   \
      dot += DPP_ROR(dot, 4); ypend += DPP_ROR(ypend, 4);                                   \
      dot += DPP_ROR(dot, 2); ypend += DPP_ROR(ypend, 2);                                   \
      dot += DPP_ROR(dot, 1); ypend += DPP_ROR(ypend, 1);                                   \
      ykeep = (jl == (S) - 1) ? ypend : ykeep;                                              \
    } else {                                                                                \
      dot = row16_sum(dot);                                                                 \
    }                                                                                       \
    const v2f d2 = v2f{dot, dot};                                                           \
    Sa = Ta - d2 * LO2(nb);                                                                 \
    Sb = Tb - d2 * HI2(nb);                                                                 \
    const v2f yv = Sa * LO2(rr) + Sb * HI2(rr);                                             \
    ypend = yv.x + yv.y;                                                                    \
    if ((S) == 15) { ypend = row16_sum(ypend); ykeep = (jl == 15) ? ypend : ykeep; }        \
  }
#define SC_COMPUTE(c)                                                                       \
  {                                                                                         \
    const unsigned a0 = sbase + (unsigned)(((c) & 1) * SC_BUF + jl * 16);                   \
    const unsigned a1 = sbase + (unsigned)(((c) & 1) * SC_BUF + il * 64);                   \
    f32x4 dec_[3], kkn_[3], nb_[3], km_[3], rr_[3], vq_[2];                                 \
    float ykeep = 0.f, ypend = 0.f;                                                         \
    SC_ISSUE(0, 0)                                                                          \
    SC_ISSUE(1, 1)                                                                          \
    SC_STEP(0, 10) SC_STEP(1, 10) SC_STEP(2, 10) SC_STEP(3, 10) SC_STEP(4, 10) SC_STEP(5, 10) SC_STEP(6, 10) SC_STEP(7, 10) \
    SC_STEP(8, 10) SC_STEP(9, 10) SC_STEP(10, 10) SC_STEP(11, 10) SC_STEP(12, 10) SC_STEP(13, 10) SC_STEP(14, 5) SC_STEP(15, 0) \
    yp[(size_t)((c) * 16 + jl) * 512] = ykeep;                                              \
  }
    constexpr int NCH = SEQ / 16;
    float* yp = Y + (size_t)b * SEQ * 512 + h * 64 + il;
    __syncthreads();
    SC_GLOAD(gA, 0);
    SC_STORE(gA, 0);
    SC_GLOAD(gA, 16);
    SC_GLOAD(gB, 32);
    __syncthreads();
    for (int c = 0; c < NCH; c += 2) {
      SC_COMPUTE(c)
      SC_STORE(gA, 1)
      if (c + 3 < NCH) SC_GLOAD(gA, (c + 3) * 16);
      asm volatile("s_waitcnt lgkmcnt(0)\n\ts_barrier" ::: "memory");
      SC_COMPUTE(c + 1)
      if (c + 2 < NCH) {
        SC_STORE(gB, 0)
        if (c + 4 < NCH) SC_GLOAD(gB, (c + 4) * 16);
      }
      asm volatile("s_waitcnt lgkmcnt(0)\n\ts_barrier" ::: "memory");
    }
  }
  for (;;) {
    __syncthreads();
    if (tid == 0) sflag[3] = (int)atomicAdd(&qctr[32], 1u);
    __syncthreads();
    const int u = sflag[3];
    __syncthreads();
    if (u >= T / 128) break;
    mix_unit(p, u, smem);
  }
  for (;;) {
    __syncthreads();
    if (tid == 0) sflag[2] = (int)atomicAdd(&qctr[16], 1u);
    __syncthreads();
    const int ch = sflag[2];
    if (ch >= CVT_CHUNKS) break;
    cvt_chunk(p, ch);
  }
}

__device__ __forceinline__ void phase_post(const Params& p) {
  const float* Y = (const float*)(p.ws + OFF_Y);
  const u16* V = (const u16*)(p.ws + OFF_REGF + 96 * MB);
  const u16* GG = (const u16*)(p.ws + OFF_REGD + 32 * MB);
  const float* BONUS = (const float*)(p.ws + OFF_BONUS);
  u16* MIXIN = (u16*)(p.ws + OFF_REGB);
  const int tid = threadIdx.x;
  const int c = (tid & 127) * 4;
  const float4 gw = *(const float4*)(p.gn_w + c), gb = *(const float4*)(p.gn_b + c);
  for (int tp = blockIdx.x; tp < T / 2; tp += gridDim.x) {
    const int t = tp * 2 + (tid >> 7);
    const size_t o = (size_t)t * 512 + c;
    const float4 y = *(const float4*)(Y + o);
    float s = row16_sum(y.x + y.y + y.z + y.w);
    const float mean = s * (1.f / 64.f);
    const float d0 = y.x - mean, d1 = y.y - mean, d2 = y.z - mean, d3 = y.w - mean;
    const float var = row16_sum(d0 * d0 + d1 * d1 + d2 * d2 + d3 * d3) * (1.f / 64.f);
    const float rstd = rsqrtf(var + 64e-5f);
    const float bon = BONUS[(size_t)t * 8 + (c >> 6)];
    const uint2 vu = *(const uint2*)(V + o), gu = *(const uint2*)(GG + o);
    const float o0 = (d0 * rstd * gw.x + gb.x + bon * bflo(vu.x)) * bflo(gu.x);
    const float o1 = (d1 * rstd * gw.y + gb.y + bon * bfhi(vu.x)) * bfhi(gu.x);
    const float o2 = (d2 * rstd * gw.z + gb.z + bon * bflo(vu.y)) * bflo(gu.y);
    const float o3 = (d3 * rstd * gw.w + gb.w + bon * bfhi(vu.y)) * bfhi(gu.y);
    *(uint2*)(MIXIN + (size_t)t * D + 512 + c) = make_uint2(pack2(o0, o1), pack2(o2, o3));
  }
}

__device__ __forceinline__ void phase_gemm_out(const Params& p, char* smem) {
  const u16* MIXIN = (const u16*)(p.ws + OFF_REGB);
  const u16* WOUT = (const u16*)(p.ws + OFF_WOUT);
  const float* MOD = (const float*)(p.ws + OFF_MOD);
  constexpr int NT = D / 128, MT = T / 128;
  for (int tile = blockIdx.x; tile < NT * MT; tile += gridDim.x) {
    const int mt = tile / NT, nt = tile % NT;
    f32x16 acc[2][2];
    gemm128d(MIXIN, D, WOUT, D, D, mt * 128, nt * 128, smem, acc);
    const int b = (mt * 128) / SEQ;
    const float* gt = MOD + b * 6144 + 2048 + nt * 128;
    epi_staged(acc, smem, [&](int row, int c4, float4 v) {
      const size_t o = (size_t)(mt * 128 + row) * D + nt * 128 + c4;
      const float4 xv = *(const float4*)(p.x + o);
      const float4 g = *(const float4*)(gt + c4);
      *(float4*)(p.out + o) = make_float4(xv.x + g.x * v.x, xv.y + g.y * v.y, xv.z + g.z * v.z, xv.w + g.w * v.w);
    });
  }
}

__device__ __forceinline__ u32 f2ord(float f) {
  u32 u = __float_as_uint(f);
  return (u & 0x80000000u) ? ~u : (u | 0x80000000u);
}
__device__ __forceinline__ float ord2f(u32 u) {
  u = (u & 0x80000000u) ? (u & 0x7FFFFFFFu) : ~u;
  return __uint_as_float(u);
}
#define TOPK_INSERT(L, x)                       \
  {                                             \
    u32 _x = (x);                               \
    _Pragma("unroll") for (int _i = 0; _i < 16; ++_i) { \
      u32 _hi = max(L[_i], _x);                 \
      _x = min(L[_i], _x);                      \
      L[_i] = _hi;                              \
    }                                           \
  }

#define CMPEX_DESC(a, b) { const u32 _hi = max(a, b); const u32 _lo = min(a, b); a = _hi; b = _lo; }
__device__ __forceinline__ void sort16_desc(u32 (&v)[16]) {
#pragma unroll
  for (int k = 2; k <= 16; k <<= 1) {
#pragma unroll
    for (int j = k >> 1; j > 0; j >>= 1) {
#pragma unroll
      for (int i = 0; i < 16; ++i) {
        const int l = i ^ j;
        if (l > i) {
          if ((i & k) == 0) CMPEX_DESC(v[i], v[l]) else CMPEX_DESC(v[l], v[i])
        }
      }
    }
  }
}
__device__ __forceinline__ void merge16_desc(u32 (&a)[16], const u32 (&b)[16]) {
#pragma unroll
  for (int i = 0; i < 16; ++i) a[i] = max(a[i], b[15 - i]);
#pragma unroll
  for (int j = 8; j > 0; j >>= 1) {
#pragma unroll
    for (int i = 0; i < 16; ++i) {
      const int l = i ^ j;
      if (l > i) CMPEX_DESC(a[i], a[l])
    }
  }
}

__device__ __forceinline__ void phase_peer_route(const Params& p, char* smem) {
  const u16* U2 = (const u16*)(p.ws + OFF_REGB);
  const u16* WQ = (const u16*)(p.ws + OFF_WQ);
  const u16* KEYS = (const u16*)(p.ws + OFF_KEYS);
  int* EXPID = (int*)(p.ws + OFF_EXPID);
  float* GATE = (float*)(p.ws + OFF_GATE);
  const int tid = threadIdx.x, lane = tid & 63, wid = tid >> 6, wm = wid >> 1, wn = wid & 1, fr = lane & 15, fq = lane >> 4;
  constexpr int QROWB = 272;
  char* qs = smem;
  char* ks = smem + 128 * QROWB;
  float* sT = (float*)smem;
  for (int task = blockIdx.x; task < (T / 128) * PEER_H; task += gridDim.x) {
    const int mt = task / PEER_H, h = task % PEER_H;
    u32 L0[16], L1[16];
#pragma unroll
    for (int pp = 0; pp < 2; ++pp) {
      f32x16 sc[2][2];
      gemm128(U2, D, WQ, D, D, mt * 128, h * 256 + pp * 128, smem, sc);
      {
        const int fr32 = lane & 31, fh = lane >> 5;
#pragma unroll
        for (int mi = 0; mi < 2; ++mi)
#pragma unroll
          for (int ni = 0; ni < 2; ++ni)
#pragma unroll
            for (int g = 0; g < 4; ++g)
              *(f32x4*)(sT + (wm * 64 + mi * 32 + fr32) * 132 + wn * 64 + ni * 32 + g * 8 + fh * 4) =
                  f32x4{sc[mi][ni][g * 4 + 0], sc[mi][ni][g * 4 + 1], sc[mi][ni][g * 4 + 2], sc[mi][ni][g * 4 + 3]};
      }
      __syncthreads();
      {
        const int trow = tid & 127, half = tid >> 7;
        u32 L[16];
#pragma unroll
        for (int i = 0; i < 16; ++i) L[i] = 0u;
#pragma unroll 1
        for (int g = 0; g < 4; ++g) {
          u32 grp[16];
          const int kb = half * 64 + g * 16;
#pragma unroll
          for (int i4 = 0; i4 < 4; ++i4) {
            const float4 sv = *(const float4*)(sT + trow * 132 + kb + i4 * 4);
            grp[i4 * 4 + 0] = (f2ord(sv.x) & ~0x7Fu) | (u32)(127 - kb - i4 * 4);
            grp[i4 * 4 + 1] = (f2ord(sv.y) & ~0x7Fu) | (u32)(126 - kb - i4 * 4);
            grp[i4 * 4 + 2] = (f2ord(sv.z) & ~0x7Fu) | (u32)(125 - kb - i4 * 4);
            grp[i4 * 4 + 3] = (f2ord(sv.w) & ~0x7Fu) | (u32)(124 - kb - i4 * 4);
          }
          sort16_desc(grp);
          merge16_desc(L, grp);
        }
        __syncthreads();
        u32* xl = (u32*)smem;
        if (half == 1) {
#pragma unroll
          for (int i = 0; i < 16; ++i) xl[trow * 17 + i] = L[i];
        }
        __syncthreads();
        if (half == 0) {
          u32 oth[16];
#pragma unroll
          for (int i = 0; i < 16; ++i) oth[i] = xl[trow * 17 + i];
          merge16_desc(L, oth);
#pragma unroll
          for (int i = 0; i < 16; ++i) {
            if (pp == 0) L0[i] = L[i]; else L1[i] = L[i];
          }
        }
      }
      __syncthreads();
    }
    if (tid < 128) {
      float s0[16], s1[16];
#pragma unroll
      for (int i = 0; i < 16; ++i) {
        s0[i] = ord2f(L0[i] & ~0x7Fu);
        s1[i] = ord2f(L1[i] & ~0x7Fu);
      }
#define CKEY(i, j) ((f2ord(s0[i] + s1[j]) & ~0xFFu) | (u32)(255 - ((i) * 16 + (j))))
      u32 B[16], Bk[16], Ck[16], Dk[16];
#pragma unroll
      for (int j = 0; j < 16; ++j) B[j] = CKEY(0, j);
#pragma unroll
      for (int j = 0; j < 8; ++j) Bk[j] = CKEY(1, j);
#pragma unroll
      for (int j = 0; j < 5; ++j) Bk[8 + j] = CKEY(2, j);
#pragma unroll
      for (int j = 0; j < 3; ++j) Bk[13 + j] = CKEY(4, j);
#pragma unroll
      for (int j = 0; j < 4; ++j) Ck[j] = CKEY(3, j);
#pragma unroll
      for (int j = 0; j < 2; ++j) { Ck[4 + j] = CKEY(5, j); Ck[6 + j] = CKEY(6, j); Ck[8 + j] = CKEY(7, j); }
#pragma unroll
      for (int i = 8; i < 14; ++i) Ck[10 + (i - 8)] = CKEY(i, 0);
      {
        const u32 d14 = CKEY(14, 0), d15 = CKEY(15, 0);
        Dk[0] = max(d14, d15);
        Dk[1] = min(d14, d15);
#pragma unroll
        for (int i = 2; i < 16; ++i) Dk[i] = 0u;
      }
#undef CKEY
      sort16_desc(Bk);
      sort16_desc(Ck);
      merge16_desc(B, Bk);
      merge16_desc(B, Ck);
      merge16_desc(B, Dk);
      float bv[16];
      int eid[16];
      u32* slot = (u32*)smem + tid * 33;
#pragma unroll
      for (int z = 0; z < 16; ++z) { slot[z] = L0[z]; slot[16 + z] = L1[z]; }
#pragma unroll
      for (int q = 0; q < 16; ++q) {
        const int pos = 255 - (int)(B[q] & 0xFFu);
        const u32 a = slot[pos >> 4], bq = slot[16 + (pos & 15)];
        const int i0 = 127 - (int)(a & 0x7Fu), i1 = 127 - (int)(bq & 0x7Fu);
        eid[q] = i0 * NKEYS + i1;
        bv[q] = ord2f(a & ~0x7Fu) + ord2f(bq & ~0x7Fu);
      }
      float mx = bv[0];
#pragma unroll
      for (int q = 1; q < 16; ++q) mx = fmaxf(mx, bv[q]);
      float den = 0.f;
#pragma unroll
      for (int q = 0; q < 16; ++q) { bv[q] = __expf(bv[q] - mx); den += bv[q]; }
      const float rden = 1.0f / den;
      const size_t o = ((size_t)(mt * 128 + tid) * PEER_H + h) * 16;
#pragma unroll
      for (int q = 0; q < 16; q += 4) {
        *(int4*)(EXPID + o + q) = make_int4(eid[q], eid[q + 1], eid[q + 2], eid[q + 3]);
        *(float4*)(GATE + o + q) = make_float4(bv[q] * rden, bv[q + 1] * rden, bv[q + 2] * rden, bv[q + 3] * rden);
      }
    }
    __syncthreads();
  }
}

#define CVT_LO(w) __builtin_amdgcn_cvt_pk_f32_fp8((int)(w), false)
#define CVT_HI(w) __builtin_amdgcn_cvt_pk_f32_fp8((int)(w), true)
__device__ __forceinline__ void phase_peer_gather(const Params& p) {
  const u16* U2 = (const u16*)(p.ws + OFF_REGB);
  const uint4* EU = (const uint4*)(p.ws + OFF_EU8);
  const uint4* EV = (const uint4*)(p.ws + OFF_EV8);
  const int* EXPID = (const int*)(p.ws + OFF_EXPID);
  const float* GATE = (const float*)(p.ws + OFF_GATE);
  const float* MOD = (const float*)(p.ws + OFF_MOD);
  const int lane = threadIdx.x & 63;
  const int gw = blockIdx.x * 4 + (threadIdx.x >> 6), nw = gridDim.x * 4;
  for (int t = gw; t < T; t += nw) {
    const int b = t / SEQ;
    const uint4 xa = *(const uint4*)(U2 + (size_t)t * D + lane * 16);
    const uint4 xb = *(const uint4*)(U2 + (size_t)t * D + lane * 16 + 8);
    v2f x2[8];
    x2[0] = v2f{bflo(xa.x), bfhi(xa.x)}; x2[1] = v2f{bflo(xa.y), bfhi(xa.y)};
    x2[2] = v2f{bflo(xa.z), bfhi(xa.z)}; x2[3] = v2f{bflo(xa.w), bfhi(xa.w)};
    x2[4] = v2f{bflo(xb.x), bfhi(xb.x)}; x2[5] = v2f{bflo(xb.y), bfhi(xb.y)};
    x2[6] = v2f{bflo(xb.z), bfhi(xb.z)}; x2[7] = v2f{bflo(xb.w), bfhi(xb.w)};
    v2f o2[8];
#pragma unroll
    for (int i = 0; i < 8; ++i) o2[i] = v2f{0.f, 0.f};
    const int idA = EXPID[(size_t)t * 128 + lane], idB = EXPID[(size_t)t * 128 + 64 + lane];
    const float gA = GATE[(size_t)t * 128 + lane], gB = GATE[(size_t)t * 128 + 64 + lane];
    for (int h = 0; h < PEER_H; ++h) {
      const int idv = (h < 4) ? idA : idB;
      const float gtv = (h < 4) ? gA : gB;
      const int lb = (h & 3) * 16;
      float part[16];
#pragma unroll
      for (int e = 0; e < 16; ++e) {
        const int id = __builtin_amdgcn_readlane(idv, lb + e);
        const uint4 a = EU[(size_t)id * 64 + lane];
        v2f acc = CVT_LO(a.x) * x2[0];
        acc = CVT_HI(a.x) * x2[1] + acc;
        acc = CVT_LO(a.y) * x2[2] + acc;
        acc = CVT_HI(a.y) * x2[3] + acc;
        acc = CVT_LO(a.z) * x2[4] + acc;
        acc = CVT_HI(a.z) * x2[5] + acc;
        acc = CVT_LO(a.w) * x2[6] + acc;
        acc = CVT_HI(a.w) * x2[7] + acc;
        part[e] = acc.x + acc.y;
      }
      float p8[8], p4[4], p2[2], p1;
      {
        const bool up = (lane & 32) != 0;
#pragma unroll
        for (int e = 0; e < 8; ++e) {
          const float mine = up ? part[e + 8] : part[e];
          const float oth = up ? part[e] : part[e + 8];
          p8[e] = mine + __shfl_xor(oth, 32);
        }
      }
      {
        const bool up = (lane & 16) != 0;
#pragma unroll
        for (int e = 0; e < 4; ++e) {
          const float mine = up ? p8[e + 4] : p8[e];
          const float oth = up ? p8[e] : p8[e + 4];
          p4[e] = mine + __shfl_xor(oth, 16);
        }
      }
      {
        const bool up = (lane & 8) != 0;
#pragma unroll
        for (int e = 0; e < 2; ++e) {
          const float mine = up ? p4[e + 2] : p4[e];
          const float oth = up ? p4[e] : p4[e + 2];
          p2[e] = mine + __shfl_xor(oth, 8);
        }
      }
      {
        const bool up = (lane & 4) != 0;
        const float mine = up ? p2[1] : p2[0];
        const float oth = up ? p2[0] : p2[1];
        p1 = mine + __shfl_xor(oth, 4);
      }
      p1 += __shfl_xor(p1, 2);
      p1 += __shfl_xor(p1, 1);
      p1 *= (1.0f / 512.f);
      const int myE = ((lane >> 5) & 1) * 8 + ((lane >> 4) & 1) * 4 + ((lane >> 3) & 1) * 2 + ((lane >> 2) & 1);
      const float gmine = __shfl(gtv, lb + myE);
      const float hv = 0.5f * p1 * (1.0f + erff(p1 * 0.70710678118654752f));
      const float coef = gmine * hv * (1.0f / 128.f);
#pragma unroll
      for (int e = 0; e < 16; ++e) {
        const int srcLane = ((e >> 3) & 1) * 32 + ((e >> 2) & 1) * 16 + ((e >> 1) & 1) * 8 + (e & 1) * 4;
        const float ce = __builtin_bit_cast(float, __builtin_amdgcn_readlane(__builtin_bit_cast(int, coef), srcLane));
        const int id = __builtin_amdgcn_readlane(idv, lb + e);
        const uint4 a = EV[(size_t)id * 64 + lane];
        const v2f c2 = v2f{ce, ce};
        o2[0] = CVT_LO(a.x) * c2 + o2[0];
        o2[1] = CVT_HI(a.x) * c2 + o2[1];
        o2[2] = CVT_LO(a.y) * c2 + o2[2];
        o2[3] = CVT_HI(a.y) * c2 + o2[3];
        o2[4] = CVT_LO(a.z) * c2 + o2[4];
        o2[5] = CVT_HI(a.z) * c2 + o2[5];
        o2[6] = CVT_LO(a.w) * c2 + o2[6];
        o2[7] = CVT_HI(a.w) * c2 + o2[7];
      }
    }
    float* orow = p.out + (size_t)t * D + lane * 16;
    const float* gt = MOD + b * 6144 + 5120 + lane * 16;
    float xf[16];
    float ss = 0.f;
#pragma unroll
    for (int q = 0; q < 4; ++q) {
      const float4 x0 = *(const float4*)(orow + q * 4);
      const float4 g0 = *(const float4*)(gt + q * 4);
      xf[q * 4 + 0] = x0.x + g0.x * o2[q * 2].x;
      xf[q * 4 + 1] = x0.y + g0.y * o2[q * 2].y;
      xf[q * 4 + 2] = x0.z + g0.z * o2[q * 2 + 1].x;
      xf[q * 4 + 3] = x0.w + g0.w * o2[q * 2 + 1].y;
    }
#pragma unroll
    for (int i = 0; i < 16; ++i) ss += xf[i] * xf[i];
    ss = wave_sum(ss);
    const float rstd = rsqrtf(ss * (1.0f / D) + 1e-6f);
#pragma unroll
    for (int q = 0; q < 4; ++q) {
      const float4 f0 = *(const float4*)(p.final_g + lane * 16 + q * 4);
      *(float4*)(orow + q * 4) =
          make_float4(xf[q * 4 + 0] * rstd * f0.x, xf[q * 4 + 1] * rstd * f0.y, xf[q * 4 + 2] * rstd * f0.z, xf[q * 4 + 3] * rstd * f0.w);
    }
  }
}

#ifndef PROBE_MASK
#define PROBE_MASK 0
#endif
__global__ void __launch_bounds__(NTHREADS, 2) hymba_mega(Params p) {
  __shared__ __attribute__((aligned(16))) char smem[SMEM_BYTES];
  __shared__ uint4 xb_words;
  cg::grid_group grid = cg::this_grid();
  if (threadIdx.x == 0) xb_words = make_uint4(0u, 0u, 0u, 0u);
  __syncthreads();
  const XcdBarrier xb = xcd_barrier_post((unsigned*)(p.ws + OFF_BAR), (volatile LAS unsigned*)&xb_words);
#define RUN_PHASE(N, CALL)                          \
  {                                                 \
    CALL;                                           \
    if ((PROBE_MASK >> (N)) & 1) { xcd_barrier(xb); CALL; } \
  }
  RUN_PHASE(0, phase_prep(p, smem))
  grid.sync();
  phase_peer_fold(p, smem);
  RUN_PHASE(1, phase_normmod(p.x, p.norm_mix_g, (const float*)(p.ws + OFF_MOD), 0, 1024, (u16*)(p.ws + OFF_REGB)))
  xcd_barrier(xb);
  RUN_PHASE(2, phase_gemm_in(p, smem))
  xcd_barrier(xb);
  RUN_PHASE(3, phase_act(p))
  xcd_barrier(xb);
  RUN_PHASE(4, phase_lora_conv(p, smem))
  xcd_barrier(xb);
  RUN_PHASE(5, phase_scanprep(p))
  xcd_barrier(xb);
  phase_scan(p, smem, 0);
  if ((PROBE_MASK >> 6) & 1) { xcd_barrier(xb); phase_scan(p, smem, 1); }
  xcd_barrier(xb);
  RUN_PHASE(7, phase_post(p))
  xcd_barrier(xb);
  RUN_PHASE(8, phase_gemm_out(p, smem))
  xcd_barrier(xb);
  RUN_PHASE(9, phase_normmod(p.out, p.norm_ffn_g, (const float*)(p.ws + OFF_MOD), 3072, 4096, (u16*)(p.ws + OFF_REGB)))
  xcd_barrier(xb);
  RUN_PHASE(10, phase_peer_route(p, smem))
  xcd_barrier(xb);
  phase_peer_gather(p);
#ifdef PROBE_TIME
  xcd_barrier(xb);
  if (blockIdx.x == 0 && threadIdx.x == 0) p.out[0] += *(const float*)(p.ws + OFF_BAR + 32768);
#endif
}

extern "C" void kernel_launch(void* const* d_in, const int* in_sizes, int n_in, void* d_out, int out_size, void* d_ws,
                              size_t ws_size, hipStream_t stream) {
  static int grid_blocks = 0;
  if (!grid_blocks) {
    int dev = 0, cus = 0, per_cu = 0;
    (void)hipGetDevice(&dev);
    (void)hipDeviceGetAttribute(&cus, hipDeviceAttributeMultiprocessorCount, dev);
    (void)hipOccupancyMaxActiveBlocksPerMultiprocessor(&per_cu, hymba_mega, NTHREADS, 0);
    if (per_cu > 2) per_cu = 2;
    grid_blocks = cus * per_cu;
  }
  if (ws_size < WS_NEEDED) {
    fprintf(stderr, "workspace too small: %zu < %zu\n", ws_size, (size_t)WS_NEEDED);
    return;
  }
  Params p{};
  const float** pf = (const float**)&p;
  for (int i = 0; i < 28; ++i) pf[i] = (const float*)d_in[i];
  p.out = (float*)d_out;
  p.ws = (char*)d_ws;
  (void)hipMemsetAsync((char*)d_ws + OFF_BAR, 0, (XCD_BAR_WORDS + 2 * (2048 + 64)) * 4, stream);
  void* args[] = {&p};
  hipError_t e = hipLaunchCooperativeKernel((void*)hymba_mega, dim3(grid_blocks), dim3(NTHREADS), args, 0, stream);
  if (e != hipSuccess) fprintf(stderr, "cooperative launch failed: %s (grid %d)\n", hipGetErrorString(e), grid_blocks);
}
```

```cpp
#include <hip/hip_runtime.h>
#include <hip/hip_cooperative_groups.h>
#include <cstdio>
#include <cstdint>
namespace cg = cooperative_groups;

typedef unsigned short u16;
typedef unsigned int u32;
using bf16x8 = __attribute__((ext_vector_type(8))) short;
using f32x4 = __attribute__((ext_vector_type(4))) float;
using f32x16 = __attribute__((ext_vector_type(16))) float;
typedef __attribute__((ext_vector_type(2))) __bf16 bf2_t;
typedef float v2f __attribute__((ext_vector_type(2)));

constexpr int D = 1024, NBATCH = 8, SEQ = 4096, T = NBATCH * SEQ;
constexpr int CONV_CH = 512, RW = 512, NPROJ = 2816, RWKV_PROJ = 1792;
constexpr int CONV_W = 31;
constexpr int NHEAD = 8;
constexpr int PEER_H = 8, PEER_K = 16, NKEYS = 128;
constexpr int NTHREADS = 256;
constexpr int SMEM_BYTES = 79872;

constexpr size_t MB = 1ull << 20;
constexpr size_t OFF_WIN = 0;
constexpr size_t OFF_WOUT = OFF_WIN + (size_t)NPROJ * D * 2;
constexpr size_t OFF_WQ = OFF_WOUT + (size_t)D * D * 2;
constexpr size_t OFF_WLORA = OFF_WQ + (size_t)2048 * D * 2;
constexpr size_t OFF_KEYS = OFF_WLORA + (size_t)1536 * 256 * 2;
constexpr size_t OFF_MOD = OFF_KEYS + (size_t)16 * 128 * 128 * 2;
constexpr size_t OFF_BONUS = OFF_MOD + (size_t)8 * 6144 * 4;
constexpr size_t OFF_BAR = OFF_BONUS + (size_t)T * 8 * 4;
constexpr size_t OFF_REGB = 16 * MB;
constexpr size_t OFF_REGC = OFF_REGB + 64 * MB;
constexpr size_t SZ_P = (size_t)T * NPROJ * 2;
constexpr size_t OFF_PC = OFF_REGC;
constexpr size_t OFF_PR = OFF_REGC + 64 * MB;
constexpr size_t OFF_Y = OFF_REGC + 64 * MB;
constexpr size_t OFF_EXPID = OFF_REGC + 160 * MB;
constexpr size_t OFF_GATE = OFF_REGC + 176 * MB;
constexpr size_t OFF_REGD = OFF_REGC + 176 * MB + 16 * MB;
constexpr size_t OFF_REGF = OFF_REGD + 64 * MB;
constexpr size_t WS_NEEDED = OFF_REGF + 160 * MB;
static_assert(OFF_BAR + (3456 + 2 * (2048 + 64)) * 4 <= OFF_REGB, "small region overflow");
static_assert(SZ_P <= 192 * MB, "P overflow");

struct Params {
  const float *x, *c, *ada_w, *ada_b, *norm_mix_g, *w_in, *conv_w, *conv_b, *ln_w, *ln_b;
  const float *mu, *w0, *w2, *a0, *a2, *g2, *k_k, *k_a, *r_k, *gn_w, *gn_b, *w_out, *norm_ffn_g;
  const float *w_q, *sub_keys, *peer_u, *peer_v, *final_g;
  float* out;
  char* ws;
};

__device__ __forceinline__ u16 f2bf(float f) {
  u32 u = __float_as_uint(f);
  u += 0x7FFFu + ((u >> 16) & 1u);
  return (u16)(u >> 16);
}
__device__ __forceinline__ float bf2f(u16 h) { return __uint_as_float(((u32)h) << 16); }
__device__ __forceinline__ u32 pack2(float a, float b) { return (u32)f2bf(a) | ((u32)f2bf(b) << 16); }
__device__ __forceinline__ float bflo(u32 v) { return __uint_as_float(v << 16); }
__device__ __forceinline__ float bfhi(u32 v) { return __uint_as_float(v & 0xFFFF0000u); }
__device__ __forceinline__ float sigmoidf_(float x) { return __builtin_amdgcn_rcpf(1.0f + __expf(-x)); }
__device__ __forceinline__ float tanhf_(float x) {
  const float e = __expf(-2.0f * fabsf(x));
  return copysignf((1.0f - e) * __builtin_amdgcn_rcpf(1.0f + e), x);
}
__device__ __forceinline__ float erff_(float x) {
  const float ax = fabsf(x);
  const float t = __builtin_amdgcn_rcpf(1.0f + 0.3275911f * ax);
  const float poly = t * (0.254829592f + t * (-0.284496736f + t * (1.421413741f + t * (-1.453152027f + t * 1.061405429f))));
  return copysignf(1.0f - poly * __expf(-ax * ax), x);
}
__device__ __forceinline__ float siluf_(float x) { return x * sigmoidf_(x); }
__device__ __forceinline__ float wave_sum(float v) {
#pragma unroll
  for (int o = 32; o > 0; o >>= 1) v += __shfl_xor(v, o);
  return v;
}
__device__ __forceinline__ float dpp_ror_add(float x, int) { return x; }
#define DPP_ROR(x, N) __builtin_bit_cast(float, __builtin_amdgcn_update_dpp(0, __builtin_bit_cast(int, (x)), 0x120 + (N), 0xF, 0xF, false))
__device__ __forceinline__ float row16_sum(float x) {
  x += DPP_ROR(x, 8);
  x += DPP_ROR(x, 4);
  x += DPP_ROR(x, 2);
  x += DPP_ROR(x, 1);
  return x;
}

#define XB_TMO      128
#define XB_XCNT(j)  (256  + 64 * (j))
#define XB_XSUB(j)  (1280 + 64 * (j))
#define XB_XGEN(j)  (2304 + 64 * (j))
#define XB_TOP      3328
#define XB_TOPGEN   3392
#define XCD_BAR_WORDS 3456
#define XB_SPIN_CAP (1u << 18)
#define LAS __attribute__((address_space(3)))
__device__ __forceinline__ unsigned xb_ld(unsigned* p)              { return __hip_atomic_load(p, __ATOMIC_RELAXED, __HIP_MEMORY_SCOPE_AGENT); }
__device__ __forceinline__ unsigned xb_add(unsigned* p, unsigned v) { return __hip_atomic_fetch_add(p, v, __ATOMIC_RELAXED, __HIP_MEMORY_SCOPE_AGENT); }
__device__ __forceinline__ unsigned xb_xcc_id() { return (unsigned)__builtin_amdgcn_s_getreg((3 << 11) | 20) & 0xFu; }
#define XB_SPIN(cond, bar) do { unsigned _sp = 0; while (cond) { __builtin_amdgcn_s_sleep(1); \
    if ((++_sp & 255u) == 0u) { if (xb_ld(&(bar)[XB_TMO])) break; if (_sp > XB_SPIN_CAP) { atomicAdd(&(bar)[XB_TMO], 1u); break; } } } } while (0)
struct XcdBarrier { unsigned* bar; unsigned x; volatile LAS unsigned* st; };
__device__ __forceinline__ XcdBarrier xcd_barrier_post(unsigned* bar, volatile LAS unsigned* st) {
    XcdBarrier b; b.bar = bar; b.x = xb_xcc_id(); b.st = st;
    if (threadIdx.x == 0) (void)xb_add(&bar[XB_XCNT(b.x)], 1u);
    return b;
}
__device__ __forceinline__ void xcd_barrier_complete(unsigned* bar, unsigned x, unsigned& nloc, unsigned& nx) {
    const unsigned G = gridDim.x * gridDim.y * gridDim.z;
    unsigned sum, cnt, mine, sp = 0u;
    for (;;) {
        sum = 0u; cnt = 0u; mine = 0u;
#pragma unroll
        for (unsigned j = 0; j < 16; ++j) { const unsigned c = xb_ld(&bar[XB_XCNT(j)]); sum += c; cnt += (c > 0u) ? 1u : 0u; mine = (j == x) ? c : mine; }
        if (sum == G) break;
        __builtin_amdgcn_s_sleep(1);
        if ((++sp & 255u) == 0u) { if (xb_ld(&bar[XB_TMO])) break; if (sp > XB_SPIN_CAP) { atomicAdd(&bar[XB_TMO], 1u); break; } }
    }
    nloc = mine > 0u ? mine : 1u; nx = cnt > 0u ? cnt : 1u;
}
__device__ __forceinline__ void xcd_barrier(const XcdBarrier& b) {
    asm volatile("s_waitcnt vmcnt(0)" ::: "memory");
    __syncthreads();
    if (threadIdx.x == 0) {
        unsigned* bar = b.bar;
        __builtin_amdgcn_s_waitcnt(0);
        unsigned nloc = b.st[0], nx = b.st[1];
        if (nloc == 0u) { xcd_barrier_complete(bar, b.x, nloc, nx); b.st[0] = nloc; b.st[1] = nx; }
        const unsigned old = xb_add(&bar[XB_XSUB(b.x)], 1u);
        const unsigned gen = old / nloc;
        if (old + 1u == (gen + 1u) * nloc) {
            __builtin_amdgcn_fence(__ATOMIC_RELEASE, "agent");
            asm volatile("s_waitcnt vmcnt(0)" ::: "memory");
            const unsigned og = xb_add(&bar[XB_TOP], 1u);
            const unsigned tg = og / nx;
            if (og + 1u == (tg + 1u) * nx) xb_add(&bar[XB_TOPGEN], 1u);
            else XB_SPIN(xb_ld(&bar[XB_TOPGEN]) == tg, bar);
            __builtin_amdgcn_fence(__ATOMIC_ACQUIRE, "agent");
            xb_add(&bar[XB_XGEN(b.x)], 1u);
            asm volatile("s_waitcnt vmcnt(0)" ::: "memory");
        } else {
            XB_SPIN(xb_ld(&bar[XB_XGEN(b.x)]) == gen, bar);
            __builtin_amdgcn_fence(__ATOMIC_ACQUIRE, "agent");
            asm volatile("s_waitcnt vmcnt(0)" ::: "memory");
        }
    }
    __syncthreads();
}

constexpr int G_ROWB = 144;
constexpr int G_TILEB = 128 * G_ROWB;
template <bool SWAP = true>
__device__ __forceinline__ void gemm128(const u16* __restrict__ A, int lda, const u16* __restrict__ B, int ldb, int K,
                                        int m0, int n0, char* smem, f32x16 (&acc)[2][2]) {
  const int tid = threadIdx.x, lane = tid & 63, wid = tid >> 6, wm = wid >> 1, wn = wid & 1;
  const int fr = lane & 15, fq = lane >> 4;
  const int ldrow = tid >> 3, ldc = tid & 7;
#pragma unroll
  for (int i = 0; i < 2; ++i)
#pragma unroll
    for (int j = 0; j < 2; ++j)
#pragma unroll
      for (int r = 0; r < 16; ++r) acc[i][j][r] = 0.f;
  const int fr32 = lane & 31, fh = lane >> 5;
  uint4 ra[4], rb[4];
  const u16* ga = A + (size_t)(m0 + ldrow) * lda + ldc * 8;
  const u16* gb = B + (size_t)(n0 + ldrow) * ldb + ldc * 8;
  const int nk = K >> 6;
#pragma unroll
  for (int i = 0; i < 4; ++i) {
    ra[i] = *(const uint4*)(ga + (size_t)(32 * i) * lda);
    rb[i] = *(const uint4*)(gb + (size_t)(32 * i) * ldb);
  }
  {
    char* sa = smem + ldrow * G_ROWB + ldc * 16;
#pragma unroll
    for (int i = 0; i < 4; ++i) {
      *(uint4*)(sa + 32 * i * G_ROWB) = ra[i];
      *(uint4*)(sa + G_TILEB + 32 * i * G_ROWB) = rb[i];
    }
  }
  __syncthreads();
  for (int kt = 0; kt < nk; ++kt) {
    const bool more = (kt + 1 < nk);
    if (more) {
      const int k0 = (kt + 1) << 6;
#pragma unroll
      for (int i = 0; i < 4; ++i) {
        ra[i] = *(const uint4*)(ga + (size_t)(32 * i) * lda + k0);
        rb[i] = *(const uint4*)(gb + (size_t)(32 * i) * ldb + k0);
      }
    }
    const char* cur = smem + (kt & 1) * 2 * G_TILEB;
    const char* sa = cur + (wm * 64 + fr32) * G_ROWB + fh * 16;
    const char* sb = cur + G_TILEB + (wn * 64 + fr32) * G_ROWB + fh * 16;
#pragma unroll
    for (int ks = 0; ks < 4; ++ks) {
      bf16x8 af[2], bfr[2];
#pragma unroll
      for (int i = 0; i < 2; ++i) {
        af[i] = *(const bf16x8*)(sa + i * 32 * G_ROWB + ks * 32);
        bfr[i] = *(const bf16x8*)(sb + i * 32 * G_ROWB + ks * 32);
      }
#pragma unroll
      for (int mi = 0; mi < 2; ++mi)
#pragma unroll
        for (int ni = 0; ni < 2; ++ni)
          acc[mi][ni] = SWAP ? __builtin_amdgcn_mfma_f32_32x32x16_bf16(bfr[ni], af[mi], acc[mi][ni], 0, 0, 0)
                             : __builtin_amdgcn_mfma_f32_32x32x16_bf16(af[mi], bfr[ni], acc[mi][ni], 0, 0, 0);
    }
    if (more) {
      char* nxt = smem + ((kt + 1) & 1) * 2 * G_TILEB + ldrow * G_ROWB + ldc * 16;
#pragma unroll
      for (int i = 0; i < 4; ++i) {
        *(uint4*)(nxt + 32 * i * G_ROWB) = ra[i];
        *(uint4*)(nxt + G_TILEB + 32 * i * G_ROWB) = rb[i];
      }
    }
    __syncthreads();
  }
}

__device__ __forceinline__ void gemm128d(const u16* __restrict__ A, int lda, const u16* __restrict__ B, int ldb, int K,
                                        int m0, int n0, char* smem, f32x16 (&acc)[2][2]) {
  const int tid = threadIdx.x, lane = tid & 63, wid = tid >> 6, wm = wid >> 1, wn = wid & 1;
  const int fr = lane & 15, fq = lane >> 4;
  const int ldrow = tid >> 3, ldc = tid & 7;
#pragma unroll
  for (int i = 0; i < 2; ++i)
#pragma unroll
    for (int j = 0; j < 2; ++j)
#pragma unroll
      for (int r = 0; r < 16; ++r) acc[i][j][r] = 0.f;
  const int fr32 = lane & 31, fh = lane >> 5;
  uint4 ra0_0, ra0_1, ra0_2, ra0_3, rb0_0, rb0_1, rb0_2, rb0_3;
  uint4 ra1_0, ra1_1, ra1_2, ra1_3, rb1_0, rb1_1, rb1_2, rb1_3;
  const u16* ga = A + (size_t)(m0 + ldrow) * lda + ldc * 8;
  const u16* gb = B + (size_t)(n0 + ldrow) * ldb + ldc * 8;
  const int nk = K >> 6;
  char* const sw = smem + ldrow * G_ROWB + ldc * 16;
#define G_LOAD1(RA, RB, I, k0)                                          \
  RA##_##I = *(const uint4*)(ga + (size_t)(32 * I) * lda + k0);         \
  RB##_##I = *(const uint4*)(gb + (size_t)(32 * I) * ldb + k0);
#define G_LOAD(RA, RB, KT)                                              \
  {                                                                     \
    const int k0 = (KT) << 6;                                           \
    G_LOAD1(RA, RB, 0, k0) G_LOAD1(RA, RB, 1, k0) G_LOAD1(RA, RB, 2, k0) G_LOAD1(RA, RB, 3, k0) \
  }
#define G_STORE1(RA, RB, I)                                             \
  *(uint4*)(d + 32 * I * G_ROWB) = RA##_##I;                            \
  *(uint4*)(d + G_TILEB + 32 * I * G_ROWB) = RB##_##I;
#define G_STORE(RA, RB, BUF)                                            \
  {                                                                     \
    char* d = sw + (BUF) * 2 * G_TILEB;                                 \
    G_STORE1(RA, RB, 0) G_STORE1(RA, RB, 1) G_STORE1(RA, RB, 2) G_STORE1(RA, RB, 3) \
  }
#define G_COMPUTE(BUF)                                                                          \
  {                                                                                             \
    const char* cur = smem + (BUF) * 2 * G_TILEB;                                               \
    const char* sa = cur + (wm * 64 + fr32) * G_ROWB + fh * 16;                                 \
    const char* sb = cur + G_TILEB + (wn * 64 + fr32) * G_ROWB + fh * 16;                       \
    _Pragma("unroll") for (int ks = 0; ks < 4; ++ks) {                                          \
      bf16x8 af[2], bfr[2];                                                                     \
      _Pragma("unroll") for (int i = 0; i < 2; ++i) {                                           \
        af[i] = *(const bf16x8*)(sa + i * 32 * G_ROWB + ks * 32);                               \
        bfr[i] = *(const bf16x8*)(sb + i * 32 * G_ROWB + ks * 32);                              \
      }                                                                                         \
      _Pragma("unroll") for (int mi = 0; mi < 2; ++mi)                                          \
      _Pragma("unroll") for (int ni = 0; ni < 2; ++ni)                                          \
        acc[mi][ni] = __builtin_amdgcn_mfma_f32_32x32x16_bf16(bfr[ni], af[mi], acc[mi][ni], 0, 0, 0); \
    }                                                                                           \
  }
  G_LOAD(ra0, rb0, 0)
  G_STORE(ra0, rb0, 0)
  G_LOAD(ra0, rb0, 1)
  if (nk > 2) G_LOAD(ra1, rb1, 2)
  __syncthreads();
  for (int kt = 0; kt < nk; kt += 2) {
    G_COMPUTE(0)
    G_STORE(ra0, rb0, 1)
    if (kt + 3 < nk) G_LOAD(ra0, rb0, kt + 3)
    __syncthreads();
    G_COMPUTE(1)
    if (kt + 2 < nk) {
      G_STORE(ra1, rb1, 0)
      if (kt + 4 < nk) G_LOAD(ra1, rb1, kt + 4)
    }
    __syncthreads();
  }
#undef G_LOAD
#undef G_LOAD1
#undef G_STORE
#undef G_STORE1
#undef G_COMPUTE
}

#define ACC_FOREACH(BODY)                                                            \
  {                                                                                  \
    const int _lane = threadIdx.x & 63, _wid = threadIdx.x >> 6;                     \
    const int _wm = _wid >> 1, _wn = _wid & 1, _fr = _lane & 15, _fq = _lane >> 4;   \
    _Pragma("unroll") for (int mi = 0; mi < 4; ++mi)                                 \
    _Pragma("unroll") for (int ni = 0; ni < 4; ++ni)                                 \
    _Pragma("unroll") for (int j = 0; j < 4; ++j) {                                  \
      const int lrow = _wm * 64 + mi * 16 + _fq * 4 + j;                             \
      const int lcol = _wn * 64 + ni * 16 + _fr;                                     \
      const float v = acc[mi][ni][j];                                                \
      BODY                                                                           \
    }                                                                                \
  }

template <class F>
__device__ __forceinline__ void epi_staged(f32x16 (&acc)[2][2], char* smem, F f) {
  float* st = (float*)smem;
  {
    const int lane = threadIdx.x & 63, wid = threadIdx.x >> 6, wm = wid >> 1, wn = wid & 1, fr32 = lane & 31, fh = lane >> 5;
#pragma unroll
    for (int mi = 0; mi < 2; ++mi)
#pragma unroll
      for (int ni = 0; ni < 2; ++ni)
#pragma unroll
        for (int g = 0; g < 4; ++g)
          *(f32x4*)(st + (wm * 64 + mi * 32 + fr32) * 132 + wn * 64 + ni * 32 + g * 8 + fh * 4) =
              f32x4{acc[mi][ni][g * 4 + 0], acc[mi][ni][g * 4 + 1], acc[mi][ni][g * 4 + 2], acc[mi][ni][g * 4 + 3]};
  }
  __syncthreads();
#pragma unroll 4
  for (int i = threadIdx.x; i < 128 * 32; i += NTHREADS) {
    const int row = i >> 5, c4 = (i & 31) << 2;
    const float4 v = *(const float4*)(st + row * 132 + c4);
    f(row, c4, v);
  }
  __syncthreads();
}

constexpr int H_ROWB = 80;
constexpr int H_A = 256 * H_ROWB, H_B = 128 * H_ROWB, H_STAGE = H_A + H_B;
__device__ __forceinline__ void gemm256(const u16* __restrict__ A, int lda, const u16* __restrict__ B, int ldb, int K,
                                        int m0, int n0, char* smem, f32x16 (&acc)[4][2]) {
  const int tid = threadIdx.x, lane = tid & 63, wid = tid >> 6, wm = wid >> 1, wn = wid & 1;
  const int fr32 = lane & 31, fh = lane >> 5;
#pragma unroll
  for (int i = 0; i < 4; ++i)
#pragma unroll
    for (int j = 0; j < 2; ++j)
#pragma unroll
      for (int r = 0; r < 16; ++r) acc[i][j][r] = 0.f;
  const int ldrow = tid >> 2, ldc = tid & 3;
  const u16* ga = A + (size_t)(m0 + ldrow) * lda + ldc * 8;
  const u16* gb = B + (size_t)(n0 + ldrow) * ldb + ldc * 8;
  uint4 a0, a1, a2, a3, b0, b1;
  uint4 c0, c1, c2, c3, d0, d1;
  const int nk = K >> 5;
  char* const swa = smem + ldrow * H_ROWB + ldc * 16;
  char* const swb = smem + H_A + ldrow * H_ROWB + ldc * 16;
#define H_LOAD(k0, A0, A1, A2, A3, B0, B1)                      \
  A0 = *(const uint4*)(ga + (k0));                              \
  A1 = *(const uint4*)(ga + (size_t)64 * lda + (k0));           \
  A2 = *(const uint4*)(ga + (size_t)128 * lda + (k0));          \
  A3 = *(const uint4*)(ga + (size_t)192 * lda + (k0));          \
  B0 = *(const uint4*)(gb + (k0));                              \
  B1 = *(const uint4*)(gb + (size_t)64 * ldb + (k0));
#define H_STORE(BUF, A0, A1, A2, A3, B0, B1)                    \
  *(uint4*)(swa + (BUF) * H_STAGE) = A0;                        \
  *(uint4*)(swa + (BUF) * H_STAGE + 64 * H_ROWB) = A1;          \
  *(uint4*)(swa + (BUF) * H_STAGE + 128 * H_ROWB) = A2;         \
  *(uint4*)(swa + (BUF) * H_STAGE + 192 * H_ROWB) = A3;         \
  *(uint4*)(swb + (BUF) * H_STAGE) = B0;                        \
  *(uint4*)(swb + (BUF) * H_STAGE + 64 * H_ROWB) = B1;
#define H_COMPUTE(BUF)                                                                          \
  {                                                                                             \
    const char* cur = smem + (BUF) * H_STAGE;                                                   \
    const char* sa = cur + (wm * 128 + fr32) * H_ROWB + fh * 16;                                \
    const char* sb = cur + H_A + (wn * 64 + fr32) * H_ROWB + fh * 16;                           \
    _Pragma("unroll") for (int ks = 0; ks < 2; ++ks) {                                          \
      bf16x8 af[4], bfr[2];                                                                     \
      _Pragma("unroll") for (int i = 0; i < 4; ++i) af[i] = *(const bf16x8*)(sa + i * 32 * H_ROWB + ks * 32); \
      _Pragma("unroll") for (int i = 0; i < 2; ++i) bfr[i] = *(const bf16x8*)(sb + i * 32 * H_ROWB + ks * 32); \
      _Pragma("unroll") for (int mi = 0; mi < 4; ++mi)                                          \
      _Pragma("unroll") for (int ni = 0; ni < 2; ++ni)                                          \
        acc[mi][ni] = __builtin_amdgcn_mfma_f32_32x32x16_bf16(bfr[ni], af[mi], acc[mi][ni], 0, 0, 0); \
    }                                                                                           \
  }
  H_LOAD(0, a0, a1, a2, a3, b0, b1)
  H_STORE(0, a0, a1, a2, a3, b0, b1)
  H_LOAD(32, a0, a1, a2, a3, b0, b1)
  if (nk > 2) { H_LOAD(64, c0, c1, c2, c3, d0, d1) }
  __syncthreads();
  for (int kt = 0; kt < nk; kt += 2) {
    H_COMPUTE(0)
    H_STORE(1, a0, a1, a2, a3, b0, b1)
    if (kt + 3 < nk) { const int k0 = (kt + 3) << 5; H_LOAD(k0, a0, a1, a2, a3, b0, b1) }
    __syncthreads();
    H_COMPUTE(1)
    if (kt + 2 < nk) {
      H_STORE(0, c0, c1, c2, c3, d0, d1)
      if (kt + 4 < nk) { const int k0 = (kt + 4) << 5; H_LOAD(k0, c0, c1, c2, c3, d0, d1) }
    }
    __syncthreads();
  }
#undef H_COMPUTE
#undef H_LOAD
#undef H_STORE
}
template <class F>
__device__ __forceinline__ void epi_staged256(f32x16 (&acc)[4][2], char* smem, F f) {
  float* st = (float*)smem;
  const int lane = threadIdx.x & 63, wid = threadIdx.x >> 6, wm = wid >> 1, wn = wid & 1, fr32 = lane & 31, fh = lane >> 5;
#pragma unroll
  for (int half = 0; half < 2; ++half) {
    if (wm == half) {
#pragma unroll
      for (int mi = 0; mi < 4; ++mi)
#pragma unroll
        for (int ni = 0; ni < 2; ++ni)
#pragma unroll
          for (int g = 0; g < 4; ++g)
            *(f32x4*)(st + (mi * 32 + fr32) * 132 + wn * 64 + ni * 32 + g * 8 + fh * 4) =
                f32x4{acc[mi][ni][g * 4 + 0], acc[mi][ni][g * 4 + 1], acc[mi][ni][g * 4 + 2], acc[mi][ni][g * 4 + 3]};
    }
    __syncthreads();
#pragma unroll 4
    for (int i = threadIdx.x; i < 128 * 32; i += NTHREADS) {
      const int row = i >> 5, c4 = (i & 31) << 2;
      const float4 v = *(const float4*)(st + row * 132 + c4);
      f(half * 128 + row, c4, v);
    }
    __syncthreads();
  }
}

__device__ __forceinline__ void transpose_tile(const float* __restrict__ W, int N, u16* __restrict__ Wt, int K, int k0, int n0, float* lds) {
  const int tid = threadIdx.x;
  __syncthreads();
#pragma unroll
  for (int i = 0; i < 16; ++i) {
    int k = i * 4 + (tid >> 6), n = tid & 63;
    lds[k * 65 + n] = W[(size_t)(k0 + k) * N + n0 + n];
  }
  __syncthreads();
#pragma unroll
  for (int i = 0; i < 16; ++i) {
    int n = i * 4 + (tid >> 6), k = tid & 63;
    Wt[(size_t)(n0 + n) * K + k0 + k] = f2bf(lds[k * 65 + n]);
  }
}

__device__ __forceinline__ void phase_prep(const Params& p, char* smem) {
  const int tid = threadIdx.x;
  float* lds = (float*)smem;
  u16* WIN = (u16*)(p.ws + OFF_WIN);
  u16* WOUT = (u16*)(p.ws + OFF_WOUT);
  u16* WLORA = (u16*)(p.ws + OFF_WLORA);
  u16* KEYS = (u16*)(p.ws + OFF_KEYS);
  float* MOD = (float*)(p.ws + OFF_MOD);
  constexpr int N_MOD = 96, N_T1 = 44 * 16, N_T2 = 16 * 16, N_T3 = 0;
  constexpr int N_TASK = N_MOD + N_T1 + N_T2 + N_T3;
  for (int task = blockIdx.x; task < N_TASK; task += gridDim.x) {
    if (task < N_MOD) {
      __syncthreads();
      for (int i = tid; i < 8 * 1024; i += NTHREADS) lds[i] = siluf_(p.c[i]);
      __syncthreads();
      const int lane = tid & 63, w = tid >> 6;
      const int col = task * 64 + lane;
      float a[8];
#pragma unroll
      for (int b = 0; b < 8; ++b) a[b] = 0.f;
      const float* wp = p.ada_w + (size_t)(w * 256) * 6144 + col;
#pragma unroll 8
      for (int k = 0; k < 256; ++k) {
        float wv = wp[(size_t)k * 6144];
#pragma unroll
        for (int b = 0; b < 8; ++b) a[b] += lds[b * 1024 + w * 256 + k] * wv;
      }
      __syncthreads();
#pragma unroll
      for (int b = 0; b < 8; ++b) lds[8192 + (w * 8 + b) * 64 + lane] = a[b];
      __syncthreads();
      for (int i = tid; i < 512; i += NTHREADS) {
        int b = i >> 6, l = i & 63;
        float s = lds[8192 + (0 * 8 + b) * 64 + l] + lds[8192 + (1 * 8 + b) * 64 + l] + lds[8192 + (2 * 8 + b) * 64 + l] +
                  lds[8192 + (3 * 8 + b) * 64 + l];
        MOD[b * 6144 + task * 64 + l] = s + p.ada_b[task * 64 + l];
      }
    } else {
      int t = task - N_MOD;
      if (t < N_T1) {
        transpose_tile(p.w_in, NPROJ, WIN, D, (t & 15) * 64, (t >> 4) * 64, lds);
      } else if (t < N_T1 + N_T2) {
        t -= N_T1;
        transpose_tile(p.w_out, D, WOUT, D, (t & 15) * 64, (t >> 4) * 64, lds);
      }
    }
  }
  const size_t gtid = (size_t)blockIdx.x * NTHREADS + tid, gn = (size_t)gridDim.x * NTHREADS;
  for (size_t i = gtid; i < (size_t)1536 * 256; i += gn) {
    int n = (int)(i >> 8), k = (int)(i & 255);
    float v = 0.f;
    if (n < 512) { if (k < 64) v = p.w2[k * 512 + n]; }
    else if (n < 1024) { if (k >= 64 && k < 128) v = p.a2[(k - 64) * 512 + (n - 512)]; }
    else { if (k >= 128) v = p.g2[(k - 128) * 512 + (n - 1024)]; }
    WLORA[i] = f2bf(v);
  }
  for (size_t i = gtid; i < (size_t)16 * 128 * 128; i += gn) KEYS[i] = f2bf(p.sub_keys[i]);
  {
    uint2* WQB = (uint2*)(p.ws + OFF_REGF);
    const float4* wq4 = (const float4*)p.w_q;
    for (size_t i = gtid; i < (size_t)1024 * 2048 / 4; i += gn) {
      const float4 v = wq4[i];
      WQB[i] = make_uint2(pack2(v.x, v.y), pack2(v.z, v.w));
    }
  }
}

__device__ __forceinline__ void phase_peer_fold(const Params& p, char* smem) {
  const u16* KEYS = (const u16*)(p.ws + OFF_KEYS);
  const u16* WQB = (const u16*)(p.ws + OFF_REGF);
  u16* MT = (u16*)(p.ws + OFF_WQ);
  for (int tile = blockIdx.x; tile < 16 * 8; tile += gridDim.x) {
    const int hp = tile >> 3, dt = tile & 7;
    f32x16 acc[2][2];
    gemm128(KEYS + (size_t)hp * 128 * 128, 128, WQB + hp * 128, 2048, 128, 0, dt * 128, smem, acc);
    epi_staged(acc, smem, [&](int row, int c4, float4 v) {
      *(uint2*)(MT + (size_t)(hp * 128 + row) * D + dt * 128 + c4) = make_uint2(pack2(v.x, v.y), pack2(v.z, v.w));
    });
  }
}

__device__ __forceinline__ void phase_normmod(const float* __restrict__ X, const float* __restrict__ g, const float* __restrict__ MOD,
                              int sh_off, int sc_off, u16* __restrict__ U) {
  const int lane = threadIdx.x & 63;
  const int gw = blockIdx.x * 4 + (threadIdx.x >> 6), nw = gridDim.x * 4;
  for (int t = gw; t < T; t += nw) {
    const int b = t / SEQ;
    const float4* xr = (const float4*)(X + (size_t)t * D);
    float4 v[4];
    float ss = 0.f;
#pragma unroll
    for (int i = 0; i < 4; ++i) {
      v[i] = xr[i * 64 + lane];
      ss += v[i].x * v[i].x + v[i].y * v[i].y + v[i].z * v[i].z + v[i].w * v[i].w;
    }
    ss = wave_sum(ss);
    const float rstd = rsqrtf(ss * (1.0f / D) + 1e-6f);
    const float4* gp = (const float4*)g;
    const float4* shp = (const float4*)(MOD + b * 6144 + sh_off);
    const float4* scp = (const float4*)(MOD + b * 6144 + sc_off);
    uint2* up = (uint2*)(U + (size_t)t * D);
#pragma unroll
    for (int i = 0; i < 4; ++i) {
      float4 gg = gp[i * 64 + lane], sh = shp[i * 64 + lane], sc = scp[i * 64 + lane];
      float o0 = v[i].x * rstd * gg.x * (1.f + sc.x) + sh.x;
      float o1 = v[i].y * rstd * gg.y * (1.f + sc.y) + sh.y;
      float o2 = v[i].z * rstd * gg.z * (1.f + sc.z) + sh.z;
      float o3 = v[i].w * rstd * gg.w * (1.f + sc.w) + sh.w;
      up[i * 64 + lane] = make_uint2(pack2(o0, o1), pack2(o2, o3));
    }
  }
}

__device__ __forceinline__ void phase_gemm_in(const Params& p, char* smem) {
  const u16* U1 = (const u16*)(p.ws + OFF_REGB);
  const u16* WIN = (const u16*)(p.ws + OFF_WIN);
  u16* P = (u16*)(p.ws + OFF_REGC);
  constexpr int NT = NPROJ / 128, MT = T / 256;
  for (int tile = blockIdx.x; tile < NT * MT; tile += gridDim.x) {
    const int mt = tile / NT, nt = tile % NT;
    f32x16 acc[4][2];
    gemm256(U1, D, WIN, D, D, mt * 256, nt * 128, smem, acc);
    epi_staged256(acc, smem, [&](int row, int c4, float4 v) {
      u16* dst = (nt < 8) ? (P + (size_t)(mt * 256 + row) * 1024 + nt * 128 + c4)
                          : (P + (size_t)32 * MB + (size_t)(mt * 256 + row) * 1792 + (nt - 8) * 128 + c4);
      *(uint2*)dst = make_uint2(pack2(v.x, v.y), pack2(v.z, v.w));
    });
  }
}

__device__ __forceinline__ void phase_act(const Params& p) {
  const u16* P = (const u16*)(p.ws + OFF_PR);
  u16* ACT = (u16*)(p.ws + OFF_REGF + 128 * MB);
  const size_t gtid = (size_t)blockIdx.x * NTHREADS + threadIdx.x, gn = (size_t)gridDim.x * NTHREADS;
  for (size_t i = gtid; i < (size_t)T * 64; i += gn) {
    const int t = (int)(i >> 6), c = (int)(i & 63) * 4;
    const u16* pr = P + (size_t)t * 1792 + 1536 + c;
    uint2 cur = *(const uint2*)pr;
    uint2 prv = make_uint2(0u, 0u);
    if ((t % SEQ) != 0) prv = *(const uint2*)(pr - 1792);
    float4 m = *(const float4*)(p.mu + 1536 + c);
    float x0 = bflo(cur.x), x1 = bfhi(cur.x), x2 = bflo(cur.y), x3 = bfhi(cur.y);
    x0 += m.x * (bflo(prv.x) - x0);
    x1 += m.y * (bfhi(prv.x) - x1);
    x2 += m.z * (bflo(prv.y) - x2);
    x3 += m.w * (bfhi(prv.y) - x3);
    if (c < 64) { x0 = tanhf_(x0); x1 = tanhf_(x1); x2 = tanhf_(x2); x3 = tanhf_(x3); }
    else if (c >= 128) { x0 = sigmoidf_(x0); x1 = sigmoidf_(x1); x2 = sigmoidf_(x2); x3 = sigmoidf_(x3); }
    *(uint2*)(ACT + (size_t)t * 256 + c) = make_uint2(pack2(x0, x1), pack2(x2, x3));
  }
}

__device__ __forceinline__ void conv_tile(const Params& p, int tile, char* smem) {
  const u16* P = (const u16*)(p.ws + OFF_PC);
  u16* MIXIN = (u16*)(p.ws + OFF_REGB);
  const int tid = threadIdx.x, lane = tid & 63, wid = tid >> 6;
  u32* ylds = (u32*)smem;
  float* olds = (float*)(smem + 62 * 1024);
  const int tok0 = tile * 32;
  const int s0 = tok0 % SEQ;
  __syncthreads();
  for (int r = 0; r < 62; ++r) {
    const int s = s0 - 30 + r;
    u32 val = 0u;
    if (s >= 0) {
      const u16* pr = P + (size_t)(tok0 - 30 + r) * 1024;
      u32 a = *(const u32*)(pr + 2 * tid);
      u32 bq = *(const u32*)(pr + 512 + 2 * tid);
      val = pack2(bflo(a) * sigmoidf_(bflo(bq)), bfhi(a) * sigmoidf_(bfhi(bq)));
    }
    ylds[r * 256 + tid] = val;
  }
  __syncthreads();
  float w0[31], w1[31];
#pragma unroll
  for (int j = 0; j < 31; ++j) {
    const float2 wv = *(const float2*)(p.conv_w + j * 512 + 2 * tid);
    w0[j] = wv.x; w1[j] = wv.y;
  }
  const float2 bias = *(const float2*)(p.conv_b + 2 * tid);
  for (int sub = 0; sub < 4; ++sub) {
    float a0[8], a1[8];
#pragma unroll
    for (int q = 0; q < 8; ++q) { a0[q] = bias.x; a1[q] = bias.y; }
#pragma unroll
    for (int rr = 0; rr < 38; ++rr) {
      const u32 yv = ylds[(sub * 8 + rr) * 256 + tid];
      const float y0 = bflo(yv), y1 = bfhi(yv);
#pragma unroll
      for (int q = 0; q < 8; ++q) {
        const int j = rr - q;
        if (j >= 0 && j < 31) { a0[q] += w0[j] * y0; a1[q] += w1[j] * y1; }
      }
    }
#pragma unroll
    for (int q = 0; q < 8; ++q) *(float2*)(olds + q * 512 + 2 * tid) = make_float2(a0[q], a1[q]);
    __syncthreads();
#pragma unroll
    for (int q2 = 0; q2 < 2; ++q2) {
      const int q = wid * 2 + q2;
      const float4 va = *(const float4*)(olds + q * 512 + lane * 8);
      const float4 vb = *(const float4*)(olds + q * 512 + lane * 8 + 4);
      float s = va.x + va.y + va.z + va.w + vb.x + vb.y + vb.z + vb.w;
      s = wave_sum(s);
      const float mean = s * (1.0f / 512.f);
      float d[8] = {va.x - mean, va.y - mean, va.z - mean, va.w - mean, vb.x - mean, vb.y - mean, vb.z - mean, vb.w - mean};
      float vs = 0.f;
#pragma unroll
      for (int e = 0; e < 8; ++e) vs += d[e] * d[e];
      vs = wave_sum(vs);
      const float rstd = rsqrtf(vs * (1.0f / 512.f) + 1e-5f);
      const float4 lw0 = *(const float4*)(p.ln_w + lane * 8), lw1 = *(const float4*)(p.ln_w + lane * 8 + 4);
      const float4 lb0 = *(const float4*)(p.ln_b + lane * 8), lb1 = *(const float4*)(p.ln_b + lane * 8 + 4);
      const float lw[8] = {lw0.x, lw0.y, lw0.z, lw0.w, lw1.x, lw1.y, lw1.z, lw1.w};
      const float lb[8] = {lb0.x, lb0.y, lb0.z, lb0.w, lb1.x, lb1.y, lb1.z, lb1.w};
      float o[8];
#pragma unroll
      for (int e = 0; e < 8; ++e) o[e] = siluf_(d[e] * rstd * lw[e] + lb[e]);
      uint4 pk = make_uint4(pack2(o[0], o[1]), pack2(o[2], o[3]), pack2(o[4], o[5]), pack2(o[6], o[7]));
      *(uint4*)(MIXIN + (size_t)(tok0 + sub * 8 + q) * D + lane * 8) = pk;
    }
    __syncthreads();
  }
}

__device__ __forceinline__ void phase_lora_conv(const Params& p, char* smem) {
  const u16* ACT = (const u16*)(p.ws + OFF_REGF + 128 * MB);
  const u16* WLORA = (const u16*)(p.ws + OFF_WLORA);
  u16* LW = (u16*)(p.ws + OFF_REGF);
  u16* AA = (u16*)(p.ws + OFF_REGD);
  u16* GG = (u16*)(p.ws + OFF_REGD + 32 * MB);
  constexpr int NT = 12, MT = T / 128, NG = NT * MT, NC = T / 32;
  for (int task = blockIdx.x; task < NG; task += gridDim.x) {
    {
      const int mt = task / NT, nt = task % NT;
      f32x16 acc[2][2];
      const int k0 = (nt < 8) ? 0 : 128;
      gemm128d(ACT + k0, 256, WLORA + k0, 256, 128, mt * 128, nt * 128, smem, acc);
      if (nt < 4) {
        epi_staged(acc, smem, [&](int row, int c4, float4 v) {
          const int n = nt * 128 + c4;
          const float4 w0 = *(const float4*)(p.w0 + n);
          const float vv[4] = {v.x + w0.x, v.y + w0.y, v.z + w0.z, v.w + w0.w};
          float o[4];
#pragma unroll
          for (int e = 0; e < 4; ++e) {
            const float z = -vv[e];
            const float sp = fmaxf(z, 0.f) + __logf(1.0f + __expf(-fabsf(z)));
            o[e] = -__expf(-sp - 0.5f);
          }
          *(uint2*)(LW + (size_t)(mt * 128 + row) * 512 + n) = make_uint2(pack2(o[0], o[1]), pack2(o[2], o[3]));
        });
      } else if (nt < 8) {
        epi_staged(acc, smem, [&](int row, int c4, float4 v) {
          const int n = (nt - 4) * 128 + c4;
          const float4 a0 = *(const float4*)(p.a0 + n);
          *(uint2*)(AA + (size_t)(mt * 128 + row) * 512 + n) =
              make_uint2(pack2(sigmoidf_(a0.x + v.x), sigmoidf_(a0.y + v.y)), pack2(sigmoidf_(a0.z + v.z), sigmoidf_(a0.w + v.w)));
        });
      } else {
        epi_staged(acc, smem, [&](int row, int c4, float4 v) {
          const int n = (nt - 8) * 128 + c4;
          *(uint2*)(GG + (size_t)(mt * 128 + row) * 512 + n) = make_uint2(pack2(v.x, v.y), pack2(v.z, v.w));
        });
      }
    }
  }
}

__device__ __forceinline__ void phase_scanprep(const Params& p) {
  const u16* P = (const u16*)(p.ws + OFF_PR);
  const u16* AA = (const u16*)(p.ws + OFF_REGD);
  u16* R = (u16*)(p.ws + OFF_REGF + 32 * MB);
  u16* KM = (u16*)(p.ws + OFF_REGF + 64 * MB);
  u16* V = (u16*)(p.ws + OFF_REGF + 96 * MB);
  u16* KKN = (u16*)(p.ws + OFF_REGF + 128 * MB);
  float* BONUS = (float*)(p.ws + OFF_BONUS);
  const int tid = threadIdx.x;
  const int c = (tid & 127) * 4;
  const float4 mur = *(const float4*)(p.mu + c), muk = *(const float4*)(p.mu + 512 + c), muv = *(const float4*)(p.mu + 1024 + c);
  const float4 kk_ = *(const float4*)(p.k_k + c), ka_ = *(const float4*)(p.k_a + c), rk_ = *(const float4*)(p.r_k + c);
  for (int tp = blockIdx.x; tp < T / 2; tp += gridDim.x) {
    const int t = tp * 2 + (tid >> 7);
    const bool first = (t % SEQ) == 0;
    const u16* pr = P + (size_t)t * 1792 + c;
    float r[4], k[4], v[4];
    {
      uint2 cu = *(const uint2*)pr, pv = first ? make_uint2(0u, 0u) : *(const uint2*)(pr - 1792);
      r[0] = bflo(cu.x); r[1] = bfhi(cu.x); r[2] = bflo(cu.y); r[3] = bfhi(cu.y);
      r[0] += mur.x * (bflo(pv.x) - r[0]); r[1] += mur.y * (bfhi(pv.x) - r[1]);
      r[2] += mur.z * (bflo(pv.y) - r[2]); r[3] += mur.w * (bfhi(pv.y) - r[3]);
    }
    {
      uint2 cu = *(const uint2*)(pr + 512), pv = first ? make_uint2(0u, 0u) : *(const uint2*)(pr + 512 - 1792);
      k[0] = bflo(cu.x); k[1] = bfhi(cu.x); k[2] = bflo(cu.y); k[3] = bfhi(cu.y);
      k[0] += muk.x * (bflo(pv.x) - k[0]); k[1] += muk.y * (bfhi(pv.x) - k[1]);
      k[2] += muk.z * (bflo(pv.y) - k[2]); k[3] += muk.w * (bfhi(pv.y) - k[3]);
    }
    {
      uint2 cu = *(const uint2*)(pr + 1024), pv = first ? make_uint2(0u, 0u) : *(const uint2*)(pr + 1024 - 1792);
      v[0] = bflo(cu.x); v[1] = bfhi(cu.x); v[2] = bflo(cu.y); v[3] = bfhi(cu.y);
      v[0] += muv.x * (bflo(pv.x) - v[0]); v[1] += muv.y * (bfhi(pv.x) - v[1]);
      v[2] += muv.z * (bflo(pv.y) - v[2]); v[3] += muv.w * (bfhi(pv.y) - v[3]);
    }
    const uint2 au = *(const uint2*)(AA + (size_t)t * 512 + c);
    const float a[4] = {bflo(au.x), bfhi(au.x), bflo(au.y), bfhi(au.y)};
    const float kkc[4] = {kk_.x, kk_.y, kk_.z, kk_.w}, kac[4] = {ka_.x, ka_.y, ka_.z, ka_.w}, rkc[4] = {rk_.x, rk_.y, rk_.z, rk_.w};
    float kk[4], km[4];
    float n2 = 0.f, bs = 0.f;
#pragma unroll
    for (int e = 0; e < 4; ++e) {
      kk[e] = k[e] * kkc[e];
      km[e] = k[e] * (1.f + (a[e] - 1.f) * kac[e]);
      n2 += kk[e] * kk[e];
      bs += r[e] * km[e] * rkc[e];
    }
    n2 = row16_sum(n2);
    bs = row16_sum(bs);
    const float inv = fminf(__builtin_amdgcn_rsqf(n2), 1e12f);
    const size_t o = (size_t)t * 512 + c;
    *(uint2*)(R + o) = make_uint2(pack2(r[0], r[1]), pack2(r[2], r[3]));
    *(uint2*)(KM + o) = make_uint2(pack2(km[0], km[1]), pack2(km[2], km[3]));
    *(uint2*)(V + o) = make_uint2(pack2(v[0], v[1]), pack2(v[2], v[3]));
    *(uint2*)(KKN + o) = make_uint2(pack2(kk[0] * inv, kk[1] * inv), pack2(kk[2] * inv, kk[3] * inv));
    if ((tid & 15) == 0) BONUS[(size_t)t * 8 + (c >> 6)] = bs;
  }
}

constexpr size_t OFF_EU8 = OFF_REGC + 128 * MB;
constexpr size_t OFF_EV8 = OFF_REGC + 144 * MB;
constexpr int CVT_CHUNKS = 256;
__device__ __forceinline__ void cvt_chunk(const Params& p, int chunk) {
  u32* EU = (u32*)(p.ws + OFF_EU8);
  u32* EV = (u32*)(p.ws + OFF_EV8);
  const float4* su = (const float4*)p.peer_u;
  const float4* sv = (const float4*)p.peer_v;
  const size_t base = (size_t)chunk * 16384;
#pragma unroll 4
  for (int q = 0; q < 64; ++q) {
    const size_t i = base + q * 256 + threadIdx.x;
    const float4 a = su[i], b = sv[i];
    int va = 0, vb = 0;
    va = __builtin_amdgcn_cvt_pk_fp8_f32(a.x * 512.f, a.y * 512.f, va, false);
    va = __builtin_amdgcn_cvt_pk_fp8_f32(a.z * 512.f, a.w * 512.f, va, true);
    vb = __builtin_amdgcn_cvt_pk_fp8_f32(b.x * 128.f, b.y * 128.f, vb, false);
    vb = __builtin_amdgcn_cvt_pk_fp8_f32(b.z * 128.f, b.w * 128.f, vb, true);
    EU[i] = (u32)va;
    EV[i] = (u32)vb;
  }
}

__device__ __forceinline__ void mix_unit(const Params& p, int u, char* smem) {
  for (int ci = 0; ci < 4; ++ci) conv_tile(p, u * 4 + ci, smem);
}

template <int OFF>
__device__ __forceinline__ f32x4 lds_ld4(unsigned addr) {
  f32x4 r;
  asm volatile("ds_read_b128 %0, %1 offset:%2" : "=v"(r) : "v"(addr), "n"(OFF));
  return r;
}
template <int OFF>
__device__ __forceinline__ float lds_ld1(unsigned addr) {
  float r;
  asm volatile("ds_read_b32 %0, %1 offset:%2" : "=v"(r) : "v"(addr), "n"(OFF));
  return r;
}
constexpr int SC_BUF = 27648;
template <int OFF>
__device__ __forceinline__ v2f lds_ld2(unsigned addr) {
  v2f r;
  asm volatile("ds_read_b64 %0, %1 offset:%2" : "=v"(r) : "v"(addr), "n"(OFF));
  return r;
}
__device__ __forceinline__ void phase_scan(const Params& p, char* smem, int rep) {
  const u16* LW = (const u16*)(p.ws + OFF_REGF);
  const u16* R = (const u16*)(p.ws + OFF_REGF + 32 * MB);
  const u16* KM = (const u16*)(p.ws + OFF_REGF + 64 * MB);
  const u16* V = (const u16*)(p.ws + OFF_REGF + 96 * MB);
  const u16* KKN = (const u16*)(p.ws + OFF_REGF + 128 * MB);
  const u16* AA = (const u16*)(p.ws + OFF_REGD);
  float* Y = (float*)(p.ws + OFF_Y);
  const int tid = threadIdx.x, lane = tid & 63, w = tid >> 6;
  const int jl = lane & 15;
  const int ss = tid >> 4, sg = tid & 15;
  unsigned* claim = (unsigned*)(p.ws + OFF_BAR) + XCD_BAR_WORDS + rep * (2048 + 64);
  unsigned* qctr = claim + 2048;
  int* sflag = (int*)(smem + 2 * SC_BUF);
  float* ypw = (float*)(smem + 56320) + w * 1024;
  const unsigned sbase = (unsigned)(size_t)(LAS char*)smem;
  if (tid == 0) {
    const unsigned key = (xb_xcc_id() & 7u) * 256u + (((unsigned)__builtin_amdgcn_s_getreg(63492) >> 8) & 0xffu);
    sflag[0] = (atomicAdd(&claim[key], 1u) == 0u) ? 1 : 0;
  }
  __syncthreads();
  const bool scan_role = sflag[0] != 0;
  for (;;) {
    if (!scan_role) break;
    __syncthreads();
    if (tid == 0) sflag[1] = (int)atomicAdd(&qctr[0], 1u);
    __syncthreads();
    const int task = sflag[1];
    if (task >= 256) break;
    const int bh = task >> 2, rg = task & 3, b = bh >> 3, h = bh & 7;
    const int il = rg * 16 + w * 4 + (lane >> 4);
    v2f Sa = v2f{0.f, 0.f}, Sb = v2f{0.f, 0.f};
    const size_t base = (size_t)b * SEQ * 512 + h * 64 + sg * 4;
    uint2 gA_lw, gA_r, gA_km, gA_v, gA_kkn, gA_a;
    uint2 gB_lw, gB_r, gB_km, gB_v, gB_kkn, gB_a;
#define SC_GLOAD(X, t0)                                      \
  {                                                          \
    const size_t o = base + (size_t)((t0) + ss) * 512;       \
    X##_lw = *(const uint2*)(LW + o); X##_r = *(const uint2*)(R + o);   \
    X##_km = *(const uint2*)(KM + o); X##_v = *(const uint2*)(V + o);   \
    X##_kkn = *(const uint2*)(KKN + o); X##_a = *(const uint2*)(AA + o); \
  }
#define SC_STORE(X, bi)                                                                                \
  {                                                                                                    \
    float* d = (float*)(smem + (bi) * SC_BUF) + ss * 64 + sg * 4;                                      \
    const float4 kq = make_float4(bflo(X##_kkn.x), bfhi(X##_kkn.x), bflo(X##_kkn.y), bfhi(X##_kkn.y)); \
    *(float4*)(d) = make_float4(__expf(bflo(X##_lw.x)), __expf(bfhi(X##_lw.x)), __expf(bflo(X##_lw.y)), __expf(bfhi(X##_lw.y))); \
    *(float4*)(d + 1024) = kq;                                                                         \
    *(float4*)(d + 2048) = make_float4(kq.x * bflo(X##_a.x), kq.y * bfhi(X##_a.x), kq.z * bflo(X##_a.y), kq.w * bfhi(X##_a.y)); \
    *(float4*)(d + 3072) = make_float4(bflo(X##_km.x), bfhi(X##_km.x), bflo(X##_km.y), bfhi(X##_km.y)); \
    *(float4*)(d + 4096) = make_float4(bflo(X##_r.x), bfhi(X##_r.x), bflo(X##_r.y), bfhi(X##_r.y));    \
    float* vt = (float*)(smem + (bi) * SC_BUF) + 5120 + (sg * 4) * 16 + ss;     \
    vt[0] = bflo(X##_v.x); vt[16] = bfhi(X##_v.x); vt[32] = bflo(X##_v.y); vt[48] = bfhi(X##_v.y);     \
  }
#define SC_ISSUE(sl, S)                                     \
  {                                                         \
    dec_[sl] = lds_ld4<(S) * 256>(a0);                      \
    kkn_[sl] = lds_ld4<4096 + (S) * 256>(a0);               \
    km_[sl] = lds_ld4<12288 + (S) * 256>(a0);               \
    if (((S) & 3) == 0) vq_[((S) >> 2) & 1] = lds_ld4<20480 + (S) * 4>(a1); \
    nb_[sl] = lds_ld4<8192 + (S) * 256>(a0);                \
    rr_[sl] = lds_ld4<16384 + (S) * 256>(a0);               \
  }
#define SC_WAIT(N, sl)                                                                          \
  asm volatile("s_waitcnt lgkmcnt(" #N ")"                                                      \
               : "+v"(dec_[sl]), "+v"(kkn_[sl]), "+v"(nb_[sl]), "+v"(km_[sl]), "+v"(rr_[sl]), "+v"(vq_[0]), "+v"(vq_[1]));
#define LO2(q) (v2f{(q).x, (q).y})
#define HI2(q) (v2f{(q).z, (q).w})
#define SC_STEP(S, N)                                                                       \
  {                                                                                         \
    if ((S) + 2 < 16) SC_ISSUE(((S) + 2) % 3, (S) + 2)                                      \
    SC_WAIT(N, (S) % 3)                                                                     \
    const f32x4 dec = dec_[(S) % 3], kkn = kkn_[(S) % 3], nb = nb_[(S) % 3], km = km_[(S) % 3], rr = rr_[(S) % 3]; \
    const float vv = vq_[((S) >> 2) & 1][(S) & 3];                                          \
    const v2f v2 = v2f{vv, vv};                                                             \
    const v2f Ta = Sa * LO2(dec) + v2 * LO2(km);                                            \
    const v2f Tb = Sb * HI2(dec) + v2 * HI2(km);                                            \
    const v2f dv = Sa * LO2(kkn) + Sb * HI2(kkn);                                           \
    float dot = dv.x + dv.y;                                                                \
    if ((S) > 0) {     \
      dot += DPP_ROR(dot, 8); ypend += DPP_ROR(ypend, 8);                                   \
      dot += DPP_ROR(dot, 4); ypend += DPP_ROR(ypend, 4);                                   \
      dot += DPP_ROR(dot, 2); ypend += DPP_ROR(ypend, 2);                                   \
      dot += DPP_ROR(dot, 1); ypend += DPP_ROR(ypend, 1);                                   \
      ykeep = (jl == (S) - 1) ? ypend : ykeep;                                              \
    } else {                                                                                \
      dot = row16_sum(dot);                                                                 \
    }                                                                                       \
    const v2f d2 = v2f{dot, dot};                                                           \
    Sa = Ta - d2 * LO2(nb);                                                                 \
    Sb = Tb - d2 * HI2(nb);                                                                 \
    const v2f yv = Sa * LO2(rr) + Sb * HI2(rr);                                             \
    ypend = yv.x + yv.y;                                                                    \
    if ((S) == 15) { ypend = row16_sum(ypend); ykeep = (jl == 15) ? ypend : ykeep; }        \
  }
#define SC_COMPUTE(c)                                                                       \
  {                                                                                         \
    const unsigned a0 = sbase + (unsigned)(((c) & 1) * SC_BUF + jl * 16);                   \
    const unsigned a1 = sbase + (unsigned)(((c) & 1) * SC_BUF + il * 64);                   \
    f32x4 dec_[3], kkn_[3], nb_[3], km_[3], rr_[3], vq_[2];                                 \
    float ykeep = 0.f, ypend = 0.f;                                                         \
    SC_ISSUE(0, 0)                                                                          \
    SC_ISSUE(1, 1)                                                                          \
    SC_STEP(0, 10) SC_STEP(1, 10) SC_STEP(2, 10) SC_STEP(3, 10) SC_STEP(4, 10) SC_STEP(5, 10) SC_STEP(6, 10) SC_STEP(7, 10) \
    SC_STEP(8, 10) SC_STEP(9, 10) SC_STEP(10, 10) SC_STEP(11, 10) SC_STEP(12, 10) SC_STEP(13, 10) SC_STEP(14, 5) SC_STEP(15, 0) \
    yp[(size_t)((c) * 16 + jl) * 512] = ykeep;                                              \
  }
    constexpr int NCH = SEQ / 16;
    float* yp = Y + (size_t)b * SEQ * 512 + h * 64 + il;
    __syncthreads();
    SC_GLOAD(gA, 0);
    SC_STORE(gA, 0);
    SC_GLOAD(gA, 16);
    SC_GLOAD(gB, 32);
    __syncthreads();
    for (int c = 0; c < NCH; c += 2) {
      SC_COMPUTE(c)
      SC_STORE(gA, 1)
      if (c + 3 < NCH) SC_GLOAD(gA, (c + 3) * 16);
      asm volatile("s_waitcnt lgkmcnt(0)\n\ts_barrier" ::: "memory");
      SC_COMPUTE(c + 1)
      if (c + 2 < NCH) {
        SC_STORE(gB, 0)
        if (c + 4 < NCH) SC_GLOAD(gB, (c + 4) * 16);
      }
      asm volatile("s_waitcnt lgkmcnt(0)\n\ts_barrier" ::: "memory");
    }
  }
  for (;;) {
    __syncthreads();
    if (tid == 0) sflag[3] = (int)atomicAdd(&qctr[32], 1u);
    __syncthreads();
    const int u = sflag[3];
    __syncthreads();
    if (u >= T / 128) break;
    mix_unit(p, u, smem);
  }
  for (;;) {
    __syncthreads();
    if (tid == 0) sflag[2] = (int)atomicAdd(&qctr[16], 1u);
    __syncthreads();
    const int ch = sflag[2];
    if (ch >= CVT_CHUNKS) break;
    cvt_chunk(p, ch);
  }
}

__device__ __forceinline__ void phase_post(const Params& p) {
  const float* Y = (const float*)(p.ws + OFF_Y);
  const u16* V = (const u16*)(p.ws + OFF_REGF + 96 * MB);
  const u16* GG = (const u16*)(p.ws + OFF_REGD + 32 * MB);
  const float* BONUS = (const float*)(p.ws + OFF_BONUS);
  u16* MIXIN = (u16*)(p.ws + OFF_REGB);
  const int tid = threadIdx.x;
  const int c = (tid & 127) * 4;
  const float4 gw = *(const float4*)(p.gn_w + c), gb = *(const float4*)(p.gn_b + c);
  for (int tp = blockIdx.x; tp < T / 2; tp += gridDim.x) {
    const int t = tp * 2 + (tid >> 7);
    const size_t o = (size_t)t * 512 + c;
    const float4 y = *(const float4*)(Y + o);
    float s = row16_sum(y.x + y.y + y.z + y.w);
    const float mean = s * (1.f / 64.f);
    const float d0 = y.x - mean, d1 = y.y - mean, d2 = y.z - mean, d3 = y.w - mean;
    const float var = row16_sum(d0 * d0 + d1 * d1 + d2 * d2 + d3 * d3) * (1.f / 64.f);
    const float rstd = rsqrtf(var + 64e-5f);
    const float bon = BONUS[(size_t)t * 8 + (c >> 6)];
    const uint2 vu = *(const uint2*)(V + o), gu = *(const uint2*)(GG + o);
    const float o0 = (d0 * rstd * gw.x + gb.x + bon * bflo(vu.x)) * bflo(gu.x);
    const float o1 = (d1 * rstd * gw.y + gb.y + bon * bfhi(vu.x)) * bfhi(gu.x);
    const float o2 = (d2 * rstd * gw.z + gb.z + bon * bflo(vu.y)) * bflo(gu.y);
    const float o3 = (d3 * rstd * gw.w + gb.w + bon * bfhi(vu.y)) * bfhi(gu.y);
    *(uint2*)(MIXIN + (size_t)t * D + 512 + c) = make_uint2(pack2(o0, o1), pack2(o2, o3));
  }
}

__device__ __forceinline__ void phase_gemm_out(const Params& p, char* smem) {
  const u16* MIXIN = (const u16*)(p.ws + OFF_REGB);
  const u16* WOUT = (const u16*)(p.ws + OFF_WOUT);
  const float* MOD = (const float*)(p.ws + OFF_MOD);
  constexpr int NT = D / 128, MT = T / 128;
  for (int tile = blockIdx.x; tile < NT * MT; tile += gridDim.x) {
    const int mt = tile / NT, nt = tile % NT;
    f32x16 acc[2][2];
    gemm128d(MIXIN, D, WOUT, D, D, mt * 128, nt * 128, smem, acc);
    const int b = (mt * 128) / SEQ;
    const float* gt = MOD + b * 6144 + 2048 + nt * 128;
    epi_staged(acc, smem, [&](int row, int c4, float4 v) {
      const size_t o = (size_t)(mt * 128 + row) * D + nt * 128 + c4;
      const float4 xv = *(const float4*)(p.x + o);
      const float4 g = *(const float4*)(gt + c4);
      *(float4*)(p.out + o) = make_float4(xv.x + g.x * v.x, xv.y + g.y * v.y, xv.z + g.z * v.z, xv.w + g.w * v.w);
    });
  }
}

__device__ __forceinline__ u32 f2ord(float f) {
  u32 u = __float_as_uint(f);
  return (u & 0x80000000u) ? ~u : (u | 0x80000000u);
}
__device__ __forceinline__ float ord2f(u32 u) {
  u = (u & 0x80000000u) ? (u & 0x7FFFFFFFu) : ~u;
  return __uint_as_float(u);
}
#define TOPK_INSERT(L, x)                       \
  {                                             \
    u32 _x = (x);                               \
    _Pragma("unroll") for (int _i = 0; _i < 16; ++_i) { \
      u32 _hi = max(L[_i], _x);                 \
      _x = min(L[_i], _x);                      \
      L[_i] = _hi;                              \
    }                                           \
  }

#define CMPEX_DESC(a, b) { const u32 _hi = max(a, b); const u32 _lo = min(a, b); a = _hi; b = _lo; }
__device__ __forceinline__ void sort16_desc(u32 (&v)[16]) {
#pragma unroll
  for (int k = 2; k <= 16; k <<= 1) {
#pragma unroll
    for (int j = k >> 1; j > 0; j >>= 1) {
#pragma unroll
      for (int i = 0; i < 16; ++i) {
        const int l = i ^ j;
        if (l > i) {
          if ((i & k) == 0) CMPEX_DESC(v[i], v[l]) else CMPEX_DESC(v[l], v[i])
        }
      }
    }
  }
}
__device__ __forceinline__ void merge16_desc(u32 (&a)[16], const u32 (&b)[16]) {
#pragma unroll
  for (int i = 0; i < 16; ++i) a[i] = max(a[i], b[15 - i]);
#pragma unroll
  for (int j = 8; j > 0; j >>= 1) {
#pragma unroll
    for (int i = 0; i < 16; ++i) {
      const int l = i ^ j;
      if (l > i) CMPEX_DESC(a[i], a[l])
    }
  }
}

__device__ __forceinline__ void phase_peer_route(const Params& p, char* smem) {
  const u16* U2 = (const u16*)(p.ws + OFF_REGB);
  const u16* WQ = (const u16*)(p.ws + OFF_WQ);
  const u16* KEYS = (const u16*)(p.ws + OFF_KEYS);
  int* EXPID = (int*)(p.ws + OFF_EXPID);
  float* GATE = (float*)(p.ws + OFF_GATE);
  const int tid = threadIdx.x, lane = tid & 63, wid = tid >> 6, wm = wid >> 1, wn = wid & 1, fr = lane & 15, fq = lane >> 4;
  constexpr int QROWB = 272;
  char* qs = smem;
  char* ks = smem + 128 * QROWB;
  float* sT = (float*)smem;
  for (int task = blockIdx.x; task < (T / 128) * PEER_H; task += gridDim.x) {
    const int mt = task / PEER_H, h = task % PEER_H;
    u32 L0[16], L1[16];
#pragma unroll
    for (int pp = 0; pp < 2; ++pp) {
      f32x16 sc[2][2];
      gemm128(U2, D, WQ, D, D, mt * 128, h * 256 + pp * 128, smem, sc);
      {
        const int fr32 = lane & 31, fh = lane >> 5;
#pragma unroll
        for (int mi = 0; mi < 2; ++mi)
#pragma unroll
          for (int ni = 0; ni < 2; ++ni)
#pragma unroll
            for (int g = 0; g < 4; ++g)
              *(f32x4*)(sT + (wm * 64 + mi * 32 + fr32) * 132 + wn * 64 + ni * 32 + g * 8 + fh * 4) =
                  f32x4{sc[mi][ni][g * 4 + 0], sc[mi][ni][g * 4 + 1], sc[mi][ni][g * 4 + 2], sc[mi][ni][g * 4 + 3]};
      }
      __syncthreads();
      {
        const int trow = tid & 127, half = tid >> 7;
        u32 L[16];
#pragma unroll
        for (int i = 0; i < 16; ++i) L[i] = 0u;
#pragma unroll 1
        for (int g = 0; g < 4; ++g) {
          u32 grp[16];
          const int kb = half * 64 + g * 16;
#pragma unroll
          for (int i4 = 0; i4 < 4; ++i4) {
            const float4 sv = *(const float4*)(sT + trow * 132 + kb + i4 * 4);
            grp[i4 * 4 + 0] = (f2ord(sv.x) & ~0x7Fu) | (u32)(127 - kb - i4 * 4);
            grp[i4 * 4 + 1] = (f2ord(sv.y) & ~0x7Fu) | (u32)(126 - kb - i4 * 4);
            grp[i4 * 4 + 2] = (f2ord(sv.z) & ~0x7Fu) | (u32)(125 - kb - i4 * 4);
            grp[i4 * 4 + 3] = (f2ord(sv.w) & ~0x7Fu) | (u32)(124 - kb - i4 * 4);
          }
          sort16_desc(grp);
          merge16_desc(L, grp);
        }
        __syncthreads();
        u32* xl = (u32*)smem;
        if (half == 1) {
#pragma unroll
          for (int i = 0; i < 16; ++i) xl[trow * 17 + i] = L[i];
        }
        __syncthreads();
        if (half == 0) {
          u32 oth[16];
#pragma unroll
          for (int i = 0; i < 16; ++i) oth[i] = xl[trow * 17 + i];
          merge16_desc(L, oth);
#pragma unroll
          for (int i = 0; i < 16; ++i) {
            if (pp == 0) L0[i] = L[i]; else L1[i] = L[i];
          }
        }
      }
      __syncthreads();
    }
    if (tid < 128) {
      float s0[16], s1[16];
#pragma unroll
      for (int i = 0; i < 16; ++i) {
        s0[i] = ord2f(L0[i] & ~0x7Fu);
        s1[i] = ord2f(L1[i] & ~0x7Fu);
      }
#define CKEY(i, j) ((f2ord(s0[i] + s1[j]) & ~0xFFu) | (u32)(255 - ((i) * 16 + (j))))
      u32 B[16], Bk[16], Ck[16], Dk[16];
#pragma unroll
      for (int j = 0; j < 16; ++j) B[j] = CKEY(0, j);
#pragma unroll
      for (int j = 0; j < 8; ++j) Bk[j] = CKEY(1, j);
#pragma unroll
      for (int j = 0; j < 5; ++j) Bk[8 + j] = CKEY(2, j);
#pragma unroll
      for (int j = 0; j < 3; ++j) Bk[13 + j] = CKEY(4, j);
#pragma unroll
      for (int j = 0; j < 4; ++j) Ck[j] = CKEY(3, j);
#pragma unroll
      for (int j = 0; j < 2; ++j) { Ck[4 + j] = CKEY(5, j); Ck[6 + j] = CKEY(6, j); Ck[8 + j] = CKEY(7, j); }
#pragma unroll
      for (int i = 8; i < 14; ++i) Ck[10 + (i - 8)] = CKEY(i, 0);
      {
        const u32 d14 = CKEY(14, 0), d15 = CKEY(15, 0);
        Dk[0] = max(d14, d15);
        Dk[1] = min(d14, d15);
#pragma unroll
        for (int i = 2; i < 16; ++i) Dk[i] = 0u;
      }
#undef CKEY
      sort16_desc(Bk);
      sort16_desc(Ck);
      merge16_desc(B, Bk);
      merge16_desc(B, Ck);
      merge16_desc(B, Dk);
      float bv[16];
      int eid[16];
      u32* slot = (u32*)smem + tid * 33;
#pragma unroll
      for (int z = 0; z < 16; ++z) { slot[z] = L0[z]; slot[16 + z] = L1[z]; }
#pragma unroll
      for (int q = 0; q < 16; ++q) {
        const int pos = 255 - (int)(B[q] & 0xFFu);
        const u32 a = slot[pos >> 4], bq = slot[16 + (pos & 15)];
        const int i0 = 127 - (int)(a & 0x7Fu), i1 = 127 - (int)(bq & 0x7Fu);
        eid[q] = i0 * NKEYS + i1;
        bv[q] = ord2f(a & ~0x7Fu) + ord2f(bq & ~0x7Fu);
      }
      float mx = bv[0];
#pragma unroll
      for (int q = 1; q < 16; ++q) mx = fmaxf(mx, bv[q]);
      float den = 0.f;
#pragma unroll
      for (int q = 0; q < 16; ++q) { bv[q] = __expf(bv[q] - mx); den += bv[q]; }
      const float rden = __builtin_amdgcn_rcpf(den);
      const size_t o = ((size_t)(mt * 128 + tid) * PEER_H + h) * 16;
#pragma unroll
      for (int q = 0; q < 16; q += 4) {
        *(int4*)(EXPID + o + q) = make_int4(eid[q], eid[q + 1], eid[q + 2], eid[q + 3]);
        *(float4*)(GATE + o + q) = make_float4(bv[q] * rden, bv[q + 1] * rden, bv[q + 2] * rden, bv[q + 3] * rden);
      }
    }
    __syncthreads();
  }
}

#define CVT_LO(w) __builtin_amdgcn_cvt_pk_f32_fp8((int)(w), false)
#define CVT_HI(w) __builtin_amdgcn_cvt_pk_f32_fp8((int)(w), true)
__device__ __forceinline__ void phase_peer_gather(const Params& p) {
  const u16* U2 = (const u16*)(p.ws + OFF_REGB);
  const uint4* EU = (const uint4*)(p.ws + OFF_EU8);
  const uint4* EV = (const uint4*)(p.ws + OFF_EV8);
  const int* EXPID = (const int*)(p.ws + OFF_EXPID);
  const float* GATE = (const float*)(p.ws + OFF_GATE);
  const float* MOD = (const float*)(p.ws + OFF_MOD);
  const int lane = threadIdx.x & 63;
  const int gw = blockIdx.x * 4 + (threadIdx.x >> 6), nw = gridDim.x * 4;
  for (int t = gw; t < T; t += nw) {
    const int b = t / SEQ;
    const uint4 xa = *(const uint4*)(U2 + (size_t)t * D + lane * 16);
    const uint4 xb = *(const uint4*)(U2 + (size_t)t * D + lane * 16 + 8);
    v2f x2[8];
    x2[0] = v2f{bflo(xa.x), bfhi(xa.x)}; x2[1] = v2f{bflo(xa.y), bfhi(xa.y)};
    x2[2] = v2f{bflo(xa.z), bfhi(xa.z)}; x2[3] = v2f{bflo(xa.w), bfhi(xa.w)};
    x2[4] = v2f{bflo(xb.x), bfhi(xb.x)}; x2[5] = v2f{bflo(xb.y), bfhi(xb.y)};
    x2[6] = v2f{bflo(xb.z), bfhi(xb.z)}; x2[7] = v2f{bflo(xb.w), bfhi(xb.w)};
    v2f o2[8];
#pragma unroll
    for (int i = 0; i < 8; ++i) o2[i] = v2f{0.f, 0.f};
    const int idA = EXPID[(size_t)t * 128 + lane], idB = EXPID[(size_t)t * 128 + 64 + lane];
    const float gA = GATE[(size_t)t * 128 + lane], gB = GATE[(size_t)t * 128 + 64 + lane];
    for (int h = 0; h < PEER_H; ++h) {
      const int idv = (h < 4) ? idA : idB;
      const float gtv = (h < 4) ? gA : gB;
      const int lb = (h & 3) * 16;
      float part[16];
#pragma unroll
      for (int e = 0; e < 16; ++e) {
        const int id = __builtin_amdgcn_readlane(idv, lb + e);
        const uint4 a = EU[(size_t)id * 64 + lane];
        v2f acc = CVT_LO(a.x) * x2[0];
        acc = CVT_HI(a.x) * x2[1] + acc;
        acc = CVT_LO(a.y) * x2[2] + acc;
        acc = CVT_HI(a.y) * x2[3] + acc;
        acc = CVT_LO(a.z) * x2[4] + acc;
        acc = CVT_HI(a.z) * x2[5] + acc;
        acc = CVT_LO(a.w) * x2[6] + acc;
        acc = CVT_HI(a.w) * x2[7] + acc;
        part[e] = acc.x + acc.y;
      }
      float p8[8], p4[4], p2[2], p1;
      {
        const bool up = (lane & 32) != 0;
#pragma unroll
        for (int e = 0; e < 8; ++e) {
          const float mine = up ? part[e + 8] : part[e];
          const float oth = up ? part[e] : part[e + 8];
          p8[e] = mine + __shfl_xor(oth, 32);
        }
      }
      {
        const bool up = (lane & 16) != 0;
#pragma unroll
        for (int e = 0; e < 4; ++e) {
          const float mine = up ? p8[e + 4] : p8[e];
          const float oth = up ? p8[e] : p8[e + 4];
          p4[e] = mine + __shfl_xor(oth, 16);
        }
      }
      {
        const bool up = (lane & 8) != 0;
#pragma unroll
        for (int e = 0; e < 2; ++e) {
          const float mine = up ? p4[e + 2] : p4[e];
          const float oth = up ? p4[e] : p4[e + 2];
          p2[e] = mine + __shfl_xor(oth, 8);
        }
      }
      {
        const bool up = (lane & 4) != 0;
        const float mine = up ? p2[1] : p2[0];
        const float oth = up ? p2[0] : p2[1];
        p1 = mine + __shfl_xor(oth, 4);
      }
      p1 += __shfl_xor(p1, 2);
      p1 += __shfl_xor(p1, 1);
      p1 *= (1.0f / 512.f);
      const int myE = ((lane >> 5) & 1) * 8 + ((lane >> 4) & 1) * 4 + ((lane >> 3) & 1) * 2 + ((lane >> 2) & 1);
      const float gmine = __shfl(gtv, lb + myE);
      const float hv = 0.5f * p1 * (1.0f + erff(p1 * 0.70710678118654752f));
      const float coef = gmine * hv * (1.0f / 128.f);
#pragma unroll
      for (int e = 0; e < 16; ++e) {
        const int srcLane = ((e >> 3) & 1) * 32 + ((e >> 2) & 1) * 16 + ((e >> 1) & 1) * 8 + (e & 1) * 4;
        const float ce = __builtin_bit_cast(float, __builtin_amdgcn_readlane(__builtin_bit_cast(int, coef), srcLane));
        const int id = __builtin_amdgcn_readlane(idv, lb + e);
        const uint4 a = EV[(size_t)id * 64 + lane];
        const v2f c2 = v2f{ce, ce};
        o2[0] = CVT_LO(a.x) * c2 + o2[0];
        o2[1] = CVT_HI(a.x) * c2 + o2[1];
        o2[2] = CVT_LO(a.y) * c2 + o2[2];
        o2[3] = CVT_HI(a.y) * c2 + o2[3];
        o2[4] = CVT_LO(a.z) * c2 + o2[4];
        o2[5] = CVT_HI(a.z) * c2 + o2[5];
        o2[6] = CVT_LO(a.w) * c2 + o2[6];
        o2[7] = CVT_HI(a.w) * c2 + o2[7];
      }
    }
    float* orow = p.out + (size_t)t * D + lane * 16;
    const float* gt = MOD + b * 6144 + 5120 + lane * 16;
    float xf[16];
    float ss = 0.f;
#pragma unroll
    for (int q = 0; q < 4; ++q) {
      const float4 x0 = *(const float4*)(orow + q * 4);
      const float4 g0 = *(const float4*)(gt + q * 4);
      xf[q * 4 + 0] = x0.x + g0.x * o2[q * 2].x;
      xf[q * 4 + 1] = x0.y + g0.y * o2[q * 2].y;
      xf[q * 4 + 2] = x0.z + g0.z * o2[q * 2 + 1].x;
      xf[q * 4 + 3] = x0.w + g0.w * o2[q * 2 + 1].y;
    }
#pragma unroll
    for (int i = 0; i < 16; ++i) ss += xf[i] * xf[i];
    ss = wave_sum(ss);
    const float rstd = rsqrtf(ss * (1.0f / D) + 1e-6f);
#pragma unroll
    for (int q = 0; q < 4; ++q) {
      const float4 f0 = *(const float4*)(p.final_g + lane * 16 + q * 4);
      *(float4*)(orow + q * 4) =
          make_float4(xf[q * 4 + 0] * rstd * f0.x, xf[q * 4 + 1] * rstd * f0.y, xf[q * 4 + 2] * rstd * f0.z, xf[q * 4 + 3] * rstd * f0.w);
    }
  }
}

#ifndef PROBE_MASK
#define PROBE_MASK 0
#endif
__global__ void __launch_bounds__(NTHREADS, 2) hymba_mega(Params p) {
  __shared__ __attribute__((aligned(16))) char smem[SMEM_BYTES];
  __shared__ uint4 xb_words;
  cg::grid_group grid = cg::this_grid();
  if (threadIdx.x == 0) xb_words = make_uint4(0u, 0u, 0u, 0u);
  __syncthreads();
  const XcdBarrier xb = xcd_barrier_post((unsigned*)(p.ws + OFF_BAR), (volatile LAS unsigned*)&xb_words);
#define RUN_PHASE(N, CALL)                          \
  {                                                 \
    CALL;                                           \
    if ((PROBE_MASK >> (N)) & 1) { xcd_barrier(xb); CALL; } \
  }
  RUN_PHASE(0, phase_prep(p, smem))
  grid.sync();
  phase_peer_fold(p, smem);
  RUN_PHASE(1, phase_normmod(p.x, p.norm_mix_g, (const float*)(p.ws + OFF_MOD), 0, 1024, (u16*)(p.ws + OFF_REGB)))
  xcd_barrier(xb);
  RUN_PHASE(2, phase_gemm_in(p, smem))
  xcd_barrier(xb);
  RUN_PHASE(3, phase_act(p))
  xcd_barrier(xb);
  RUN_PHASE(4, phase_lora_conv(p, smem))
  xcd_barrier(xb);
  RUN_PHASE(5, phase_scanprep(p))
  xcd_barrier(xb);
  phase_scan(p, smem, 0);
  if ((PROBE_MASK >> 6) & 1) { xcd_barrier(xb); phase_scan(p, smem, 1); }
  xcd_barrier(xb);
  RUN_PHASE(7, phase_post(p))
  xcd_barrier(xb);
  RUN_PHASE(8, phase_gemm_out(p, smem))
  xcd_barrier(xb);
  RUN_PHASE(9, phase_normmod(p.out, p.norm_ffn_g, (const float*)(p.ws + OFF_MOD), 3072, 4096, (u16*)(p.ws + OFF_REGB)))
  xcd_barrier(xb);
  RUN_PHASE(10, phase_peer_route(p, smem))
  xcd_barrier(xb);
  phase_peer_gather(p);
#ifdef PROBE_TIME
  xcd_barrier(xb);
  if (blockIdx.x == 0 && threadIdx.x == 0) p.out[0] += *(const float*)(p.ws + OFF_BAR + 32768);
#endif
}

extern "C" void kernel_launch(void* const* d_in, const int* in_sizes, int n_in, void* d_out, int out_size, void* d_ws,
                              size_t ws_size, hipStream_t stream) {
  static int grid_blocks = 0;
  if (!grid_blocks) {
    int dev = 0, cus = 0, per_cu = 0;
    (void)hipGetDevice(&dev);
    (void)hipDeviceGetAttribute(&cus, hipDeviceAttributeMultiprocessorCount, dev);
    (void)hipOccupancyMaxActiveBlocksPerMultiprocessor(&per_cu, hymba_mega, NTHREADS, 0);
    if (per_cu > 2) per_cu = 2;
    grid_blocks = cus * per_cu;
  }
  if (ws_size < WS_NEEDED) {
    fprintf(stderr, "workspace too small: %zu < %zu\n", ws_size, (size_t)WS_NEEDED);
    return;
  }
  Params p{};
  const float** pf = (const float**)&p;
  for (int i = 0; i < 28; ++i) pf[i] = (const float*)d_in[i];
  p.out = (float*)d_out;
  p.ws = (char*)d_ws;
  (void)hipMemsetAsync((char*)d_ws + OFF_BAR, 0, (XCD_BAR_WORDS + 2 * (2048 + 64)) * 4, stream);
  void* args[] = {&p};
  hipError_t e = hipLaunchCooperativeKernel((void*)hymba_mega, dim3(grid_blocks), dim3(NTHREADS), args, 0, stream);
  if (e != hipSuccess) fprintf(stderr, "cooperative launch failed: %s (grid %d)\n", hipGetErrorString(e), grid_blocks);
}
```

```cpp
#include <hip/hip_runtime.h>
#include <hip/hip_cooperative_groups.h>
#include <cstdio>
#include <cstdint>
namespace cg = cooperative_groups;

typedef unsigned short u16;
typedef unsigned int u32;
using bf16x8 = __attribute__((ext_vector_type(8))) short;
using f32x4 = __attribute__((ext_vector_type(4))) float;
using f32x16 = __attribute__((ext_vector_type(16))) float;
typedef __attribute__((ext_vector_type(2))) __bf16 bf2_t;
typedef float v2f __attribute__((ext_vector_type(2)));

constexpr int D = 1024, NBATCH = 8, SEQ = 4096, T = NBATCH * SEQ;
constexpr int CONV_CH = 512, RW = 512, NPROJ = 2816, RWKV_PROJ = 1792;
constexpr int CONV_W = 31;
constexpr int NHEAD = 8;
constexpr int PEER_H = 8, PEER_K = 16, NKEYS = 128;
constexpr int NTHREADS = 256;
constexpr int SMEM_BYTES = 79872;

constexpr size_t MB = 1ull << 20;
constexpr size_t OFF_WIN = 0;
constexpr size_t OFF_WOUT = OFF_WIN + (size_t)NPROJ * D * 2;
constexpr size_t OFF_WQ = OFF_WOUT + (size_t)D * D * 2;
constexpr size_t OFF_WLORA = OFF_WQ + (size_t)2048 * D * 2;
constexpr size_t OFF_KEYS = OFF_WLORA + (size_t)1536 * 256 * 2;
constexpr size_t OFF_MOD = OFF_KEYS + (size_t)16 * 128 * 128 * 2;
constexpr size_t OFF_BONUS = OFF_MOD + (size_t)8 * 6144 * 4;
constexpr size_t OFF_BAR = OFF_BONUS + (size_t)T * 8 * 4;
constexpr size_t OFF_REGB = 16 * MB;
constexpr size_t OFF_REGC = OFF_REGB + 64 * MB;
constexpr size_t SZ_P = (size_t)T * NPROJ * 2;
constexpr size_t OFF_PC = OFF_REGC;
constexpr size_t OFF_PR = OFF_REGC + 64 * MB;
constexpr size_t OFF_Y = OFF_REGC + 64 * MB;
constexpr size_t OFF_EXPID = OFF_REGC + 160 * MB;
constexpr size_t OFF_GATE = OFF_REGC + 176 * MB;
constexpr size_t OFF_REGD = OFF_REGC + 176 * MB + 16 * MB;
constexpr size_t OFF_REGF = OFF_REGD + 64 * MB;
constexpr size_t WS_NEEDED = OFF_REGF + 160 * MB;
static_assert(OFF_BAR + (3456 + 2 * (2048 + 64)) * 4 <= OFF_REGB, "small region overflow");
static_assert(SZ_P <= 192 * MB, "P overflow");

struct Params {
  const float *x, *c, *ada_w, *ada_b, *norm_mix_g, *w_in, *conv_w, *conv_b, *ln_w, *ln_b;
  const float *mu, *w0, *w2, *a0, *a2, *g2, *k_k, *k_a, *r_k, *gn_w, *gn_b, *w_out, *norm_ffn_g;
  const float *w_q, *sub_keys, *peer_u, *peer_v, *final_g;
  float* out;
  char* ws;
};

typedef __bf16 bf2v_t __attribute__((ext_vector_type(2)));
__device__ __forceinline__ u32 pack2(float a, float b) {
  return __builtin_bit_cast(u32, __builtin_convertvector((v2f{a, b}), bf2v_t));
}
__device__ __forceinline__ u16 f2bf(float f) { return (u16)(pack2(f, 0.f) & 0xFFFFu); }
__device__ __forceinline__ float bf2f(u16 h) { return __uint_as_float(((u32)h) << 16); }

__device__ __forceinline__ float bflo(u32 v) { return __uint_as_float(v << 16); }
__device__ __forceinline__ float bfhi(u32 v) { return __uint_as_float(v & 0xFFFF0000u); }
__device__ __forceinline__ float sigmoidf_(float x) { return __builtin_amdgcn_rcpf(1.0f + __expf(-x)); }
__device__ __forceinline__ float tanhf_(float x) {
  const float e = __expf(-2.0f * fabsf(x));
  return copysignf((1.0f - e) * __builtin_amdgcn_rcpf(1.0f + e), x);
}
__device__ __forceinline__ float erff_(float x) {
  const float ax = fabsf(x);
  const float t = __builtin_amdgcn_rcpf(1.0f + 0.3275911f * ax);
  const float poly = t * (0.254829592f + t * (-0.284496736f + t * (1.421413741f + t * (-1.453152027f + t * 1.061405429f))));
  return copysignf(1.0f - poly * __expf(-ax * ax), x);
}
__device__ __forceinline__ float siluf_(float x) { return x * sigmoidf_(x); }
__device__ __forceinline__ float wave_sum(float v) {
#pragma unroll
  for (int o = 32; o > 0; o >>= 1) v += __shfl_xor(v, o);
  return v;
}
__device__ __forceinline__ float dpp_ror_add(float x, int) { return x; }
#define DPP_ROR(x, N) __builtin_bit_cast(float, __builtin_amdgcn_update_dpp(0, __builtin_bit_cast(int, (x)), 0x120 + (N), 0xF, 0xF, false))
__device__ __forceinline__ float row16_sum(float x) {
  x += DPP_ROR(x, 8);
  x += DPP_ROR(x, 4);
  x += DPP_ROR(x, 2);
  x += DPP_ROR(x, 1);
  return x;
}

#define XB_TMO      128
#define XB_XCNT(j)  (256  + 64 * (j))
#define XB_XSUB(j)  (1280 + 64 * (j))
#define XB_XGEN(j)  (2304 + 64 * (j))
#define XB_TOP      3328
#define XB_TOPGEN   3392
#define XCD_BAR_WORDS 3456
#define XB_SPIN_CAP (1u << 18)
#define LAS __attribute__((address_space(3)))
__device__ __forceinline__ unsigned xb_ld(unsigned* p)              { return __hip_atomic_load(p, __ATOMIC_RELAXED, __HIP_MEMORY_SCOPE_AGENT); }
__device__ __forceinline__ unsigned xb_add(unsigned* p, unsigned v) { return __hip_atomic_fetch_add(p, v, __ATOMIC_RELAXED, __HIP_MEMORY_SCOPE_AGENT); }
__device__ __forceinline__ unsigned xb_xcc_id() { return (unsigned)__builtin_amdgcn_s_getreg((3 << 11) | 20) & 0xFu; }
#define XB_SPIN(cond, bar) do { unsigned _sp = 0; while (cond) { __builtin_amdgcn_s_sleep(1); \
    if ((++_sp & 255u) == 0u) { if (xb_ld(&(bar)[XB_TMO])) break; if (_sp > XB_SPIN_CAP) { atomicAdd(&(bar)[XB_TMO], 1u); break; } } } } while (0)
struct XcdBarrier { unsigned* bar; unsigned x; volatile LAS unsigned* st; };
__device__ __forceinline__ XcdBarrier xcd_barrier_post(unsigned* bar, volatile LAS unsigned* st) {
    XcdBarrier b; b.bar = bar; b.x = xb_xcc_id(); b.st = st;
    if (threadIdx.x == 0) (void)xb_add(&bar[XB_XCNT(b.x)], 1u);
    return b;
}
__device__ __forceinline__ void xcd_barrier_complete(unsigned* bar, unsigned x, unsigned& nloc, unsigned& nx) {
    const unsigned G = gridDim.x * gridDim.y * gridDim.z;
    unsigned sum, cnt, mine, sp = 0u;
    for (;;) {
        sum = 0u; cnt = 0u; mine = 0u;
#pragma unroll
        for (unsigned j = 0; j < 16; ++j) { const unsigned c = xb_ld(&bar[XB_XCNT(j)]); sum += c; cnt += (c > 0u) ? 1u : 0u; mine = (j == x) ? c : mine; }
        if (sum == G) break;
        __builtin_amdgcn_s_sleep(1);
        if ((++sp & 255u) == 0u) { if (xb_ld(&bar[XB_TMO])) break; if (sp > XB_SPIN_CAP) { atomicAdd(&bar[XB_TMO], 1u); break; } }
    }
    nloc = mine > 0u ? mine : 1u; nx = cnt > 0u ? cnt : 1u;
}
__device__ __forceinline__ void xcd_barrier(const XcdBarrier& b) {
    asm volatile("s_waitcnt vmcnt(0)" ::: "memory");
    __syncthreads();
    if (threadIdx.x == 0) {
        unsigned* bar = b.bar;
        __builtin_amdgcn_s_waitcnt(0);
        unsigned nloc = b.st[0], nx = b.st[1];
        if (nloc == 0u) { xcd_barrier_complete(bar, b.x, nloc, nx); b.st[0] = nloc; b.st[1] = nx; }
        const unsigned old = xb_add(&bar[XB_XSUB(b.x)], 1u);
        const unsigned gen = old / nloc;
        if (old + 1u == (gen + 1u) * nloc) {
            __builtin_amdgcn_fence(__ATOMIC_RELEASE, "agent");
            asm volatile("s_waitcnt vmcnt(0)" ::: "memory");
            const unsigned og = xb_add(&bar[XB_TOP], 1u);
            const unsigned tg = og / nx;
            if (og + 1u == (tg + 1u) * nx) xb_add(&bar[XB_TOPGEN], 1u);
            else XB_SPIN(xb_ld(&bar[XB_TOPGEN]) == tg, bar);
            __builtin_amdgcn_fence(__ATOMIC_ACQUIRE, "agent");
            xb_add(&bar[XB_XGEN(b.x)], 1u);
            asm volatile("s_waitcnt vmcnt(0)" ::: "memory");
        } else {
            XB_SPIN(xb_ld(&bar[XB_XGEN(b.x)]) == gen, bar);
            __builtin_amdgcn_fence(__ATOMIC_ACQUIRE, "agent");
            asm volatile("s_waitcnt vmcnt(0)" ::: "memory");
        }
    }
    __syncthreads();
}

constexpr int G_ROWB = 144;
constexpr int G_TILEB = 128 * G_ROWB;
template <bool SWAP = true>
__device__ __forceinline__ void gemm128(const u16* __restrict__ A, int lda, const u16* __restrict__ B, int ldb, int K,
                                        int m0, int n0, char* smem, f32x16 (&acc)[2][2]) {
  const int tid = threadIdx.x, lane = tid & 63, wid = tid >> 6, wm = wid >> 1, wn = wid & 1;
  const int fr = lane & 15, fq = lane >> 4;
  const int ldrow = tid >> 3, ldc = tid & 7;
#pragma unroll
  for (int i = 0; i < 2; ++i)
#pragma unroll
    for (int j = 0; j < 2; ++j)
#pragma unroll
      for (int r = 0; r < 16; ++r) acc[i][j][r] = 0.f;
  const int fr32 = lane & 31, fh = lane >> 5;
  uint4 ra[4], rb[4];
  const u16* ga = A + (size_t)(m0 + ldrow) * lda + ldc * 8;
  const u16* gb = B + (size_t)(n0 + ldrow) * ldb + ldc * 8;
  const int nk = K >> 6;
#pragma unroll
  for (int i = 0; i < 4; ++i) {
    ra[i] = *(const uint4*)(ga + (size_t)(32 * i) * lda);
    rb[i] = *(const uint4*)(gb + (size_t)(32 * i) * ldb);
  }
  {
    char* sa = smem + ldrow * G_ROWB + ldc * 16;
#pragma unroll
    for (int i = 0; i < 4; ++i) {
      *(uint4*)(sa + 32 * i * G_ROWB) = ra[i];
      *(uint4*)(sa + G_TILEB + 32 * i * G_ROWB) = rb[i];
    }
  }
  __syncthreads();
  for (int kt = 0; kt < nk; ++kt) {
    const bool more = (kt + 1 < nk);
    if (more) {
      const int k0 = (kt + 1) << 6;
#pragma unroll
      for (int i = 0; i < 4; ++i) {
        ra[i] = *(const uint4*)(ga + (size_t)(32 * i) * lda + k0);
        rb[i] = *(const uint4*)(gb + (size_t)(32 * i) * ldb + k0);
      }
    }
    const char* cur = smem + (kt & 1) * 2 * G_TILEB;
    const char* sa = cur + (wm * 64 + fr32) * G_ROWB + fh * 16;
    const char* sb = cur + G_TILEB + (wn * 64 + fr32) * G_ROWB + fh * 16;
#pragma unroll
    for (int ks = 0; ks < 4; ++ks) {
      bf16x8 af[2], bfr[2];
#pragma unroll
      for (int i = 0; i < 2; ++i) {
        af[i] = *(const bf16x8*)(sa + i * 32 * G_ROWB + ks * 32);
        bfr[i] = *(const bf16x8*)(sb + i * 32 * G_ROWB + ks * 32);
      }
#pragma unroll
      for (int mi = 0; mi < 2; ++mi)
#pragma unroll
        for (int ni = 0; ni < 2; ++ni)
          acc[mi][ni] = SWAP ? __builtin_amdgcn_mfma_f32_32x32x16_bf16(bfr[ni], af[mi], acc[mi][ni], 0, 0, 0)
                             : __builtin_amdgcn_mfma_f32_32x32x16_bf16(af[mi], bfr[ni], acc[mi][ni], 0, 0, 0);
    }
    if (more) {
      char* nxt = smem + ((kt + 1) & 1) * 2 * G_TILEB + ldrow * G_ROWB + ldc * 16;
#pragma unroll
      for (int i = 0; i < 4; ++i) {
        *(uint4*)(nxt + 32 * i * G_ROWB) = ra[i];
        *(uint4*)(nxt + G_TILEB + 32 * i * G_ROWB) = rb[i];
      }
    }
    __syncthreads();
  }
}

__device__ __forceinline__ void gemm128d(const u16* __restrict__ A, int lda, const u16* __restrict__ B, int ldb, int K,
                                        int m0, int n0, char* smem, f32x16 (&acc)[2][2]) {
  const int tid = threadIdx.x, lane = tid & 63, wid = tid >> 6, wm = wid >> 1, wn = wid & 1;
  const int fr = lane & 15, fq = lane >> 4;
  const int ldrow = tid >> 3, ldc = tid & 7;
#pragma unroll
  for (int i = 0; i < 2; ++i)
#pragma unroll
    for (int j = 0; j < 2; ++j)
#pragma unroll
      for (int r = 0; r < 16; ++r) acc[i][j][r] = 0.f;
  const int fr32 = lane & 31, fh = lane >> 5;
  uint4 ra0_0, ra0_1, ra0_2, ra0_3, rb0_0, rb0_1, rb0_2, rb0_3;
  uint4 ra1_0, ra1_1, ra1_2, ra1_3, rb1_0, rb1_1, rb1_2, rb1_3;
  const u16* ga = A + (size_t)(m0 + ldrow) * lda + ldc * 8;
  const u16* gb = B + (size_t)(n0 + ldrow) * ldb + ldc * 8;
  const int nk = K >> 6;
  char* const sw = smem + ldrow * G_ROWB + ldc * 16;
#define G_LOAD1(RA, RB, I, k0)                                          \
  RA##_##I = *(const uint4*)(ga + (size_t)(32 * I) * lda + k0);         \
  RB##_##I = *(const uint4*)(gb + (size_t)(32 * I) * ldb + k0);
#define G_LOAD(RA, RB, KT)                                              \
  {                                                                     \
    const int k0 = (KT) << 6;                                           \
    G_LOAD1(RA, RB, 0, k0) G_LOAD1(RA, RB, 1, k0) G_LOAD1(RA, RB, 2, k0) G_LOAD1(RA, RB, 3, k0) \
  }
#define G_STORE1(RA, RB, I)                                             \
  *(uint4*)(d + 32 * I * G_ROWB) = RA##_##I;                            \
  *(uint4*)(d + G_TILEB + 32 * I * G_ROWB) = RB##_##I;
#define G_STORE(RA, RB, BUF)                                            \
  {                                                                     \
    char* d = sw + (BUF) * 2 * G_TILEB;                                 \
    G_STORE1(RA, RB, 0) G_STORE1(RA, RB, 1) G_STORE1(RA, RB, 2) G_STORE1(RA, RB, 3) \
  }
#define G_COMPUTE(BUF)                                                                          \
  {                                                                                             \
    const char* cur = smem + (BUF) * 2 * G_TILEB;                                               \
    const char* sa = cur + (wm * 64 + fr32) * G_ROWB + fh * 16;                                 \
    const char* sb = cur + G_TILEB + (wn * 64 + fr32) * G_ROWB + fh * 16;                       \
    _Pragma("unroll") for (int ks = 0; ks < 4; ++ks) {                                          \
      bf16x8 af[2], bfr[2];                                                                     \
      _Pragma("unroll") for (int i = 0; i < 2; ++i) {                                           \
        af[i] = *(const bf16x8*)(sa + i * 32 * G_ROWB + ks * 32);                               \
        bfr[i] = *(const bf16x8*)(sb + i * 32 * G_ROWB + ks * 32);                              \
      }                                                                                         \
      _Pragma("unroll") for (int mi = 0; mi < 2; ++mi)                                          \
      _Pragma("unroll") for (int ni = 0; ni < 2; ++ni)                                          \
        acc[mi][ni] = __builtin_amdgcn_mfma_f32_32x32x16_bf16(bfr[ni], af[mi], acc[mi][ni], 0, 0, 0); \
    }                                                                                           \
  }
  G_LOAD(ra0, rb0, 0)
  G_STORE(ra0, rb0, 0)
  G_LOAD(ra0, rb0, 1)
  if (nk > 2) G_LOAD(ra1, rb1, 2)
  __syncthreads();
  for (int kt = 0; kt < nk; kt += 2) {
    G_COMPUTE(0)
    G_STORE(ra0, rb0, 1)
    if (kt + 3 < nk) G_LOAD(ra0, rb0, kt + 3)
    __syncthreads();
    G_COMPUTE(1)
    if (kt + 2 < nk) {
      G_STORE(ra1, rb1, 0)
      if (kt + 4 < nk) G_LOAD(ra1, rb1, kt + 4)
    }
    __syncthreads();
  }
#undef G_LOAD
#undef G_LOAD1
#undef G_STORE
#undef G_STORE1
#undef G_COMPUTE
}

#define ACC_FOREACH(BODY)                                                            \
  {                                                                                  \
    const int _lane = threadIdx.x & 63, _wid = threadIdx.x >> 6;                     \
    const int _wm = _wid >> 1, _wn = _wid & 1, _fr = _lane & 15, _fq = _lane >> 4;   \
    _Pragma("unroll") for (int mi = 0; mi < 4; ++mi)                                 \
    _Pragma("unroll") for (int ni = 0; ni < 4; ++ni)                                 \
    _Pragma("unroll") for (int j = 0; j < 4; ++j) {                                  \
      const int lrow = _wm * 64 + mi * 16 + _fq * 4 + j;                             \
      const int lcol = _wn * 64 + ni * 16 + _fr;                                     \
      const float v = acc[mi][ni][j];                                                \
      BODY                                                                           \
    }                                                                                \
  }

template <class F>
__device__ __forceinline__ void epi_staged(f32x16 (&acc)[2][2], char* smem, F f) {
  float* st = (float*)smem;
  {
    const int lane = threadIdx.x & 63, wid = threadIdx.x >> 6, wm = wid >> 1, wn = wid & 1, fr32 = lane & 31, fh = lane >> 5;
#pragma unroll
    for (int mi = 0; mi < 2; ++mi)
#pragma unroll
      for (int ni = 0; ni < 2; ++ni)
#pragma unroll
        for (int g = 0; g < 4; ++g)
          *(f32x4*)(st + (wm * 64 + mi * 32 + fr32) * 132 + wn * 64 + ni * 32 + g * 8 + fh * 4) =
              f32x4{acc[mi][ni][g * 4 + 0], acc[mi][ni][g * 4 + 1], acc[mi][ni][g * 4 + 2], acc[mi][ni][g * 4 + 3]};
  }
  __syncthreads();
#pragma unroll 4
  for (int i = threadIdx.x; i < 128 * 32; i += NTHREADS) {
    const int row = i >> 5, c4 = (i & 31) << 2;
    const float4 v = *(const float4*)(st + row * 132 + c4);
    f(row, c4, v);
  }
  __syncthreads();
}

constexpr int H_ROWB = 80;
constexpr int H_A = 256 * H_ROWB, H_B = 128 * H_ROWB, H_STAGE = H_A + H_B;
__device__ __forceinline__ void gemm256(const u16* __restrict__ A, int lda, const u16* __restrict__ B, int ldb, int K,
                                        int m0, int n0, char* smem, f32x16 (&acc)[4][2]) {
  const int tid = threadIdx.x, lane = tid & 63, wid = tid >> 6, wm = wid >> 1, wn = wid & 1;
  const int fr32 = lane & 31, fh = lane >> 5;
#pragma unroll
  for (int i = 0; i < 4; ++i)
#pragma unroll
    for (int j = 0; j < 2; ++j)
#pragma unroll
      for (int r = 0; r < 16; ++r) acc[i][j][r] = 0.f;
  const int ldrow = tid >> 2, ldc = tid & 3;
  const u16* ga = A + (size_t)(m0 + ldrow) * lda + ldc * 8;
  const u16* gb = B + (size_t)(n0 + ldrow) * ldb + ldc * 8;
  uint4 a0, a1, a2, a3, b0, b1;
  uint4 c0, c1, c2, c3, d0, d1;
  const int nk = K >> 5;
  char* const swa = smem + ldrow * H_ROWB + ldc * 16;
  char* const swb = smem + H_A + ldrow * H_ROWB + ldc * 16;
#define H_LOAD(k0, A0, A1, A2, A3, B0, B1)                      \
  A0 = *(const uint4*)(ga + (k0));                              \
  A1 = *(const uint4*)(ga + (size_t)64 * lda + (k0));           \
  A2 = *(const uint4*)(ga + (size_t)128 * lda + (k0));          \
  A3 = *(const uint4*)(ga + (size_t)192 * lda + (k0));          \
  B0 = *(const uint4*)(gb + (k0));                              \
  B1 = *(const uint4*)(gb + (size_t)64 * ldb + (k0));
#define H_STORE(BUF, A0, A1, A2, A3, B0, B1)                    \
  *(uint4*)(swa + (BUF) * H_STAGE) = A0;                        \
  *(uint4*)(swa + (BUF) * H_STAGE + 64 * H_ROWB) = A1;          \
  *(uint4*)(swa + (BUF) * H_STAGE + 128 * H_ROWB) = A2;         \
  *(uint4*)(swa + (BUF) * H_STAGE + 192 * H_ROWB) = A3;         \
  *(uint4*)(swb + (BUF) * H_STAGE) = B0;                        \
  *(uint4*)(swb + (BUF) * H_STAGE + 64 * H_ROWB) = B1;
#define H_COMPUTE(BUF)                                                                          \
  {                                                                                             \
    const char* cur = smem + (BUF) * H_STAGE;                                                   \
    const char* sa = cur + (wm * 128 + fr32) * H_ROWB + fh * 16;                                \
    const char* sb = cur + H_A + (wn * 64 + fr32) * H_ROWB + fh * 16;                           \
    _Pragma("unroll") for (int ks = 0; ks < 2; ++ks) {                                          \
      bf16x8 af[4], bfr[2];                                                                     \
      _Pragma("unroll") for (int i = 0; i < 4; ++i) af[i] = *(const bf16x8*)(sa + i * 32 * H_ROWB + ks * 32); \
      _Pragma("unroll") for (int i = 0; i < 2; ++i) bfr[i] = *(const bf16x8*)(sb + i * 32 * H_ROWB + ks * 32); \
      _Pragma("unroll") for (int mi = 0; mi < 4; ++mi)                                          \
      _Pragma("unroll") for (int ni = 0; ni < 2; ++ni)                                          \
        acc[mi][ni] = __builtin_amdgcn_mfma_f32_32x32x16_bf16(bfr[ni], af[mi], acc[mi][ni], 0, 0, 0); \
    }                                                                                           \
  }
  H_LOAD(0, a0, a1, a2, a3, b0, b1)
  H_STORE(0, a0, a1, a2, a3, b0, b1)
  H_LOAD(32, a0, a1, a2, a3, b0, b1)
  if (nk > 2) { H_LOAD(64, c0, c1, c2, c3, d0, d1) }
  __syncthreads();
  for (int kt = 0; kt < nk; kt += 2) {
    H_COMPUTE(0)
    H_STORE(1, a0, a1, a2, a3, b0, b1)
    if (kt + 3 < nk) { const int k0 = (kt + 3) << 5; H_LOAD(k0, a0, a1, a2, a3, b0, b1) }
    __syncthreads();
    H_COMPUTE(1)
    if (kt + 2 < nk) {
      H_STORE(0, c0, c1, c2, c3, d0, d1)
      if (kt + 4 < nk) { const int k0 = (kt + 4) << 5; H_LOAD(k0, c0, c1, c2, c3, d0, d1) }
    }
    __syncthreads();
  }
#undef H_COMPUTE
#undef H_LOAD
#undef H_STORE
}
template <class F>
__device__ __forceinline__ void epi_staged256(f32x16 (&acc)[4][2], char* smem, F f) {
  float* st = (float*)smem;
  const int lane = threadIdx.x & 63, wid = threadIdx.x >> 6, wm = wid >> 1, wn = wid & 1, fr32 = lane & 31, fh = lane >> 5;
#pragma unroll
  for (int half = 0; half < 2; ++half) {
    if (wm == half) {
#pragma unroll
      for (int mi = 0; mi < 4; ++mi)
#pragma unroll
        for (int ni = 0; ni < 2; ++ni)
#pragma unroll
          for (int g = 0; g < 4; ++g)
            *(f32x4*)(st + (mi * 32 + fr32) * 132 + wn * 64 + ni * 32 + g * 8 + fh * 4) =
                f32x4{acc[mi][ni][g * 4 + 0], acc[mi][ni][g * 4 + 1], acc[mi][ni][g * 4 + 2], acc[mi][ni][g * 4 + 3]};
    }
    __syncthreads();
#pragma unroll 4
    for (int i = threadIdx.x; i < 128 * 32; i += NTHREADS) {
      const int row = i >> 5, c4 = (i & 31) << 2;
      const float4 v = *(const float4*)(st + row * 132 + c4);
      f(half * 128 + row, c4, v);
    }
    __syncthreads();
  }
}

__device__ __forceinline__ void transpose_tile(const float* __restrict__ W, int N, u16* __restrict__ Wt, int K, int k0, int n0, float* lds) {
  const int tid = threadIdx.x;
  __syncthreads();
#pragma unroll
  for (int i = 0; i < 16; ++i) {
    int k = i * 4 + (tid >> 6), n = tid & 63;
    lds[k * 65 + n] = W[(size_t)(k0 + k) * N + n0 + n];
  }
  __syncthreads();
#pragma unroll
  for (int i = 0; i < 16; ++i) {
    int n = i * 4 + (tid >> 6), k = tid & 63;
    Wt[(size_t)(n0 + n) * K + k0 + k] = f2bf(lds[k * 65 + n]);
  }
}

__device__ __forceinline__ void phase_prep(const Params& p, char* smem) {
  const int tid = threadIdx.x;
  float* lds = (float*)smem;
  u16* WIN = (u16*)(p.ws + OFF_WIN);
  u16* WOUT = (u16*)(p.ws + OFF_WOUT);
  u16* WLORA = (u16*)(p.ws + OFF_WLORA);
  u16* KEYS = (u16*)(p.ws + OFF_KEYS);
  float* MOD = (float*)(p.ws + OFF_MOD);
  constexpr int N_MOD = 96, N_T1 = 44 * 16, N_T2 = 16 * 16, N_T3 = 0;
  constexpr int N_TASK = N_MOD + N_T1 + N_T2 + N_T3;
  for (int task = blockIdx.x; task < N_TASK; task += gridDim.x) {
    if (task < N_MOD) {
      __syncthreads();
      for (int i = tid; i < 8 * 1024; i += NTHREADS) lds[i] = siluf_(p.c[i]);
      __syncthreads();
      const int lane = tid & 63, w = tid >> 6;
      const int col = task * 64 + lane;
      float a[8];
#pragma unroll
      for (int b = 0; b < 8; ++b) a[b] = 0.f;
      const float* wp = p.ada_w + (size_t)(w * 256) * 6144 + col;
#pragma unroll 8
      for (int k = 0; k < 256; ++k) {
        float wv = wp[(size_t)k * 6144];
#pragma unroll
        for (int b = 0; b < 8; ++b) a[b] += lds[b * 1024 + w * 256 + k] * wv;
      }
      __syncthreads();
#pragma unroll
      for (int b = 0; b < 8; ++b) lds[8192 + (w * 8 + b) * 64 + lane] = a[b];
      __syncthreads();
      for (int i = tid; i < 512; i += NTHREADS) {
        int b = i >> 6, l = i & 63;
        float s = lds[8192 + (0 * 8 + b) * 64 + l] + lds[8192 + (1 * 8 + b) * 64 + l] + lds[8192 + (2 * 8 + b) * 64 + l] +
                  lds[8192 + (3 * 8 + b) * 64 + l];
        MOD[b * 6144 + task * 64 + l] = s + p.ada_b[task * 64 + l];
      }
    } else {
      int t = task - N_MOD;
      if (t < N_T1) {
        transpose_tile(p.w_in, NPROJ, WIN, D, (t & 15) * 64, (t >> 4) * 64, lds);
      } else if (t < N_T1 + N_T2) {
        t -= N_T1;
        transpose_tile(p.w_out, D, WOUT, D, (t & 15) * 64, (t >> 4) * 64, lds);
      }
    }
  }
  const size_t gtid = (size_t)blockIdx.x * NTHREADS + tid, gn = (size_t)gridDim.x * NTHREADS;
  for (size_t i = gtid; i < (size_t)1536 * 256; i += gn) {
    int n = (int)(i >> 8), k = (int)(i & 255);
    float v = 0.f;
    if (n < 512) { if (k < 64) v = p.w2[k * 512 + n]; }
    else if (n < 1024) { if (k >= 64 && k < 128) v = p.a2[(k - 64) * 512 + (n - 512)]; }
    else { if (k >= 128) v = p.g2[(k - 128) * 512 + (n - 1024)]; }
    WLORA[i] = f2bf(v);
  }
  for (size_t i = gtid; i < (size_t)16 * 128 * 128; i += gn) KEYS[i] = f2bf(p.sub_keys[i]);
  {
    uint2* WQB = (uint2*)(p.ws + OFF_REGF);
    const float4* wq4 = (const float4*)p.w_q;
    for (size_t i = gtid; i < (size_t)1024 * 2048 / 4; i += gn) {
      const float4 v = wq4[i];
      WQB[i] = make_uint2(pack2(v.x, v.y), pack2(v.z, v.w));
    }
  }
}

__device__ __forceinline__ void phase_peer_fold(const Params& p, char* smem) {
  const u16* KEYS = (const u16*)(p.ws + OFF_KEYS);
  const u16* WQB = (const u16*)(p.ws + OFF_REGF);
  u16* MT = (u16*)(p.ws + OFF_WQ);
  for (int tile = blockIdx.x; tile < 16 * 8; tile += gridDim.x) {
    const int hp = tile >> 3, dt = tile & 7;
    f32x16 acc[2][2];
    gemm128(KEYS + (size_t)hp * 128 * 128, 128, WQB + hp * 128, 2048, 128, 0, dt * 128, smem, acc);
    epi_staged(acc, smem, [&](int row, int c4, float4 v) {
      *(uint2*)(MT + (size_t)(hp * 128 + row) * D + dt * 128 + c4) = make_uint2(pack2(v.x, v.y), pack2(v.z, v.w));
    });
  }
}

__device__ __forceinline__ void phase_normmod(const float* __restrict__ X, const float* __restrict__ g, const float* __restrict__ MOD,
                              int sh_off, int sc_off, u16* __restrict__ U) {
  const int lane = threadIdx.x & 63;
  const int gw = blockIdx.x * 4 + (threadIdx.x >> 6), nw = gridDim.x * 4;
  for (int t = gw; t < T; t += nw) {
    const int b = t / SEQ;
    const float4* xr = (const float4*)(X + (size_t)t * D);
    float4 v[4];
    float ss = 0.f;
#pragma unroll
    for (int i = 0; i < 4; ++i) {
      v[i] = xr[i * 64 + lane];
      ss += v[i].x * v[i].x + v[i].y * v[i].y + v[i].z * v[i].z + v[i].w * v[i].w;
    }
    ss = wave_sum(ss);
    const float rstd = __builtin_amdgcn_rsqf(ss * (1.0f / D) + 1e-6f);
    const float4* gp = (const float4*)g;
    const float4* shp = (const float4*)(MOD + b * 6144 + sh_off);
    const float4* scp = (const float4*)(MOD + b * 6144 + sc_off);
    uint2* up = (uint2*)(U + (size_t)t * D);
#pragma unroll
    for (int i = 0; i < 4; ++i) {
      float4 gg = gp[i * 64 + lane], sh = shp[i * 64 + lane], sc = scp[i * 64 + lane];
      float o0 = v[i].x * rstd * gg.x * (1.f + sc.x) + sh.x;
      float o1 = v[i].y * rstd * gg.y * (1.f + sc.y) + sh.y;
      float o2 = v[i].z * rstd * gg.z * (1.f + sc.z) + sh.z;
      float o3 = v[i].w * rstd * gg.w * (1.f + sc.w) + sh.w;
      up[i * 64 + lane] = make_uint2(pack2(o0, o1), pack2(o2, o3));
    }
  }
}

__device__ __forceinline__ void phase_gemm_in(const Params& p, char* smem) {
  const u16* U1 = (const u16*)(p.ws + OFF_REGB);
  const u16* WIN = (const u16*)(p.ws + OFF_WIN);
  u16* P = (u16*)(p.ws + OFF_REGC);
  constexpr int NT = NPROJ / 128, MT = T / 256;
  for (int tile = blockIdx.x; tile < NT * MT; tile += gridDim.x) {
    const int mt = tile / NT, nt = tile % NT;
    f32x16 acc[4][2];
    gemm256(U1, D, WIN, D, D, mt * 256, nt * 128, smem, acc);
    epi_staged256(acc, smem, [&](int row, int c4, float4 v) {
      u16* dst = (nt < 8) ? (P + (size_t)(mt * 256 + row) * 1024 + nt * 128 + c4)
                          : (P + (size_t)32 * MB + (size_t)(mt * 256 + row) * 1792 + (nt - 8) * 128 + c4);
      *(uint2*)dst = make_uint2(pack2(v.x, v.y), pack2(v.z, v.w));
    });
  }
}

__device__ __forceinline__ void phase_act(const Params& p) {
  const u16* P = (const u16*)(p.ws + OFF_PR);
  u16* ACT = (u16*)(p.ws + OFF_REGF + 128 * MB);
  const size_t gtid = (size_t)blockIdx.x * NTHREADS + threadIdx.x, gn = (size_t)gridDim.x * NTHREADS;
  for (size_t i = gtid; i < (size_t)T * 64; i += gn) {
    const int t = (int)(i >> 6), c = (int)(i & 63) * 4;
    const u16* pr = P + (size_t)t * 1792 + 1536 + c;
    uint2 cur = *(const uint2*)pr;
    uint2 prv = make_uint2(0u, 0u);
    if ((t % SEQ) != 0) prv = *(const uint2*)(pr - 1792);
    float4 m = *(const float4*)(p.mu + 1536 + c);
    float x0 = bflo(cur.x), x1 = bfhi(cur.x), x2 = bflo(cur.y), x3 = bfhi(cur.y);
    x0 += m.x * (bflo(prv.x) - x0);
    x1 += m.y * (bfhi(prv.x) - x1);
    x2 += m.z * (bflo(prv.y) - x2);
    x3 += m.w * (bfhi(prv.y) - x3);
    if (c < 64) { x0 = tanhf_(x0); x1 = tanhf_(x1); x2 = tanhf_(x2); x3 = tanhf_(x3); }
    else if (c >= 128) { x0 = sigmoidf_(x0); x1 = sigmoidf_(x1); x2 = sigmoidf_(x2); x3 = sigmoidf_(x3); }
    *(uint2*)(ACT + (size_t)t * 256 + c) = make_uint2(pack2(x0, x1), pack2(x2, x3));
  }
}

__device__ __forceinline__ void conv_tile(const Params& p, int tile, char* smem) {
  const u16* P = (const u16*)(p.ws + OFF_PC);
  u16* MIXIN = (u16*)(p.ws + OFF_REGB);
  const int tid = threadIdx.x, lane = tid & 63, wid = tid >> 6;
  u32* ylds = (u32*)smem;
  float* olds = (float*)(smem + 62 * 1024);
  const int tok0 = tile * 32;
  const int s0 = tok0 % SEQ;
  __syncthreads();
  for (int r = 0; r < 62; ++r) {
    const int s = s0 - 30 + r;
    u32 val = 0u;
    if (s >= 0) {
      const u16* pr = P + (size_t)(tok0 - 30 + r) * 1024;
      u32 a = *(const u32*)(pr + 2 * tid);
      u32 bq = *(const u32*)(pr + 512 + 2 * tid);
      val = pack2(bflo(a) * sigmoidf_(bflo(bq)), bfhi(a) * sigmoidf_(bfhi(bq)));
    }
    ylds[r * 256 + tid] = val;
  }
  __syncthreads();
  float w0[31], w1[31];
#pragma unroll
  for (int j = 0; j < 31; ++j) {
    const float2 wv = *(const float2*)(p.conv_w + j * 512 + 2 * tid);
    w0[j] = wv.x; w1[j] = wv.y;
  }
  const float2 bias = *(const float2*)(p.conv_b + 2 * tid);
  for (int sub = 0; sub < 4; ++sub) {
    float a0[8], a1[8];
#pragma unroll
    for (int q = 0; q < 8; ++q) { a0[q] = bias.x; a1[q] = bias.y; }
#pragma unroll
    for (int rr = 0; rr < 38; ++rr) {
      const u32 yv = ylds[(sub * 8 + rr) * 256 + tid];
      const float y0 = bflo(yv), y1 = bfhi(yv);
#pragma unroll
      for (int q = 0; q < 8; ++q) {
        const int j = rr - q;
        if (j >= 0 && j < 31) { a0[q] += w0[j] * y0; a1[q] += w1[j] * y1; }
      }
    }
#pragma unroll
    for (int q = 0; q < 8; ++q) *(float2*)(olds + q * 512 + 2 * tid) = make_float2(a0[q], a1[q]);
    __syncthreads();
#pragma unroll
    for (int q2 = 0; q2 < 2; ++q2) {
      const int q = wid * 2 + q2;
      const float4 va = *(const float4*)(olds + q * 512 + lane * 8);
      const float4 vb = *(const float4*)(olds + q * 512 + lane * 8 + 4);
      float s = va.x + va.y + va.z + va.w + vb.x + vb.y + vb.z + vb.w;
      s = wave_sum(s);
      const float mean = s * (1.0f / 512.f);
      float d[8] = {va.x - mean, va.y - mean, va.z - mean, va.w - mean, vb.x - mean, vb.y - mean, vb.z - mean, vb.w - mean};
      float vs = 0.f;
#pragma unroll
      for (int e = 0; e < 8; ++e) vs += d[e] * d[e];
      vs = wave_sum(vs);
      const float rstd = __builtin_amdgcn_rsqf(vs * (1.0f / 512.f) + 1e-5f);
      const float4 lw0 = *(const float4*)(p.ln_w + lane * 8), lw1 = *(const float4*)(p.ln_w + lane * 8 + 4);
      const float4 lb0 = *(const float4*)(p.ln_b + lane * 8), lb1 = *(const float4*)(p.ln_b + lane * 8 + 4);
      const float lw[8] = {lw0.x, lw0.y, lw0.z, lw0.w, lw1.x, lw1.y, lw1.z, lw1.w};
      const float lb[8] = {lb0.x, lb0.y, lb0.z, lb0.w, lb1.x, lb1.y, lb1.z, lb1.w};
      float o[8];
#pragma unroll
      for (int e = 0; e < 8; ++e) o[e] = siluf_(d[e] * rstd * lw[e] + lb[e]);
      uint4 pk = make_uint4(pack2(o[0], o[1]), pack2(o[2], o[3]), pack2(o[4], o[5]), pack2(o[6], o[7]));
      *(uint4*)(MIXIN + (size_t)(tok0 + sub * 8 + q) * D + lane * 8) = pk;
    }
    __syncthreads();
  }
}

__device__ __forceinline__ void phase_lora_conv(const Params& p, char* smem) {
  const u16* ACT = (const u16*)(p.ws + OFF_REGF + 128 * MB);
  const u16* WLORA = (const u16*)(p.ws + OFF_WLORA);
  u16* LW = (u16*)(p.ws + OFF_REGF);
  u16* AA = (u16*)(p.ws + OFF_REGD);
  u16* GG = (u16*)(p.ws + OFF_REGD + 32 * MB);
  constexpr int NT = 12, MT = T / 128, NG = NT * MT, NC = T / 32;
  for (int task = blockIdx.x; task < NG; task += gridDim.x) {
    {
      const int mt = task / NT, nt = task % NT;
      f32x16 acc[2][2];
      const int k0 = (nt < 8) ? 0 : 128;
      gemm128d(ACT + k0, 256, WLORA + k0, 256, 128, mt * 128, nt * 128, smem, acc);
      if (nt < 4) {
        epi_staged(acc, smem, [&](int row, int c4, float4 v) {
          const int n = nt * 128 + c4;
          const float4 w0 = *(const float4*)(p.w0 + n);
          const float vv[4] = {v.x + w0.x, v.y + w0.y, v.z + w0.z, v.w + w0.w};
          float o[4];
#pragma unroll
          for (int e = 0; e < 4; ++e) {
            const float z = -vv[e];
            const float sp = fmaxf(z, 0.f) + __logf(1.0f + __expf(-fabsf(z)));
            o[e] = -__expf(-sp - 0.5f);
          }
          *(uint2*)(LW + (size_t)(mt * 128 + row) * 512 + n) = make_uint2(pack2(o[0], o[1]), pack2(o[2], o[3]));
        });
      } else if (nt < 8) {
        epi_staged(acc, smem, [&](int row, int c4, float4 v) {
          const int n = (nt - 4) * 128 + c4;
          const float4 a0 = *(const float4*)(p.a0 + n);
          *(uint2*)(AA + (size_t)(mt * 128 + row) * 512 + n) =
              make_uint2(pack2(sigmoidf_(a0.x + v.x), sigmoidf_(a0.y + v.y)), pack2(sigmoidf_(a0.z + v.z), sigmoidf_(a0.w + v.w)));
        });
      } else {
        epi_staged(acc, smem, [&](int row, int c4, float4 v) {
          const int n = (nt - 8) * 128 + c4;
          *(uint2*)(GG + (size_t)(mt * 128 + row) * 512 + n) = make_uint2(pack2(v.x, v.y), pack2(v.z, v.w));
        });
      }
    }
  }
}

__device__ __forceinline__ void phase_scanprep(const Params& p) {
  const u16* P = (const u16*)(p.ws + OFF_PR);
  const u16* AA = (const u16*)(p.ws + OFF_REGD);
  u16* R = (u16*)(p.ws + OFF_REGF + 32 * MB);
  u16* KM = (u16*)(p.ws + OFF_REGF + 64 * MB);
  u16* V = (u16*)(p.ws + OFF_REGF + 96 * MB);
  u16* KKN = (u16*)(p.ws + OFF_REGF + 128 * MB);
  float* BONUS = (float*)(p.ws + OFF_BONUS);
  const int tid = threadIdx.x;
  const int c = (tid & 127) * 4;
  const float4 mur = *(const float4*)(p.mu + c), muk = *(const float4*)(p.mu + 512 + c), muv = *(const float4*)(p.mu + 1024 + c);
  const float4 kk_ = *(const float4*)(p.k_k + c), ka_ = *(const float4*)(p.k_a + c), rk_ = *(const float4*)(p.r_k + c);
  for (int tp = blockIdx.x; tp < T / 2; tp += gridDim.x) {
    const int t = tp * 2 + (tid >> 7);
    const bool first = (t % SEQ) == 0;
    const u16* pr = P + (size_t)t * 1792 + c;
    float r[4], k[4], v[4];
    {
      uint2 cu = *(const uint2*)pr, pv = first ? make_uint2(0u, 0u) : *(const uint2*)(pr - 1792);
      r[0] = bflo(cu.x); r[1] = bfhi(cu.x); r[2] = bflo(cu.y); r[3] = bfhi(cu.y);
      r[0] += mur.x * (bflo(pv.x) - r[0]); r[1] += mur.y * (bfhi(pv.x) - r[1]);
      r[2] += mur.z * (bflo(pv.y) - r[2]); r[3] += mur.w * (bfhi(pv.y) - r[3]);
    }
    {
      uint2 cu = *(const uint2*)(pr + 512), pv = first ? make_uint2(0u, 0u) : *(const uint2*)(pr + 512 - 1792);
      k[0] = bflo(cu.x); k[1] = bfhi(cu.x); k[2] = bflo(cu.y); k[3] = bfhi(cu.y);
      k[0] += muk.x * (bflo(pv.x) - k[0]); k[1] += muk.y * (bfhi(pv.x) - k[1]);
      k[2] += muk.z * (bflo(pv.y) - k[2]); k[3] += muk.w * (bfhi(pv.y) - k[3]);
    }
    {
      uint2 cu = *(const uint2*)(pr + 1024), pv = first ? make_uint2(0u, 0u) : *(const uint2*)(pr + 1024 - 1792);
      v[0] = bflo(cu.x); v[1] = bfhi(cu.x); v[2] = bflo(cu.y); v[3] = bfhi(cu.y);
      v[0] += muv.x * (bflo(pv.x) - v[0]); v[1] += muv.y * (bfhi(pv.x) - v[1]);
      v[2] += muv.z * (bflo(pv.y) - v[2]); v[3] += muv.w * (bfhi(pv.y) - v[3]);
    }
    const uint2 au = *(const uint2*)(AA + (size_t)t * 512 + c);
    const float a[4] = {bflo(au.x), bfhi(au.x), bflo(au.y), bfhi(au.y)};
    const float kkc[4] = {kk_.x, kk_.y, kk_.z, kk_.w}, kac[4] = {ka_.x, ka_.y, ka_.z, ka_.w}, rkc[4] = {rk_.x, rk_.y, rk_.z, rk_.w};
    float kk[4], km[4];
    float n2 = 0.f, bs = 0.f;
#pragma unroll
    for (int e = 0; e < 4; ++e) {
      kk[e] = k[e] * kkc[e];
      km[e] = k[e] * (1.f + (a[e] - 1.f) * kac[e]);
      n2 += kk[e] * kk[e];
      bs += r[e] * km[e] * rkc[e];
    }
    n2 = row16_sum(n2);
    bs = row16_sum(bs);
    const float inv = fminf(__builtin_amdgcn_rsqf(n2), 1e12f);
    const size_t o = (size_t)t * 512 + c;
    *(uint2*)(R + o) = make_uint2(pack2(r[0], r[1]), pack2(r[2], r[3]));
    *(uint2*)(KM + o) = make_uint2(pack2(km[0], km[1]), pack2(km[2], km[3]));
    *(uint2*)(V + o) = make_uint2(pack2(v[0], v[1]), pack2(v[2], v[3]));
    *(uint2*)(KKN + o) = make_uint2(pack2(kk[0] * inv, kk[1] * inv), pack2(kk[2] * inv, kk[3] * inv));
    if ((tid & 15) == 0) BONUS[(size_t)t * 8 + (c >> 6)] = bs;
  }
}

constexpr size_t OFF_EU8 = OFF_REGC + 128 * MB;
constexpr size_t OFF_EV8 = OFF_REGC + 144 * MB;
constexpr int CVT_CHUNKS = 256;
__device__ __forceinline__ void cvt_chunk(const Params& p, int chunk) {
  u32* EU = (u32*)(p.ws + OFF_EU8);
  u32* EV = (u32*)(p.ws + OFF_EV8);
  const float4* su = (const float4*)p.peer_u;
  const float4* sv = (const float4*)p.peer_v;
  const size_t base = (size_t)chunk * 16384;
#pragma unroll 4
  for (int q = 0; q < 64; ++q) {
    const size_t i = base + q * 256 + threadIdx.x;
    const float4 a = su[i], b = sv[i];
    int va = 0, vb = 0;
    va = __builtin_amdgcn_cvt_pk_fp8_f32(a.x * 512.f, a.y * 512.f, va, false);
    va = __builtin_amdgcn_cvt_pk_fp8_f32(a.z * 512.f, a.w * 512.f, va, true);
    vb = __builtin_amdgcn_cvt_pk_fp8_f32(b.x * 128.f, b.y * 128.f, vb, false);
    vb = __builtin_amdgcn_cvt_pk_fp8_f32(b.z * 128.f, b.w * 128.f, vb, true);
    EU[i] = (u32)va;
    EV[i] = (u32)vb;
  }
}

__device__ __forceinline__ void mix_unit(const Params& p, int u, char* smem) {
  for (int ci = 0; ci < 4; ++ci) conv_tile(p, u * 4 + ci, smem);
}

template <int OFF>
__device__ __forceinline__ f32x4 lds_ld4(unsigned addr) {
  f32x4 r;
  asm volatile("ds_read_b128 %0, %1 offset:%2" : "=v"(r) : "v"(addr), "n"(OFF));
  return r;
}
template <int OFF>
__device__ __forceinline__ float lds_ld1(unsigned addr) {
  float r;
  asm volatile("ds_read_b32 %0, %1 offset:%2" : "=v"(r) : "v"(addr), "n"(OFF));
  return r;
}
constexpr int SC_BUF = 27648;
template <int OFF>
__device__ __forceinline__ v2f lds_ld2(unsigned addr) {
  v2f r;
  asm volatile("ds_read_b64 %0, %1 offset:%2" : "=v"(r) : "v"(addr), "n"(OFF));
  return r;
}
__device__ __forceinline__ void phase_scan(const Params& p, char* smem, int rep) {
  const u16* LW = (const u16*)(p.ws + OFF_REGF);
  const u16* R = (const u16*)(p.ws + OFF_REGF + 32 * MB);
  const u16* KM = (const u16*)(p.ws + OFF_REGF + 64 * MB);
  const u16* V = (const u16*)(p.ws + OFF_REGF + 96 * MB);
  const u16* KKN = (const u16*)(p.ws + OFF_REGF + 128 * MB);
  const u16* AA = (const u16*)(p.ws + OFF_REGD);
  float* Y = (float*)(p.ws + OFF_Y);
  const int tid = threadIdx.x, lane = tid & 63, w = tid >> 6;
  const int jl = lane & 15;
  const int ss = tid >> 4, sg = tid & 15;
  unsigned* claim = (unsigned*)(p.ws + OFF_BAR) + XCD_BAR_WORDS + rep * (2048 + 64);
  unsigned* qctr = claim + 2048;
  int* sflag = (int*)(smem + 2 * SC_BUF);
  float* ypw = (float*)(smem + 56320) + w * 1024;
  const unsigned sbase = (unsigned)(size_t)(LAS char*)smem;
  if (tid == 0) {
    const unsigned key = (xb_xcc_id() & 7u) * 256u + (((unsigned)__builtin_amdgcn_s_getreg(63492) >> 8) & 0xffu);
    sflag[0] = (atomicAdd(&claim[key], 1u) == 0u) ? 1 : 0;
  }
  __syncthreads();
  const bool scan_role = sflag[0] != 0;
  for (;;) {
    if (!scan_role) break;
    __syncthreads();
    if (tid == 0) sflag[1] = (int)atomicAdd(&qctr[0], 1u);
    __syncthreads();
    const int task = sflag[1];
    if (task >= 256) break;
    const int bh = task >> 2, rg = task & 3, b = bh >> 3, h = bh & 7;
    const int il = rg * 16 + w * 4 + (lane >> 4);
    v2f Sa = v2f{0.f, 0.f}, Sb = v2f{0.f, 0.f};
    const size_t base = (size_t)b * SEQ * 512 + h * 64 + sg * 4;
    uint2 gA_lw, gA_r, gA_km, gA_v, gA_kkn, gA_a;
    uint2 gB_lw, gB_r, gB_km, gB_v, gB_kkn, gB_a;
#define SC_GLOAD(X, t0)                                      \
  {                                                          \
    const size_t o = base + (size_t)((t0) + ss) * 512;       \
    X##_lw = *(const uint2*)(LW + o); X##_r = *(const uint2*)(R + o);   \
    X##_km = *(const uint2*)(KM + o); X##_v = *(const uint2*)(V + o);   \
    X##_kkn = *(const uint2*)(KKN + o); X##_a = *(const uint2*)(AA + o); \
  }
#define SC_STORE(X, bi)                                                                                \
  {                                                                                                    \
    float* d = (float*)(smem + (bi) * SC_BUF) + ss * 64 + sg * 4;                                      \
    const float4 kq = make_float4(bflo(X##_kkn.x), bfhi(X##_kkn.x), bflo(X##_kkn.y), bfhi(X##_kkn.y)); \
    *(float4*)(d) = make_float4(__expf(bflo(X##_lw.x)), __expf(bfhi(X##_lw.x)), __expf(bflo(X##_lw.y)), __expf(bfhi(X##_lw.y))); \
    *(float4*)(d + 1024) = kq;                                                                         \
    *(float4*)(d + 2048) = make_float4(kq.x * bflo(X##_a.x), kq.y * bfhi(X##_a.x), kq.z * bflo(X##_a.y), kq.w * bfhi(X##_a.y)); \
    *(float4*)(d + 3072) = make_float4(bflo(X##_km.x), bfhi(X##_km.x), bflo(X##_km.y), bfhi(X##_km.y)); \
    *(float4*)(d + 4096) = make_float4(bflo(X##_r.x), bfhi(X##_r.x), bflo(X##_r.y), bfhi(X##_r.y));    \
    float* vt = (float*)(smem + (bi) * SC_BUF) + 5120 + (sg * 4) * 16 + ss;     \
    vt[0] = bflo(X##_v.x); vt[16] = bfhi(X##_v.x); vt[32] = bflo(X##_v.y); vt[48] = bfhi(X##_v.y);     \
  }
#define SC_ISSUE(sl, S)                                     \
  {                                                         \
    dec_[sl] = lds_ld4<(S) * 256>(a0);                      \
    kkn_[sl] = lds_ld4<4096 + (S) * 256>(a0);               \
    km_[sl] = lds_ld4<12288 + (S) * 256>(a0);               \
    if (((S) & 3) == 0) vq_[((S) >> 2) & 1] = lds_ld4<20480 + (S) * 4>(a1); \
    nb_[sl] = lds_ld4<8192 + (S) * 256>(a0);                \
    rr_[sl] = lds_ld4<16384 + (S) * 256>(a0);               \
  }
#define SC_WAIT(N, sl)                                                                          \
  asm volatile("s_waitcnt lgkmcnt(" #N ")"                                                      \
               : "+v"(dec_[sl]), "+v"(kkn_[sl]), "+v"(nb_[sl]), "+v"(km_[sl]), "+v"(rr_[sl]), "+v"(vq_[0]), "+v"(vq_[1]));
#define LO2(q) (v2f{(q).x, (q).y})
#define HI2(q) (v2f{(q).z, (q).w})
#define SC_STEP(S, N)                                                                       \
  {                                                                                         \
    if ((S) + 2 < 16) SC_ISSUE(((S) + 2) % 3, (S) + 2)                                      \
    SC_WAIT(N, (S) % 3)                                                                     \
    const f32x4 dec = dec_[(S) % 3], kkn = kkn_[(S) % 3], nb = nb_[(S) % 3], km = km_[(S) % 3], rr = rr_[(S) % 3]; \
    const float vv = vq_[((S) >> 2) & 1][(S) & 3];                                          \
    const v2f v2 = v2f{vv, vv};                                                             \
    const v2f Ta = Sa * LO2(dec) + v2 * LO2(km);                                            \
    const v2f Tb = Sb * HI2(dec) + v2 * HI2(km);                                            \
    const v2f dv = Sa * LO2(kkn) + Sb * HI2(kkn);                                           \
    float dot = dv.x + dv.y;                                                                \
    if ((S) > 0) {     \
      dot += DPP_ROR(dot, 8); ypend += DPP_ROR(ypend, 8);                                   \
      dot += DPP_ROR(dot, 4); ypend += DPP_ROR(ypend, 4);                                   \
      dot += DPP_ROR(dot, 2); ypend += DPP_ROR(ypend, 2);                                   \
      dot += DPP_ROR(dot, 1); ypend += DPP_ROR(ypend, 1);                                   \
      ykeep = (jl == (S) - 1) ? ypend : ykeep;                                              \
    } else {                                                                                \
      dot = row16_sum(dot);                                                                 \
    }                                                                                       \
    const v2f d2 = v2f{dot, dot};                                                           \
    Sa = Ta - d2 * LO2(nb);                                                                 \
    Sb = Tb - d2 * HI2(nb);                                                                 \
    const v2f yv = Sa * LO2(rr) + Sb * HI2(rr);                                             \
    ypend = yv.x + yv.y;                                                                    \
    if ((S) == 15) { ypend = row16_sum(ypend); ykeep = (jl == 15) ? ypend : ykeep; }        \
  }
#define SC_COMPUTE(c)                                                                       \
  {                                                                                         \
    const unsigned a0 = sbase + (unsigned)(((c) & 1) * SC_BUF + jl * 16);                   \
    const unsigned a1 = sbase + (unsigned)(((c) & 1) * SC_BUF + il * 64);                   \
    f32x4 dec_[3], kkn_[3], nb_[3], km_[3], rr_[3], vq_[2];                                 \
    float ykeep = 0.f, ypend = 0.f;                                                         \
    SC_ISSUE(0, 0)                                                                          \
    SC_ISSUE(1, 1)                                                                          \
    SC_STEP(0, 10) SC_STEP(1, 10) SC_STEP(2, 10) SC_STEP(3, 10) SC_STEP(4, 10) SC_STEP(5, 10) SC_STEP(6, 10) SC_STEP(7, 10) \
    SC_STEP(8, 10) SC_STEP(9, 10) SC_STEP(10, 10) SC_STEP(11, 10) SC_STEP(12, 10) SC_STEP(13, 10) SC_STEP(14, 5) SC_STEP(15, 0) \
    yp[(size_t)((c) * 16 + jl) * 512] = ykeep;                                              \
  }
    constexpr int NCH = SEQ / 16;
    float* yp = Y + (size_t)b * SEQ * 512 + h * 64 + il;
    __syncthreads();
    SC_GLOAD(gA, 0);
    SC_STORE(gA, 0);
    SC_GLOAD(gA, 16);
    SC_GLOAD(gB, 32);
    __syncthreads();
    for (int c = 0; c < NCH; c += 2) {
      SC_COMPUTE(c)
      SC_STORE(gA, 1)
      if (c + 3 < NCH) SC_GLOAD(gA, (c + 3) * 16);
      asm volatile("s_waitcnt lgkmcnt(0)\n\ts_barrier" ::: "memory");
      SC_COMPUTE(c + 1)
      if (c + 2 < NCH) {
        SC_STORE(gB, 0)
        if (c + 4 < NCH) SC_GLOAD(gB, (c + 4) * 16);
      }
      asm volatile("s_waitcnt lgkmcnt(0)\n\ts_barrier" ::: "memory");
    }
  }
  for (;;) {
    __syncthreads();
    if (tid == 0) sflag[3] = (int)atomicAdd(&qctr[32], 1u);
    __syncthreads();
    const int u = sflag[3];
    __syncthreads();
    if (u >= T / 128) break;
    mix_unit(p, u, smem);
  }
  for (;;) {
    __syncthreads();
    if (tid == 0) sflag[2] = (int)atomicAdd(&qctr[16], 1u);
    __syncthreads();
    const int ch = sflag[2];
    if (ch >= CVT_CHUNKS) break;
    cvt_chunk(p, ch);
  }
}

__device__ __forceinline__ void phase_post(const Params& p) {
  const float* Y = (const float*)(p.ws + OFF_Y);
  const u16* V = (const u16*)(p.ws + OFF_REGF + 96 * MB);
  const u16* GG = (const u16*)(p.ws + OFF_REGD + 32 * MB);
  const float* BONUS = (const float*)(p.ws + OFF_BONUS);
  u16* MIXIN = (u16*)(p.ws + OFF_REGB);
  const int tid = threadIdx.x;
  const int c = (tid & 127) * 4;
  const float4 gw = *(const float4*)(p.gn_w + c), gb = *(const float4*)(p.gn_b + c);
  for (int tp = blockIdx.x; tp < T / 2; tp += gridDim.x) {
    const int t = tp * 2 + (tid >> 7);
    const size_t o = (size_t)t * 512 + c;
    const float4 y = *(const float4*)(Y + o);
    float s = row16_sum(y.x + y.y + y.z + y.w);
    const float mean = s * (1.f / 64.f);
    const float d0 = y.x - mean, d1 = y.y - mean, d2 = y.z - mean, d3 = y.w - mean;
    const float var = row16_sum(d0 * d0 + d1 * d1 + d2 * d2 + d3 * d3) * (1.f / 64.f);
    const float rstd = __builtin_amdgcn_rsqf(var + 64e-5f);
    const float bon = BONUS[(size_t)t * 8 + (c >> 6)];
    const uint2 vu = *(const uint2*)(V + o), gu = *(const uint2*)(GG + o);
    const float o0 = (d0 * rstd * gw.x + gb.x + bon * bflo(vu.x)) * bflo(gu.x);
    const float o1 = (d1 * rstd * gw.y + gb.y + bon * bfhi(vu.x)) * bfhi(gu.x);
    const float o2 = (d2 * rstd * gw.z + gb.z + bon * bflo(vu.y)) * bflo(gu.y);
    const float o3 = (d3 * rstd * gw.w + gb.w + bon * bfhi(vu.y)) * bfhi(gu.y);
    *(uint2*)(MIXIN + (size_t)t * D + 512 + c) = make_uint2(pack2(o0, o1), pack2(o2, o3));
  }
}

__device__ __forceinline__ void phase_gemm_out(const Params& p, char* smem) {
  const u16* MIXIN = (const u16*)(p.ws + OFF_REGB);
  const u16* WOUT = (const u16*)(p.ws + OFF_WOUT);
  const float* MOD = (const float*)(p.ws + OFF_MOD);
  constexpr int NT = D / 128, MT = T / 128;
  for (int tile = blockIdx.x; tile < NT * MT; tile += gridDim.x) {
    const int mt = tile / NT, nt = tile % NT;
    f32x16 acc[2][2];
    gemm128d(MIXIN, D, WOUT, D, D, mt * 128, nt * 128, smem, acc);
    const int b = (mt * 128) / SEQ;
    const float* gt = MOD + b * 6144 + 2048 + nt * 128;
    epi_staged(acc, smem, [&](int row, int c4, float4 v) {
      const size_t o = (size_t)(mt * 128 + row) * D + nt * 128 + c4;
      const float4 xv = *(const float4*)(p.x + o);
      const float4 g = *(const float4*)(gt + c4);
      *(float4*)(p.out + o) = make_float4(xv.x + g.x * v.x, xv.y + g.y * v.y, xv.z + g.z * v.z, xv.w + g.w * v.w);
    });
  }
}

__device__ __forceinline__ u32 f2ord(float f) {
  u32 u = __float_as_uint(f);
  return (u & 0x80000000u) ? ~u : (u | 0x80000000u);
}
__device__ __forceinline__ float ord2f(u32 u) {
  u = (u & 0x80000000u) ? (u & 0x7FFFFFFFu) : ~u;
  return __uint_as_float(u);
}
#define TOPK_INSERT(L, x)                       \
  {                                             \
    u32 _x = (x);                               \
    _Pragma("unroll") for (int _i = 0; _i < 16; ++_i) { \
      u32 _hi = max(L[_i], _x);                 \
      _x = min(L[_i], _x);                      \
      L[_i] = _hi;                              \
    }                                           \
  }

#define CMPEX_DESC(a, b) { const u32 _hi = max(a, b); const u32 _lo = min(a, b); a = _hi; b = _lo; }
__device__ __forceinline__ void sort16_desc(u32 (&v)[16]) {
#pragma unroll
  for (int k = 2; k <= 16; k <<= 1) {
#pragma unroll
    for (int j = k >> 1; j > 0; j >>= 1) {
#pragma unroll
      for (int i = 0; i < 16; ++i) {
        const int l = i ^ j;
        if (l > i) {
          if ((i & k) == 0) CMPEX_DESC(v[i], v[l]) else CMPEX_DESC(v[l], v[i])
        }
      }
    }
  }
}
__device__ __forceinline__ void merge16_desc(u32 (&a)[16], const u32 (&b)[16]) {
#pragma unroll
  for (int i = 0; i < 16; ++i) a[i] = max(a[i], b[15 - i]);
#pragma unroll
  for (int j = 8; j > 0; j >>= 1) {
#pragma unroll
    for (int i = 0; i < 16; ++i) {
      const int l = i ^ j;
      if (l > i) CMPEX_DESC(a[i], a[l])
    }
  }
}

__device__ __forceinline__ void phase_peer_route(const Params& p, char* smem) {
  const u16* U2 = (const u16*)(p.ws + OFF_REGB);
  const u16* WQ = (const u16*)(p.ws + OFF_WQ);
  const u16* KEYS = (const u16*)(p.ws + OFF_KEYS);
  int* EXPID = (int*)(p.ws + OFF_EXPID);
  float* GATE = (float*)(p.ws + OFF_GATE);
  const int tid = threadIdx.x, lane = tid & 63, wid = tid >> 6, wm = wid >> 1, wn = wid & 1, fr = lane & 15, fq = lane >> 4;
  constexpr int QROWB = 272;
  char* qs = smem;
  char* ks = smem + 128 * QROWB;
  float* sT = (float*)smem;
  for (int task = blockIdx.x; task < (T / 128) * PEER_H; task += gridDim.x) {
    const int mt = task / PEER_H, h = task % PEER_H;
    u32 L0[16], L1[16];
#pragma unroll
    for (int pp = 0; pp < 2; ++pp) {
      f32x16 sc[2][2];
      gemm128(U2, D, WQ, D, D, mt * 128, h * 256 + pp * 128, smem, sc);
      {
        const int fr32 = lane & 31, fh = lane >> 5;
#pragma unroll
        for (int mi = 0; mi < 2; ++mi)
#pragma unroll
          for (int ni = 0; ni < 2; ++ni)
#pragma unroll
            for (int g = 0; g < 4; ++g)
              *(f32x4*)(sT + (wm * 64 + mi * 32 + fr32) * 132 + wn * 64 + ni * 32 + g * 8 + fh * 4) =
                  f32x4{sc[mi][ni][g * 4 + 0], sc[mi][ni][g * 4 + 1], sc[mi][ni][g * 4 + 2], sc[mi][ni][g * 4 + 3]};
      }
      __syncthreads();
      {
        const int trow = tid & 127, half = tid >> 7;
        u32 L[16];
#pragma unroll
        for (int i = 0; i < 16; ++i) L[i] = 0u;
#pragma unroll 1
        for (int g = 0; g < 4; ++g) {
          u32 grp[16];
          const int kb = half * 64 + g * 16;
#pragma unroll
          for (int i4 = 0; i4 < 4; ++i4) {
            const float4 sv = *(const float4*)(sT + trow * 132 + kb + i4 * 4);
            grp[i4 * 4 + 0] = (f2ord(sv.x) & ~0x7Fu) | (u32)(127 - kb - i4 * 4);
            grp[i4 * 4 + 1] = (f2ord(sv.y) & ~0x7Fu) | (u32)(126 - kb - i4 * 4);
            grp[i4 * 4 + 2] = (f2ord(sv.z) & ~0x7Fu) | (u32)(125 - kb - i4 * 4);
            grp[i4 * 4 + 3] = (f2ord(sv.w) & ~0x7Fu) | (u32)(124 - kb - i4 * 4);
          }
          sort16_desc(grp);
          merge16_desc(L, grp);
        }
        __syncthreads();
        u32* xl = (u32*)smem;
        if (half == 1) {
#pragma unroll
          for (int i = 0; i < 16; ++i) xl[trow * 17 + i] = L[i];
        }
        __syncthreads();
        if (half == 0) {
          u32 oth[16];
#pragma unroll
          for (int i = 0; i < 16; ++i) oth[i] = xl[trow * 17 + i];
          merge16_desc(L, oth);
#pragma unroll
          for (int i = 0; i < 16; ++i) {
            if (pp == 0) L0[i] = L[i]; else L1[i] = L[i];
          }
        }
      }
      __syncthreads();
    }
    if (tid < 128) {
      float s0[16], s1[16];
#pragma unroll
      for (int i = 0; i < 16; ++i) {
        s0[i] = ord2f(L0[i] & ~0x7Fu);
        s1[i] = ord2f(L1[i] & ~0x7Fu);
      }
#define CKEY(i, j) ((f2ord(s0[i] + s1[j]) & ~0xFFu) | (u32)(255 - ((i) * 16 + (j))))
      u32 B[16], Bk[16], Ck[16], Dk[16];
#pragma unroll
      for (int j = 0; j < 16; ++j) B[j] = CKEY(0, j);
#pragma unroll
      for (int j = 0; j < 8; ++j) Bk[j] = CKEY(1, j);
#pragma unroll
      for (int j = 0; j < 5; ++j) Bk[8 + j] = CKEY(2, j);
#pragma unroll
      for (int j = 0; j < 3; ++j) Bk[13 + j] = CKEY(4, j);
#pragma unroll
      for (int j = 0; j < 4; ++j) Ck[j] = CKEY(3, j);
#pragma unroll
      for (int j = 0; j < 2; ++j) { Ck[4 + j] = CKEY(5, j); Ck[6 + j] = CKEY(6, j); Ck[8 + j] = CKEY(7, j); }
#pragma unroll
      for (int i = 8; i < 14; ++i) Ck[10 + (i - 8)] = CKEY(i, 0);
      {
        const u32 d14 = CKEY(14, 0), d15 = CKEY(15, 0);
        Dk[0] = max(d14, d15);
        Dk[1] = min(d14, d15);
#pragma unroll
        for (int i = 2; i < 16; ++i) Dk[i] = 0u;
      }
#undef CKEY
      sort16_desc(Bk);
      sort16_desc(Ck);
      merge16_desc(B, Bk);
      merge16_desc(B, Ck);
      merge16_desc(B, Dk);
      float bv[16];
      int eid[16];
      u32* slot = (u32*)smem + tid * 33;
#pragma unroll
      for (int z = 0; z < 16; ++z) { slot[z] = L0[z]; slot[16 + z] = L1[z]; }
#pragma unroll
      for (int q = 0; q < 16; ++q) {
        const int pos = 255 - (int)(B[q] & 0xFFu);
        const u32 a = slot[pos >> 4], bq = slot[16 + (pos & 15)];
        const int i0 = 127 - (int)(a & 0x7Fu), i1 = 127 - (int)(bq & 0x7Fu);
        eid[q] = i0 * NKEYS + i1;
        bv[q] = ord2f(a & ~0x7Fu) + ord2f(bq & ~0x7Fu);
      }
      float mx = bv[0];
#pragma unroll
      for (int q = 1; q < 16; ++q) mx = fmaxf(mx, bv[q]);
      float den = 0.f;
#pragma unroll
      for (int q = 0; q < 16; ++q) { bv[q] = __expf(bv[q] - mx); den += bv[q]; }
      const float rden = __builtin_amdgcn_rcpf(den);
      const size_t o = ((size_t)(mt * 128 + tid) * PEER_H + h) * 16;
#pragma unroll
      for (int q = 0; q < 16; q += 4) {
        *(int4*)(EXPID + o + q) = make_int4(eid[q], eid[q + 1], eid[q + 2], eid[q + 3]);
        *(float4*)(GATE + o + q) = make_float4(bv[q] * rden, bv[q + 1] * rden, bv[q + 2] * rden, bv[q + 3] * rden);
      }
    }
    __syncthreads();
  }
}

#define CVT_LO(w) __builtin_amdgcn_cvt_pk_f32_fp8((int)(w), false)
#define CVT_HI(w) __builtin_amdgcn_cvt_pk_f32_fp8((int)(w), true)
__device__ __forceinline__ void phase_peer_gather(const Params& p) {
  const u16* U2 = (const u16*)(p.ws + OFF_REGB);
  const uint4* EU = (const uint4*)(p.ws + OFF_EU8);
  const uint4* EV = (const uint4*)(p.ws + OFF_EV8);
  const int* EXPID = (const int*)(p.ws + OFF_EXPID);
  const float* GATE = (const float*)(p.ws + OFF_GATE);
  const float* MOD = (const float*)(p.ws + OFF_MOD);
  const int lane = threadIdx.x & 63;
  const int gw = blockIdx.x * 4 + (threadIdx.x >> 6), nw = gridDim.x * 4;
  for (int t = gw; t < T; t += nw) {
    const int b = t / SEQ;
    const uint4 xa = *(const uint4*)(U2 + (size_t)t * D + lane * 16);
    const uint4 xb = *(const uint4*)(U2 + (size_t)t * D + lane * 16 + 8);
    v2f x2[8];
    x2[0] = v2f{bflo(xa.x), bfhi(xa.x)}; x2[1] = v2f{bflo(xa.y), bfhi(xa.y)};
    x2[2] = v2f{bflo(xa.z), bfhi(xa.z)}; x2[3] = v2f{bflo(xa.w), bfhi(xa.w)};
    x2[4] = v2f{bflo(xb.x), bfhi(xb.x)}; x2[5] = v2f{bflo(xb.y), bfhi(xb.y)};
    x2[6] = v2f{bflo(xb.z), bfhi(xb.z)}; x2[7] = v2f{bflo(xb.w), bfhi(xb.w)};
    v2f o2[8];
#pragma unroll
    for (int i = 0; i < 8; ++i) o2[i] = v2f{0.f, 0.f};
    const int idA = EXPID[(size_t)t * 128 + lane], idB = EXPID[(size_t)t * 128 + 64 + lane];
    const float gA = GATE[(size_t)t * 128 + lane], gB = GATE[(size_t)t * 128 + 64 + lane];
    for (int h = 0; h < PEER_H; ++h) {
      const int idv = (h < 4) ? idA : idB;
      const float gtv = (h < 4) ? gA : gB;
      const int lb = (h & 3) * 16;
      float part[16];
#pragma unroll
      for (int e = 0; e < 16; ++e) {
        const int id = __builtin_amdgcn_readlane(idv, lb + e);
        const uint4 a = EU[(size_t)id * 64 + lane];
        v2f acc = CVT_LO(a.x) * x2[0];
        acc = CVT_HI(a.x) * x2[1] + acc;
        acc = CVT_LO(a.y) * x2[2] + acc;
        acc = CVT_HI(a.y) * x2[3] + acc;
        acc = CVT_LO(a.z) * x2[4] + acc;
        acc = CVT_HI(a.z) * x2[5] + acc;
        acc = CVT_LO(a.w) * x2[6] + acc;
        acc = CVT_HI(a.w) * x2[7] + acc;
        part[e] = acc.x + acc.y;
      }
      float p8[8], p4[4], p2[2], p1;
      {
        const bool up = (lane & 32) != 0;
#pragma unroll
        for (int e = 0; e < 8; ++e) {
          const float mine = up ? part[e + 8] : part[e];
          const float oth = up ? part[e] : part[e + 8];
          p8[e] = mine + __shfl_xor(oth, 32);
        }
      }
      {
        const bool up = (lane & 16) != 0;
#pragma unroll
        for (int e = 0; e < 4; ++e) {
          const float mine = up ? p8[e + 4] : p8[e];
          const float oth = up ? p8[e] : p8[e + 4];
          p4[e] = mine + __shfl_xor(oth, 16);
        }
      }
      {
        const bool up = (lane & 8) != 0;
#pragma unroll
        for (int e = 0; e < 2; ++e) {
          const float mine = up ? p4[e + 2] : p4[e];
          const float oth = up ? p4[e] : p4[e + 2];
          p2[e] = mine + __shfl_xor(oth, 8);
        }
      }
      {
        const bool up = (lane & 4) != 0;
        const float mine = up ? p2[1] : p2[0];
        const float oth = up ? p2[0] : p2[1];
        p1 = mine + __shfl_xor(oth, 4);
      }
      p1 += __shfl_xor(p1, 2);
      p1 += __shfl_xor(p1, 1);
      p1 *= (1.0f / 512.f);
      const int myE = ((lane >> 5) & 1) * 8 + ((lane >> 4) & 1) * 4 + ((lane >> 3) & 1) * 2 + ((lane >> 2) & 1);
      const float gmine = __shfl(gtv, lb + myE);
      const float hv = 0.5f * p1 * (1.0f + erff(p1 * 0.70710678118654752f));
      const float coef = gmine * hv * (1.0f / 128.f);
#pragma unroll
      for (int e = 0; e < 16; ++e) {
        const int srcLane = ((e >> 3) & 1) * 32 + ((e >> 2) & 1) * 16 + ((e >> 1) & 1) * 8 + (e & 1) * 4;
        const float ce = __builtin_bit_cast(float, __builtin_amdgcn_readlane(__builtin_bit_cast(int, coef), srcLane));
        const int id = __builtin_amdgcn_readlane(idv, lb + e);
        const uint4 a = EV[(size_t)id * 64 + lane];
        const v2f c2 = v2f{ce, ce};
        o2[0] = CVT_LO(a.x) * c2 + o2[0];
        o2[1] = CVT_HI(a.x) * c2 + o2[1];
        o2[2] = CVT_LO(a.y) * c2 + o2[2];
        o2[3] = CVT_HI(a.y) * c2 + o2[3];
        o2[4] = CVT_LO(a.z) * c2 + o2[4];
        o2[5] = CVT_HI(a.z) * c2 + o2[5];
        o2[6] = CVT_LO(a.w) * c2 + o2[6];
        o2[7] = CVT_HI(a.w) * c2 + o2[7];
      }
    }
    float* orow = p.out + (size_t)t * D + lane * 16;
    const float* gt = MOD + b * 6144 + 5120 + lane * 16;
    float xf[16];
    float ss = 0.f;
#pragma unroll
    for (int q = 0; q < 4; ++q) {
      const float4 x0 = *(const float4*)(orow + q * 4);
      const float4 g0 = *(const float4*)(gt + q * 4);
      xf[q * 4 + 0] = x0.x + g0.x * o2[q * 2].x;
      xf[q * 4 + 1] = x0.y + g0.y * o2[q * 2].y;
      xf[q * 4 + 2] = x0.z + g0.z * o2[q * 2 + 1].x;
      xf[q * 4 + 3] = x0.w + g0.w * o2[q * 2 + 1].y;
    }
#pragma unroll
    for (int i = 0; i < 16; ++i) ss += xf[i] * xf[i];
    ss = wave_sum(ss);
    const float rstd = __builtin_amdgcn_rsqf(ss * (1.0f / D) + 1e-6f);
#pragma unroll
    for (int q = 0; q < 4; ++q) {
      const float4 f0 = *(const float4*)(p.final_g + lane * 16 + q * 4);
      *(float4*)(orow + q * 4) =
          make_float4(xf[q * 4 + 0] * rstd * f0.x, xf[q * 4 + 1] * rstd * f0.y, xf[q * 4 + 2] * rstd * f0.z, xf[q * 4 + 3] * rstd * f0.w);
    }
  }
}

#ifndef PROBE_MASK
#define PROBE_MASK 0
#endif
__global__ void __launch_bounds__(NTHREADS, 2) hymba_mega(Params p) {
  __shared__ __attribute__((aligned(16))) char smem[SMEM_BYTES];
  __shared__ uint4 xb_words;
  cg::grid_group grid = cg::this_grid();
  if (threadIdx.x == 0) xb_words = make_uint4(0u, 0u, 0u, 0u);
  __syncthreads();
  const XcdBarrier xb = xcd_barrier_post((unsigned*)(p.ws + OFF_BAR), (volatile LAS unsigned*)&xb_words);
#define RUN_PHASE(N, CALL)                          \
  {                                                 \
    CALL;                                           \
    if ((PROBE_MASK >> (N)) & 1) { xcd_barrier(xb); CALL; } \
  }
  RUN_PHASE(0, phase_prep(p, smem))
  grid.sync();
  phase_peer_fold(p, smem);
  RUN_PHASE(1, phase_normmod(p.x, p.norm_mix_g, (const float*)(p.ws + OFF_MOD), 0, 1024, (u16*)(p.ws + OFF_REGB)))
  xcd_barrier(xb);
  RUN_PHASE(2, phase_gemm_in(p, smem))
  xcd_barrier(xb);
  RUN_PHASE(3, phase_act(p))
  xcd_barrier(xb);
  RUN_PHASE(4, phase_lora_conv(p, smem))
  xcd_barrier(xb);
  RUN_PHASE(5, phase_scanprep(p))
  xcd_barrier(xb);
  phase_scan(p, smem, 0);
  if ((PROBE_MASK >> 6) & 1) { xcd_barrier(xb); phase_scan(p, smem, 1); }
  xcd_barrier(xb);
  RUN_PHASE(7, phase_post(p))
  xcd_barrier(xb);
  RUN_PHASE(8, phase_gemm_out(p, smem))
  xcd_barrier(xb);
  RUN_PHASE(9, phase_normmod(p.out, p.norm_ffn_g, (const float*)(p.ws + OFF_MOD), 3072, 4096, (u16*)(p.ws + OFF_REGB)))
  xcd_barrier(xb);
  RUN_PHASE(10, phase_peer_route(p, smem))
  xcd_barrier(xb);
  phase_peer_gather(p);
#ifdef PROBE_TIME
  xcd_barrier(xb);
  if (blockIdx.x == 0 && threadIdx.x == 0) p.out[0] += *(const float*)(p.ws + OFF_BAR + 32768);
#endif
}

extern "C" void kernel_launch(void* const* d_in, const int* in_sizes, int n_in, void* d_out, int out_size, void* d_ws,
                              size_t ws_size, hipStream_t stream) {
  static int grid_blocks = 0;
  if (!grid_blocks) {
    int dev = 0, cus = 0, per_cu = 0;
    (void)hipGetDevice(&dev);
    (void)hipDeviceGetAttribute(&cus, hipDeviceAttributeMultiprocessorCount, dev);
    (void)hipOccupancyMaxActiveBlocksPerMultiprocessor(&per_cu, hymba_mega, NTHREADS, 0);
    if (per_cu > 2) per_cu = 2;
    grid_blocks = cus * per_cu;
  }
  if (ws_size < WS_NEEDED) {
    fprintf(stderr, "workspace too small: %zu < %zu\n", ws_size, (size_t)WS_NEEDED);
    return;
  }
  Params p{};
  const float** pf = (const float**)&p;
  for (int i = 0; i < 28; ++i) pf[i] = (const float*)d_in[i];
  p.out = (float*)d_out;
  p.ws = (char*)d_ws;
  (void)hipMemsetAsync((char*)d_ws + OFF_BAR, 0, (XCD_BAR_WORDS + 2 * (2048 + 64)) * 4, stream);
  void* args[] = {&p};
  hipError_t e = hipLaunchCooperativeKernel((void*)hymba_mega, dim3(grid_blocks), dim3(NTHREADS), args, 0, stream);
  if (e != hipSuccess) fprintf(stderr, "cooperative launch failed: %s (grid %d)\n", hipGetErrorString(e), grid_blocks);
}
```

```cpp
#include <hip/hip_runtime.h>
#include <hip/hip_cooperative_groups.h>
#include <cstdio>
#include <cstdint>
namespace cg = cooperative_groups;

typedef unsigned short u16;
typedef unsigned int u32;
using bf16x8 = __attribute__((ext_vector_type(8))) short;
using f32x4 = __attribute__((ext_vector_type(4))) float;
using f32x16 = __attribute__((ext_vector_type(16))) float;
typedef __attribute__((ext_vector_type(2))) __bf16 bf2_t;
typedef float v2f __attribute__((ext_vector_type(2)));

constexpr int D = 1024, NBATCH = 8, SEQ = 4096, T = NBATCH * SEQ;
constexpr int CONV_CH = 512, RW = 512, NPROJ = 2816, RWKV_PROJ = 1792;
constexpr int CONV_W = 31;
constexpr int NHEAD = 8;
constexpr int PEER_H = 8, PEER_K = 16, NKEYS = 128;
constexpr int NTHREADS = 256;
constexpr int SMEM_BYTES = 79872;

constexpr size_t MB = 1ull << 20;
constexpr size_t OFF_WIN = 0;
constexpr size_t OFF_WOUT = OFF_WIN + (size_t)NPROJ * D * 2;
constexpr size_t OFF_WQ = OFF_WOUT + (size_t)D * D * 2;
constexpr size_t OFF_WLORA = OFF_WQ + (size_t)2048 * D * 2;
constexpr size_t OFF_KEYS = OFF_WLORA + (size_t)1536 * 256 * 2;
constexpr size_t OFF_MOD = OFF_KEYS + (size_t)16 * 128 * 128 * 2;
constexpr size_t OFF_BONUS = OFF_MOD + (size_t)8 * 6144 * 4;
constexpr size_t OFF_BAR = OFF_BONUS + (size_t)T * 8 * 4;
constexpr size_t OFF_REGB = 16 * MB;
constexpr size_t OFF_REGC = OFF_REGB + 64 * MB;
constexpr size_t SZ_P = (size_t)T * NPROJ * 2;
constexpr size_t OFF_PC = OFF_REGC;
constexpr size_t OFF_PR = OFF_REGC + 64 * MB;
constexpr size_t OFF_Y = OFF_REGC + 64 * MB;
constexpr size_t OFF_EXPID = OFF_REGC + 160 * MB;
constexpr size_t OFF_GATE = OFF_REGC + 176 * MB;
constexpr size_t OFF_REGD = OFF_REGC + 176 * MB + 16 * MB;
constexpr size_t OFF_REGF = OFF_REGD + 64 * MB;
constexpr size_t WS_NEEDED = OFF_REGF + 160 * MB;
static_assert(OFF_BAR + (3456 + 2 * (2048 + 64)) * 4 <= OFF_REGB, "small region overflow");
static_assert(SZ_P <= 192 * MB, "P overflow");

struct Params {
  const float *x, *c, *ada_w, *ada_b, *norm_mix_g, *w_in, *conv_w, *conv_b, *ln_w, *ln_b;
  const float *mu, *w0, *w2, *a0, *a2, *g2, *k_k, *k_a, *r_k, *gn_w, *gn_b, *w_out, *norm_ffn_g;
  const float *w_q, *sub_keys, *peer_u, *peer_v, *final_g;
  float* out;
  char* ws;
};

typedef __bf16 bf2v_t __attribute__((ext_vector_type(2)));
__device__ __forceinline__ u32 pack2(float a, float b) {
  return __builtin_bit_cast(u32, __builtin_convertvector((v2f{a, b}), bf2v_t));
}
__device__ __forceinline__ u16 f2bf(float f) { return (u16)(pack2(f, 0.f) & 0xFFFFu); }
__device__ __forceinline__ float bf2f(u16 h) { return __uint_as_float(((u32)h) << 16); }

__device__ __forceinline__ float bflo(u32 v) { return __uint_as_float(v << 16); }
__device__ __forceinline__ float bfhi(u32 v) { return __uint_as_float(v & 0xFFFF0000u); }
__device__ __forceinline__ float sigmoidf_(float x) { return __builtin_amdgcn_rcpf(1.0f + __expf(-x)); }
__device__ __forceinline__ float tanhf_(float x) {
  const float e = __expf(-2.0f * fabsf(x));
  return copysignf((1.0f - e) * __builtin_amdgcn_rcpf(1.0f + e), x);
}
__device__ __forceinline__ float erff_(float x) {
  const float ax = fabsf(x);
  const float t = __builtin_amdgcn_rcpf(1.0f + 0.3275911f * ax);
  const float poly = t * (0.254829592f + t * (-0.284496736f + t * (1.421413741f + t * (-1.453152027f + t * 1.061405429f))));
  return copysignf(1.0f - poly * __expf(-ax * ax), x);
}
__device__ __forceinline__ float siluf_(float x) { return x * sigmoidf_(x); }
__device__ __forceinline__ float wave_sum(float v) {
#pragma unroll
  for (int o = 32; o > 0; o >>= 1) v += __shfl_xor(v, o);
  return v;
}
__device__ __forceinline__ float dpp_ror_add(float x, int) { return x; }
#define DPP_ROR(x, N) __builtin_bit_cast(float, __builtin_amdgcn_update_dpp(0, __builtin_bit_cast(int, (x)), 0x120 + (N), 0xF, 0xF, false))
__device__ __forceinline__ float row16_sum(float x) {
  x += DPP_ROR(x, 8);
  x += DPP_ROR(x, 4);
  x += DPP_ROR(x, 2);
  x += DPP_ROR(x, 1);
  return x;
}

#define XB_TMO      128
#define XB_XCNT(j)  (256  + 64 * (j))
#define XB_XSUB(j)  (1280 + 64 * (j))
#define XB_XGEN(j)  (2304 + 64 * (j))
#define XB_TOP      3328
#define XB_TOPGEN   3392
#define XCD_BAR_WORDS 3456
#define XB_SPIN_CAP (1u << 18)
#define LAS __attribute__((address_space(3)))
__device__ __forceinline__ unsigned xb_ld(unsigned* p)              { return __hip_atomic_load(p, __ATOMIC_RELAXED, __HIP_MEMORY_SCOPE_AGENT); }
__device__ __forceinline__ unsigned xb_add(unsigned* p, unsigned v) { return __hip_atomic_fetch_add(p, v, __ATOMIC_RELAXED, __HIP_MEMORY_SCOPE_AGENT); }
__device__ __forceinline__ unsigned xb_xcc_id() { return (unsigned)__builtin_amdgcn_s_getreg((3 << 11) | 20) & 0xFu; }
#define XB_SPIN(cond, bar) do { unsigned _sp = 0; while (cond) { __builtin_amdgcn_s_sleep(1); \
    if ((++_sp & 255u) == 0u) { if (xb_ld(&(bar)[XB_TMO])) break; if (_sp > XB_SPIN_CAP) { atomicAdd(&(bar)[XB_TMO], 1u); break; } } } } while (0)
struct XcdBarrier { unsigned* bar; unsigned x; volatile LAS unsigned* st; };
__device__ __forceinline__ XcdBarrier xcd_barrier_post(unsigned* bar, volatile LAS unsigned* st) {
    XcdBarrier b; b.bar = bar; b.x = xb_xcc_id(); b.st = st;
    if (threadIdx.x == 0) (void)xb_add(&bar[XB_XCNT(b.x)], 1u);
    return b;
}
__device__ __forceinline__ void xcd_barrier_complete(unsigned* bar, unsigned x, unsigned& nloc, unsigned& nx) {
    const unsigned G = gridDim.x * gridDim.y * gridDim.z;
    unsigned sum, cnt, mine, sp = 0u;
    for (;;) {
        sum = 0u; cnt = 0u; mine = 0u;
#pragma unroll
        for (unsigned j = 0; j < 16; ++j) { const unsigned c = xb_ld(&bar[XB_XCNT(j)]); sum += c; cnt += (c > 0u) ? 1u : 0u; mine = (j == x) ? c : mine; }
        if (sum == G) break;
        __builtin_amdgcn_s_sleep(1);
        if ((++sp & 255u) == 0u) { if (xb_ld(&bar[XB_TMO])) break; if (sp > XB_SPIN_CAP) { atomicAdd(&bar[XB_TMO], 1u); break; } }
    }
    nloc = mine > 0u ? mine : 1u; nx = cnt > 0u ? cnt : 1u;
}
__device__ __forceinline__ void xcd_barrier(const XcdBarrier& b) {
    asm volatile("s_waitcnt vmcnt(0)" ::: "memory");
    __syncthreads();
    if (threadIdx.x == 0) {
        unsigned* bar = b.bar;
        __builtin_amdgcn_s_waitcnt(0);
        unsigned nloc = b.st[0], nx = b.st[1];
        if (nloc == 0u) { xcd_barrier_complete(bar, b.x, nloc, nx); b.st[0] = nloc; b.st[1] = nx; }
        const unsigned old = xb_add(&bar[XB_XSUB(b.x)], 1u);
        const unsigned gen = old / nloc;
        if (old + 1u == (gen + 1u) * nloc) {
            __builtin_amdgcn_fence(__ATOMIC_RELEASE, "agent");
            asm volatile("s_waitcnt vmcnt(0)" ::: "memory");
            const unsigned og = xb_add(&bar[XB_TOP], 1u);
            const unsigned tg = og / nx;
            if (og + 1u == (tg + 1u) * nx) xb_add(&bar[XB_TOPGEN], 1u);
            else XB_SPIN(xb_ld(&bar[XB_TOPGEN]) == tg, bar);
            __builtin_amdgcn_fence(__ATOMIC_ACQUIRE, "agent");
            xb_add(&bar[XB_XGEN(b.x)], 1u);
            asm volatile("s_waitcnt vmcnt(0)" ::: "memory");
        } else {
            XB_SPIN(xb_ld(&bar[XB_XGEN(b.x)]) == gen, bar);
            __builtin_amdgcn_fence(__ATOMIC_ACQUIRE, "agent");
            asm volatile("s_waitcnt vmcnt(0)" ::: "memory");
        }
    }
    __syncthreads();
}

constexpr int G_ROWB = 144;
constexpr int G_TILEB = 128 * G_ROWB;
template <bool SWAP = true>
__device__ __forceinline__ void gemm128(const u16* __restrict__ A, int lda, const u16* __restrict__ B, int ldb, int K,
                                        int m0, int n0, char* smem, f32x16 (&acc)[2][2]) {
  const int tid = threadIdx.x, lane = tid & 63, wid = tid >> 6, wm = wid >> 1, wn = wid & 1;
  const int fr = lane & 15, fq = lane >> 4;
  const int ldrow = tid >> 3, ldc = tid & 7;
#pragma unroll
  for (int i = 0; i < 2; ++i)
#pragma unroll
    for (int j = 0; j < 2; ++j)
#pragma unroll
      for (int r = 0; r < 16; ++r) acc[i][j][r] = 0.f;
  const int fr32 = lane & 31, fh = lane >> 5;
  uint4 ra[4], rb[4];
  const u16* ga = A + (size_t)(m0 + ldrow) * lda + ldc * 8;
  const u16* gb = B + (size_t)(n0 + ldrow) * ldb + ldc * 8;
  const int nk = K >> 6;
#pragma unroll
  for (int i = 0; i < 4; ++i) {
    ra[i] = *(const uint4*)(ga + (size_t)(32 * i) * lda);
    rb[i] = *(const uint4*)(gb + (size_t)(32 * i) * ldb);
  }
  {
    char* sa = smem + ldrow * G_ROWB + ldc * 16;
#pragma unroll
    for (int i = 0; i < 4; ++i) {
      *(uint4*)(sa + 32 * i * G_ROWB) = ra[i];
      *(uint4*)(sa + G_TILEB + 32 * i * G_ROWB) = rb[i];
    }
  }
  __syncthreads();
  for (int kt = 0; kt < nk; ++kt) {
    const bool more = (kt + 1 < nk);
    if (more) {
      const int k0 = (kt + 1) << 6;
#pragma unroll
      for (int i = 0; i < 4; ++i) {
        ra[i] = *(const uint4*)(ga + (size_t)(32 * i) * lda + k0);
        rb[i] = *(const uint4*)(gb + (size_t)(32 * i) * ldb + k0);
      }
    }
    const char* cur = smem + (kt & 1) * 2 * G_TILEB;
    const char* sa = cur + (wm * 64 + fr32) * G_ROWB + fh * 16;
    const char* sb = cur + G_TILEB + (wn * 64 + fr32) * G_ROWB + fh * 16;
#pragma unroll
    for (int ks = 0; ks < 4; ++ks) {
      bf16x8 af[2], bfr[2];
#pragma unroll
      for (int i = 0; i < 2; ++i) {
        af[i] = *(const bf16x8*)(sa + i * 32 * G_ROWB + ks * 32);
        bfr[i] = *(const bf16x8*)(sb + i * 32 * G_ROWB + ks * 32);
      }
#pragma unroll
      for (int mi = 0; mi < 2; ++mi)
#pragma unroll
        for (int ni = 0; ni < 2; ++ni)
          acc[mi][ni] = SWAP ? __builtin_amdgcn_mfma_f32_32x32x16_bf16(bfr[ni], af[mi], acc[mi][ni], 0, 0, 0)
                             : __builtin_amdgcn_mfma_f32_32x32x16_bf16(af[mi], bfr[ni], acc[mi][ni], 0, 0, 0);
    }
    if (more) {
      char* nxt = smem + ((kt + 1) & 1) * 2 * G_TILEB + ldrow * G_ROWB + ldc * 16;
#pragma unroll
      for (int i = 0; i < 4; ++i) {
        *(uint4*)(nxt + 32 * i * G_ROWB) = ra[i];
        *(uint4*)(nxt + G_TILEB + 32 * i * G_ROWB) = rb[i];
      }
    }
    __syncthreads();
  }
}

__device__ __forceinline__ void gemm128d(const u16* __restrict__ A, int lda, const u16* __restrict__ B, int ldb, int K,
                                        int m0, int n0, char* smem, f32x16 (&acc)[2][2]) {
  const int tid = threadIdx.x, lane = tid & 63, wid = tid >> 6, wm = wid >> 1, wn = wid & 1;
  const int fr = lane & 15, fq = lane >> 4;
  const int ldrow = tid >> 3, ldc = tid & 7;
#pragma unroll
  for (int i = 0; i < 2; ++i)
#pragma unroll
    for (int j = 0; j < 2; ++j)
#pragma unroll
      for (int r = 0; r < 16; ++r) acc[i][j][r] = 0.f;
  const int fr32 = lane & 31, fh = lane >> 5;
  uint4 ra0_0, ra0_1, ra0_2, ra0_3, rb0_0, rb0_1, rb0_2, rb0_3;
  uint4 ra1_0, ra1_1, ra1_2, ra1_3, rb1_0, rb1_1, rb1_2, rb1_3;
  const u16* ga = A + (size_t)(m0 + ldrow) * lda + ldc * 8;
  const u16* gb = B + (size_t)(n0 + ldrow) * ldb + ldc * 8;
  const int nk = K >> 6;
  char* const sw = smem + ldrow * G_ROWB + ldc * 16;
#define G_LOAD1(RA, RB, I, k0)                                          \
  RA##_##I = *(const uint4*)(ga + (size_t)(32 * I) * lda + k0);         \
  RB##_##I = *(const uint4*)(gb + (size_t)(32 * I) * ldb + k0);
#define G_LOAD(RA, RB, KT)                                              \
  {                                                                     \
    const int k0 = (KT) << 6;                                           \
    G_LOAD1(RA, RB, 0, k0) G_LOAD1(RA, RB, 1, k0) G_LOAD1(RA, RB, 2, k0) G_LOAD1(RA, RB, 3, k0) \
  }
#define G_STORE1(RA, RB, I)                                             \
  *(uint4*)(d + 32 * I * G_ROWB) = RA##_##I;                            \
  *(uint4*)(d + G_TILEB + 32 * I * G_ROWB) = RB##_##I;
#define G_STORE(RA, RB, BUF)                                            \
  {                                                                     \
    char* d = sw + (BUF) * 2 * G_TILEB;                                 \
    G_STORE1(RA, RB, 0) G_STORE1(RA, RB, 1) G_STORE1(RA, RB, 2) G_STORE1(RA, RB, 3) \
  }
#define G_COMPUTE(BUF)                                                                          \
  {                                                                                             \
    const char* cur = smem + (BUF) * 2 * G_TILEB;                                               \
    const char* sa = cur + (wm * 64 + fr32) * G_ROWB + fh * 16;                                 \
    const char* sb = cur + G_TILEB + (wn * 64 + fr32) * G_ROWB + fh * 16;                       \
    _Pragma("unroll") for (int ks = 0; ks < 4; ++ks) {                                          \
      bf16x8 af[2], bfr[2];                                                                     \
      _Pragma("unroll") for (int i = 0; i < 2; ++i) {                                           \
        af[i] = *(const bf16x8*)(sa + i * 32 * G_ROWB + ks * 32);                               \
        bfr[i] = *(const bf16x8*)(sb + i * 32 * G_ROWB + ks * 32);                              \
      }                                                                                         \
      _Pragma("unroll") for (int mi = 0; mi < 2; ++mi)                                          \
      _Pragma("unroll") for (int ni = 0; ni < 2; ++ni)                                          \
        acc[mi][ni] = __builtin_amdgcn_mfma_f32_32x32x16_bf16(bfr[ni], af[mi], acc[mi][ni], 0, 0, 0); \
    }                                                                                           \
  }
  G_LOAD(ra0, rb0, 0)
  G_STORE(ra0, rb0, 0)
  G_LOAD(ra0, rb0, 1)
  if (nk > 2) G_LOAD(ra1, rb1, 2)
  __syncthreads();
  for (int kt = 0; kt < nk; kt += 2) {
    G_COMPUTE(0)
    G_STORE(ra0, rb0, 1)
    if (kt + 3 < nk) G_LOAD(ra0, rb0, kt + 3)
    __syncthreads();
    G_COMPUTE(1)
    if (kt + 2 < nk) {
      G_STORE(ra1, rb1, 0)
      if (kt + 4 < nk) G_LOAD(ra1, rb1, kt + 4)
    }
    __syncthreads();
  }
#undef G_LOAD
#undef G_LOAD1
#undef G_STORE
#undef G_STORE1
#undef G_COMPUTE
}

#define ACC_FOREACH(BODY)                                                            \
  {                                                                                  \
    const int _lane = threadIdx.x & 63, _wid = threadIdx.x >> 6;                     \
    const int _wm = _wid >> 1, _wn = _wid & 1, _fr = _lane & 15, _fq = _lane >> 4;   \
    _Pragma("unroll") for (int mi = 0; mi < 4; ++mi)                                 \
    _Pragma("unroll") for (int ni = 0; ni < 4; ++ni)                                 \
    _Pragma("unroll") for (int j = 0; j < 4; ++j) {                                  \
      const int lrow = _wm * 64 + mi * 16 + _fq * 4 + j;                             \
      const int lcol = _wn * 64 + ni * 16 + _fr;                                     \
      const float v = acc[mi][ni][j];                                                \
      BODY                                                                           \
    }                                                                                \
  }

template <class F>
__device__ __forceinline__ void epi_staged(f32x16 (&acc)[2][2], char* smem, F f) {
  float* st = (float*)smem;
  {
    const int lane = threadIdx.x & 63, wid = threadIdx.x >> 6, wm = wid >> 1, wn = wid & 1, fr32 = lane & 31, fh = lane >> 5;
#pragma unroll
    for (int mi = 0; mi < 2; ++mi)
#pragma unroll
      for (int ni = 0; ni < 2; ++ni)
#pragma unroll
        for (int g = 0; g < 4; ++g)
          *(f32x4*)(st + (wm * 64 + mi * 32 + fr32) * 132 + wn * 64 + ni * 32 + g * 8 + fh * 4) =
              f32x4{acc[mi][ni][g * 4 + 0], acc[mi][ni][g * 4 + 1], acc[mi][ni][g * 4 + 2], acc[mi][ni][g * 4 + 3]};
  }
  __syncthreads();
#pragma unroll 4
  for (int i = threadIdx.x; i < 128 * 32; i += NTHREADS) {
    const int row = i >> 5, c4 = (i & 31) << 2;
    const float4 v = *(const float4*)(st + row * 132 + c4);
    f(row, c4, v);
  }
  __syncthreads();
}

constexpr int H_ROWB = 80;
constexpr int H_A = 256 * H_ROWB, H_B = 128 * H_ROWB, H_STAGE = H_A + H_B;
__device__ __forceinline__ void gemm256(const u16* __restrict__ A, int lda, const u16* __restrict__ B, int ldb, int K,
                                        int m0, int n0, char* smem, f32x16 (&acc)[4][2]) {
  const int tid = threadIdx.x, lane = tid & 63, wid = tid >> 6, wm = wid >> 1, wn = wid & 1;
  const int fr32 = lane & 31, fh = lane >> 5;
#pragma unroll
  for (int i = 0; i < 4; ++i)
#pragma unroll
    for (int j = 0; j < 2; ++j)
#pragma unroll
      for (int r = 0; r < 16; ++r) acc[i][j][r] = 0.f;
  const int ldrow = tid >> 2, ldc = tid & 3;
  const u16* ga = A + (size_t)(m0 + ldrow) * lda + ldc * 8;
  const u16* gb = B + (size_t)(n0 + ldrow) * ldb + ldc * 8;
  uint4 a0, a1, a2, a3, b0, b1;
  uint4 c0, c1, c2, c3, d0, d1;
  const int nk = K >> 5;
  char* const swa = smem + ldrow * H_ROWB + ldc * 16;
  char* const swb = smem + H_A + ldrow * H_ROWB + ldc * 16;
#define H_LOAD(k0, A0, A1, A2, A3, B0, B1)                      \
  A0 = *(const uint4*)(ga + (k0));                              \
  A1 = *(const uint4*)(ga + (size_t)64 * lda + (k0));           \
  A2 = *(const uint4*)(ga + (size_t)128 * lda + (k0));          \
  A3 = *(const uint4*)(ga + (size_t)192 * lda + (k0));          \
  B0 = *(const uint4*)(gb + (k0));                              \
  B1 = *(const uint4*)(gb + (size_t)64 * ldb + (k0));
#define H_STORE(BUF, A0, A1, A2, A3, B0, B1)                    \
  *(uint4*)(swa + (BUF) * H_STAGE) = A0;                        \
  *(uint4*)(swa + (BUF) * H_STAGE + 64 * H_ROWB) = A1;          \
  *(uint4*)(swa + (BUF) * H_STAGE + 128 * H_ROWB) = A2;         \
  *(uint4*)(swa + (BUF) * H_STAGE + 192 * H_ROWB) = A3;         \
  *(uint4*)(swb + (BUF) * H_STAGE) = B0;                        \
  *(uint4*)(swb + (BUF) * H_STAGE + 64 * H_ROWB) = B1;
#define H_COMPUTE(BUF)                                                                          \
  {                                                                                             \
    const char* cur = smem + (BUF) * H_STAGE;                                                   \
    const char* sa = cur + (wm * 128 + fr32) * H_ROWB + fh * 16;                                \
    const char* sb = cur + H_A + (wn * 64 + fr32) * H_ROWB + fh * 16;                           \
    _Pragma("unroll") for (int ks = 0; ks < 2; ++ks) {                                          \
      bf16x8 af[4], bfr[2];                                                                     \
      _Pragma("unroll") for (int i = 0; i < 4; ++i) af[i] = *(const bf16x8*)(sa + i * 32 * H_ROWB + ks * 32); \
      _Pragma("unroll") for (int i = 0; i < 2; ++i) bfr[i] = *(const bf16x8*)(sb + i * 32 * H_ROWB + ks * 32); \
      _Pragma("unroll") for (int mi = 0; mi < 4; ++mi)                                          \
      _Pragma("unroll") for (int ni = 0; ni < 2; ++ni)                                          \
        acc[mi][ni] = __builtin_amdgcn_mfma_f32_32x32x16_bf16(bfr[ni], af[mi], acc[mi][ni], 0, 0, 0); \
    }                                                                                           \
  }
  H_LOAD(0, a0, a1, a2, a3, b0, b1)
  H_STORE(0, a0, a1, a2, a3, b0, b1)
  H_LOAD(32, a0, a1, a2, a3, b0, b1)
  if (nk > 2) { H_LOAD(64, c0, c1, c2, c3, d0, d1) }
  __syncthreads();
  for (int kt = 0; kt < nk; kt += 2) {
    H_COMPUTE(0)
    H_STORE(1, a0, a1, a2, a3, b0, b1)
    if (kt + 3 < nk) { const int k0 = (kt + 3) << 5; H_LOAD(k0, a0, a1, a2, a3, b0, b1) }
    __syncthreads();
    H_COMPUTE(1)
    if (kt + 2 < nk) {
      H_STORE(0, c0, c1, c2, c3, d0, d1)
      if (kt + 4 < nk) { const int k0 = (kt + 4) << 5; H_LOAD(k0, c0, c1, c2, c3, d0, d1) }
    }
    __syncthreads();
  }
#undef H_COMPUTE
#undef H_LOAD
#undef H_STORE
}
template <class F>
__device__ __forceinline__ void epi_staged256(f32x16 (&acc)[4][2], char* smem, F f) {
  float* st = (float*)smem;
  const int lane = threadIdx.x & 63, wid = threadIdx.x >> 6, wm = wid >> 1, wn = wid & 1, fr32 = lane & 31, fh = lane >> 5;
#pragma unroll
  for (int half = 0; half < 2; ++half) {
    if (wm == half) {
#pragma unroll
      for (int mi = 0; mi < 4; ++mi)
#pragma unroll
        for (int ni = 0; ni < 2; ++ni)
#pragma unroll
          for (int g = 0; g < 4; ++g)
            *(f32x4*)(st + (mi * 32 + fr32) * 132 + wn * 64 + ni * 32 + g * 8 + fh * 4) =
                f32x4{acc[mi][ni][g * 4 + 0], acc[mi][ni][g * 4 + 1], acc[mi][ni][g * 4 + 2], acc[mi][ni][g * 4 + 3]};
    }
    __syncthreads();
#pragma unroll 4
    for (int i = threadIdx.x; i < 128 * 32; i += NTHREADS) {
      const int row = i >> 5, c4 = (i & 31) << 2;
      const float4 v = *(const float4*)(st + row * 132 + c4);
      f(half * 128 + row, c4, v);
    }
    __syncthreads();
  }
}

__device__ __forceinline__ void transpose_tile(const float* __restrict__ W, int N, u16* __restrict__ Wt, int K, int k0, int n0, float* lds) {
  const int tid = threadIdx.x;
  __syncthreads();
#pragma unroll
  for (int i = 0; i < 16; ++i) {
    int k = i * 4 + (tid >> 6), n = tid & 63;
    lds[k * 65 + n] = W[(size_t)(k0 + k) * N + n0 + n];
  }
  __syncthreads();
#pragma unroll
  for (int i = 0; i < 16; ++i) {
    int n = i * 4 + (tid >> 6), k = tid & 63;
    Wt[(size_t)(n0 + n) * K + k0 + k] = f2bf(lds[k * 65 + n]);
  }
}

__device__ __forceinline__ void phase_prep(const Params& p, char* smem) {
  const int tid = threadIdx.x;
  float* lds = (float*)smem;
  u16* WIN = (u16*)(p.ws + OFF_WIN);
  u16* WOUT = (u16*)(p.ws + OFF_WOUT);
  u16* WLORA = (u16*)(p.ws + OFF_WLORA);
  u16* KEYS = (u16*)(p.ws + OFF_KEYS);
  float* MOD = (float*)(p.ws + OFF_MOD);
  constexpr int N_MOD = 96, N_T1 = 44 * 16, N_T2 = 16 * 16, N_T3 = 0;
  constexpr int N_TASK = N_MOD + N_T1 + N_T2 + N_T3;
  for (int task = blockIdx.x; task < N_TASK; task += gridDim.x) {
    if (task < N_MOD) {
      __syncthreads();
      for (int i = tid; i < 8 * 1024; i += NTHREADS) lds[i] = siluf_(p.c[i]);
      __syncthreads();
      const int lane = tid & 63, w = tid >> 6;
      const int col = task * 64 + lane;
      float a[8];
#pragma unroll
      for (int b = 0; b < 8; ++b) a[b] = 0.f;
      const float* wp = p.ada_w + (size_t)(w * 256) * 6144 + col;
#pragma unroll 8
      for (int k = 0; k < 256; ++k) {
        float wv = wp[(size_t)k * 6144];
#pragma unroll
        for (int b = 0; b < 8; ++b) a[b] += lds[b * 1024 + w * 256 + k] * wv;
      }
      __syncthreads();
#pragma unroll
      for (int b = 0; b < 8; ++b) lds[8192 + (w * 8 + b) * 64 + lane] = a[b];
      __syncthreads();
      for (int i = tid; i < 512; i += NTHREADS) {
        int b = i >> 6, l = i & 63;
        float s = lds[8192 + (0 * 8 + b) * 64 + l] + lds[8192 + (1 * 8 + b) * 64 + l] + lds[8192 + (2 * 8 + b) * 64 + l] +
                  lds[8192 + (3 * 8 + b) * 64 + l];
        MOD[b * 6144 + task * 64 + l] = s + p.ada_b[task * 64 + l];
      }
    } else {
      int t = task - N_MOD;
      if (t < N_T1) {
        transpose_tile(p.w_in, NPROJ, WIN, D, (t & 15) * 64, (t >> 4) * 64, lds);
      } else if (t < N_T1 + N_T2) {
        t -= N_T1;
        transpose_tile(p.w_out, D, WOUT, D, (t & 15) * 64, (t >> 4) * 64, lds);
      }
    }
  }
  const size_t gtid = (size_t)blockIdx.x * NTHREADS + tid, gn = (size_t)gridDim.x * NTHREADS;
  for (size_t i = gtid; i < (size_t)1536 * 256; i += gn) {
    int n = (int)(i >> 8), k = (int)(i & 255);
    float v = 0.f;
    if (n < 512) { if (k < 64) v = p.w2[k * 512 + n]; }
    else if (n < 1024) { if (k >= 64 && k < 128) v = p.a2[(k - 64) * 512 + (n - 512)]; }
    else { if (k >= 128) v = p.g2[(k - 128) * 512 + (n - 1024)]; }
    WLORA[i] = f2bf(v);
  }
  for (size_t i = gtid; i < (size_t)16 * 128 * 128; i += gn) KEYS[i] = f2bf(p.sub_keys[i]);
  {
    uint2* WQB = (uint2*)(p.ws + OFF_REGF);
    const float4* wq4 = (const float4*)p.w_q;
    for (size_t i = gtid; i < (size_t)1024 * 2048 / 4; i += gn) {
      const float4 v = wq4[i];
      WQB[i] = make_uint2(pack2(v.x, v.y), pack2(v.z, v.w));
    }
  }
}

__device__ __forceinline__ void phase_peer_fold(const Params& p, char* smem) {
  const u16* KEYS = (const u16*)(p.ws + OFF_KEYS);
  const u16* WQB = (const u16*)(p.ws + OFF_REGF);
  u16* MT = (u16*)(p.ws + OFF_WQ);
  for (int tile = blockIdx.x; tile < 16 * 8; tile += gridDim.x) {
    const int hp = tile >> 3, dt = tile & 7;
    f32x16 acc[2][2];
    gemm128(KEYS + (size_t)hp * 128 * 128, 128, WQB + hp * 128, 2048, 128, 0, dt * 128, smem, acc);
    epi_staged(acc, smem, [&](int row, int c4, float4 v) {
      *(uint2*)(MT + (size_t)(hp * 128 + row) * D + dt * 128 + c4) = make_uint2(pack2(v.x, v.y), pack2(v.z, v.w));
    });
  }
}

__device__ __forceinline__ void phase_normmod(const float* __restrict__ X, const float* __restrict__ g, const float* __restrict__ MOD,
                              int sh_off, int sc_off, u16* __restrict__ U) {
  const int lane = threadIdx.x & 63;
  const int gw = blockIdx.x * 4 + (threadIdx.x >> 6), nw = gridDim.x * 4;
  for (int t = gw; t < T; t += nw) {
    const int b = t / SEQ;
    const float4* xr = (const float4*)(X + (size_t)t * D);
    float4 v[4];
    float ss = 0.f;
#pragma unroll
    for (int i = 0; i < 4; ++i) {
      v[i] = xr[i * 64 + lane];
      ss += v[i].x * v[i].x + v[i].y * v[i].y + v[i].z * v[i].z + v[i].w * v[i].w;
    }
    ss = wave_sum(ss);
    const float rstd = __builtin_amdgcn_rsqf(ss * (1.0f / D) + 1e-6f);
    const float4* gp = (const float4*)g;
    const float4* shp = (const float4*)(MOD + b * 6144 + sh_off);
    const float4* scp = (const float4*)(MOD + b * 6144 + sc_off);
    uint2* up = (uint2*)(U + (size_t)t * D);
#pragma unroll
    for (int i = 0; i < 4; ++i) {
      float4 gg = gp[i * 64 + lane], sh = shp[i * 64 + lane], sc = scp[i * 64 + lane];
      float o0 = v[i].x * rstd * gg.x * (1.f + sc.x) + sh.x;
      float o1 = v[i].y * rstd * gg.y * (1.f + sc.y) + sh.y;
      float o2 = v[i].z * rstd * gg.z * (1.f + sc.z) + sh.z;
      float o3 = v[i].w * rstd * gg.w * (1.f + sc.w) + sh.w;
      up[i * 64 + lane] = make_uint2(pack2(o0, o1), pack2(o2, o3));
    }
  }
}

__device__ __forceinline__ void phase_gemm_in(const Params& p, char* smem) {
  const u16* U1 = (const u16*)(p.ws + OFF_REGB);
  const u16* WIN = (const u16*)(p.ws + OFF_WIN);
  u16* P = (u16*)(p.ws + OFF_REGC);
  constexpr int NT = NPROJ / 128, MT = T / 256;
  for (int tile = blockIdx.x; tile < NT * MT; tile += gridDim.x) {
    const int mt = tile / NT, nt = tile % NT;
    f32x16 acc[4][2];
    gemm256(U1, D, WIN, D, D, mt * 256, nt * 128, smem, acc);
    epi_staged256(acc, smem, [&](int row, int c4, float4 v) {
      u16* dst = (nt < 8) ? (P + (size_t)(mt * 256 + row) * 1024 + nt * 128 + c4)
                          : (P + (size_t)32 * MB + (size_t)(mt * 256 + row) * 1792 + (nt - 8) * 128 + c4);
      *(uint2*)dst = make_uint2(pack2(v.x, v.y), pack2(v.z, v.w));
    });
  }
}

__device__ __forceinline__ void phase_act(const Params& p) {
  const u16* P = (const u16*)(p.ws + OFF_PR);
  u16* ACT = (u16*)(p.ws + OFF_REGF + 128 * MB);
  const size_t gtid = (size_t)blockIdx.x * NTHREADS + threadIdx.x, gn = (size_t)gridDim.x * NTHREADS;
  for (size_t i = gtid; i < (size_t)T * 64; i += gn) {
    const int t = (int)(i >> 6), c = (int)(i & 63) * 4;
    const u16* pr = P + (size_t)t * 1792 + 1536 + c;
    uint2 cur = *(const uint2*)pr;
    uint2 prv = make_uint2(0u, 0u);
    if ((t % SEQ) != 0) prv = *(const uint2*)(pr - 1792);
    float4 m = *(const float4*)(p.mu + 1536 + c);
    float x0 = bflo(cur.x), x1 = bfhi(cur.x), x2 = bflo(cur.y), x3 = bfhi(cur.y);
    x0 += m.x * (bflo(prv.x) - x0);
    x1 += m.y * (bfhi(prv.x) - x1);
    x2 += m.z * (bflo(prv.y) - x2);
    x3 += m.w * (bfhi(prv.y) - x3);
    if (c < 64) { x0 = tanhf_(x0); x1 = tanhf_(x1); x2 = tanhf_(x2); x3 = tanhf_(x3); }
    else if (c >= 128) { x0 = sigmoidf_(x0); x1 = sigmoidf_(x1); x2 = sigmoidf_(x2); x3 = sigmoidf_(x3); }
    *(uint2*)(ACT + (size_t)t * 256 + c) = make_uint2(pack2(x0, x1), pack2(x2, x3));
  }
}

__device__ __forceinline__ void conv_tile(const Params& p, int tile, char* smem) {
  const u16* P = (const u16*)(p.ws + OFF_PC);
  u16* MIXIN = (u16*)(p.ws + OFF_REGB);
  const int tid = threadIdx.x, lane = tid & 63, wid = tid >> 6;
  u32* ylds = (u32*)smem;
  float* olds = (float*)(smem + 62 * 1024);
  const int tok0 = tile * 32;
  const int s0 = tok0 % SEQ;
  __syncthreads();
  for (int r = 0; r < 62; ++r) {
    const int s = s0 - 30 + r;
    u32 val = 0u;
    if (s >= 0) {
      const u16* pr = P + (size_t)(tok0 - 30 + r) * 1024;
      u32 a = *(const u32*)(pr + 2 * tid);
      u32 bq = *(const u32*)(pr + 512 + 2 * tid);
      val = pack2(bflo(a) * sigmoidf_(bflo(bq)), bfhi(a) * sigmoidf_(bfhi(bq)));
    }
    ylds[r * 256 + tid] = val;
  }
  __syncthreads();
  float w0[31], w1[31];
#pragma unroll
  for (int j = 0; j < 31; ++j) {
    const float2 wv = *(const float2*)(p.conv_w + j * 512 + 2 * tid);
    w0[j] = wv.x; w1[j] = wv.y;
  }
  const float2 bias = *(const float2*)(p.conv_b + 2 * tid);
  for (int sub = 0; sub < 4; ++sub) {
    float a0[8], a1[8];
#pragma unroll
    for (int q = 0; q < 8; ++q) { a0[q] = bias.x; a1[q] = bias.y; }
#pragma unroll
    for (int rr = 0; rr < 38; ++rr) {
      const u32 yv = ylds[(sub * 8 + rr) * 256 + tid];
      const float y0 = bflo(yv), y1 = bfhi(yv);
#pragma unroll
      for (int q = 0; q < 8; ++q) {
        const int j = rr - q;
        if (j >= 0 && j < 31) { a0[q] += w0[j] * y0; a1[q] += w1[j] * y1; }
      }
    }
#pragma unroll
    for (int q = 0; q < 8; ++q) *(float2*)(olds + q * 512 + 2 * tid) = make_float2(a0[q], a1[q]);
    __syncthreads();
#pragma unroll
    for (int q2 = 0; q2 < 2; ++q2) {
      const int q = wid * 2 + q2;
      const float4 va = *(const float4*)(olds + q * 512 + lane * 8);
      const float4 vb = *(const float4*)(olds + q * 512 + lane * 8 + 4);
      float s = va.x + va.y + va.z + va.w + vb.x + vb.y + vb.z + vb.w;
      s = wave_sum(s);
      const float mean = s * (1.0f / 512.f);
      float d[8] = {va.x - mean, va.y - mean, va.z - mean, va.w - mean, vb.x - mean, vb.y - mean, vb.z - mean, vb.w - mean};
      float vs = 0.f;
#pragma unroll
      for (int e = 0; e < 8; ++e) vs += d[e] * d[e];
      vs = wave_sum(vs);
      const float rstd = __builtin_amdgcn_rsqf(vs * (1.0f / 512.f) + 1e-5f);
      const float4 lw0 = *(const float4*)(p.ln_w + lane * 8), lw1 = *(const float4*)(p.ln_w + lane * 8 + 4);
      const float4 lb0 = *(const float4*)(p.ln_b + lane * 8), lb1 = *(const float4*)(p.ln_b + lane * 8 + 4);
      const float lw[8] = {lw0.x, lw0.y, lw0.z, lw0.w, lw1.x, lw1.y, lw1.z, lw1.w};
      const float lb[8] = {lb0.x, lb0.y, lb0.z, lb0.w, lb1.x, lb1.y, lb1.z, lb1.w};
      float o[8];
#pragma unroll
      for (int e = 0; e < 8; ++e) o[e] = siluf_(d[e] * rstd * lw[e] + lb[e]);
      uint4 pk = make_uint4(pack2(o[0], o[1]), pack2(o[2], o[3]), pack2(o[4], o[5]), pack2(o[6], o[7]));
      *(uint4*)(MIXIN + (size_t)(tok0 + sub * 8 + q) * D + lane * 8) = pk;
    }
    __syncthreads();
  }
}

__device__ __forceinline__ void phase_lora_conv(const Params& p, char* smem) {
  const u16* ACT = (const u16*)(p.ws + OFF_REGF + 128 * MB);
  const u16* WLORA = (const u16*)(p.ws + OFF_WLORA);
  u16* LW = (u16*)(p.ws + OFF_REGF);
  u16* AA = (u16*)(p.ws + OFF_REGD);
  u16* GG = (u16*)(p.ws + OFF_REGD + 32 * MB);
  constexpr int NT = 12, MT = T / 128, NG = NT * MT, NC = T / 32;
  for (int task = blockIdx.x; task < NG; task += gridDim.x) {
    {
      const int mt = task / NT, nt = task % NT;
      f32x16 acc[2][2];
      const int k0 = (nt < 8) ? 0 : 128;
      gemm128d(ACT + k0, 256, WLORA + k0, 256, 128, mt * 128, nt * 128, smem, acc);
      if (nt < 4) {
        epi_staged(acc, smem, [&](int row, int c4, float4 v) {
          const int n = nt * 128 + c4;
          const float4 w0 = *(const float4*)(p.w0 + n);
          const float vv[4] = {v.x + w0.x, v.y + w0.y, v.z + w0.z, v.w + w0.w};
          float o[4];
#pragma unroll
          for (int e = 0; e < 4; ++e) {
            const float z = -vv[e];
            const float sp = fmaxf(z, 0.f) + __logf(1.0f + __expf(-fabsf(z)));
            o[e] = -__expf(-sp - 0.5f);
          }
          *(uint2*)(LW + (size_t)(mt * 128 + row) * 512 + n) = make_uint2(pack2(o[0], o[1]), pack2(o[2], o[3]));
        });
      } else if (nt < 8) {
        epi_staged(acc, smem, [&](int row, int c4, float4 v) {
          const int n = (nt - 4) * 128 + c4;
          const float4 a0 = *(const float4*)(p.a0 + n);
          *(uint2*)(AA + (size_t)(mt * 128 + row) * 512 + n) =
              make_uint2(pack2(sigmoidf_(a0.x + v.x), sigmoidf_(a0.y + v.y)), pack2(sigmoidf_(a0.z + v.z), sigmoidf_(a0.w + v.w)));
        });
      } else {
        epi_staged(acc, smem, [&](int row, int c4, float4 v) {
          const int n = (nt - 8) * 128 + c4;
          *(uint2*)(GG + (size_t)(mt * 128 + row) * 512 + n) = make_uint2(pack2(v.x, v.y), pack2(v.z, v.w));
        });
      }
    }
  }
}

__device__ __forceinline__ void phase_scanprep(const Params& p) {
  const u16* P = (const u16*)(p.ws + OFF_PR);
  const u16* AA = (const u16*)(p.ws + OFF_REGD);
  u16* R = (u16*)(p.ws + OFF_REGF + 32 * MB);
  u16* KM = (u16*)(p.ws + OFF_REGF + 64 * MB);
  u16* V = (u16*)(p.ws + OFF_REGF + 96 * MB);
  u16* KKN = (u16*)(p.ws + OFF_REGF + 128 * MB);
  float* BONUS = (float*)(p.ws + OFF_BONUS);
  const int tid = threadIdx.x;
  const int c = (tid & 127) * 4;
  const float4 mur = *(const float4*)(p.mu + c), muk = *(const float4*)(p.mu + 512 + c), muv = *(const float4*)(p.mu + 1024 + c);
  const float4 kk_ = *(const float4*)(p.k_k + c), ka_ = *(const float4*)(p.k_a + c), rk_ = *(const float4*)(p.r_k + c);
  for (int tp = blockIdx.x; tp < T / 2; tp += gridDim.x) {
    const int t = tp * 2 + (tid >> 7);
    const bool first = (t % SEQ) == 0;
    const u16* pr = P + (size_t)t * 1792 + c;
    float r[4], k[4], v[4];
    {
      uint2 cu = *(const uint2*)pr, pv = first ? make_uint2(0u, 0u) : *(const uint2*)(pr - 1792);
      r[0] = bflo(cu.x); r[1] = bfhi(cu.x); r[2] = bflo(cu.y); r[3] = bfhi(cu.y);
      r[0] += mur.x * (bflo(pv.x) - r[0]); r[1] += mur.y * (bfhi(pv.x) - r[1]);
      r[2] += mur.z * (bflo(pv.y) - r[2]); r[3] += mur.w * (bfhi(pv.y) - r[3]);
    }
    {
      uint2 cu = *(const uint2*)(pr + 512), pv = first ? make_uint2(0u, 0u) : *(const uint2*)(pr + 512 - 1792);
      k[0] = bflo(cu.x); k[1] = bfhi(cu.x); k[2] = bflo(cu.y); k[3] = bfhi(cu.y);
      k[0] += muk.x * (bflo(pv.x) - k[0]); k[1] += muk.y * (bfhi(pv.x) - k[1]);
      k[2] += muk.z * (bflo(pv.y) - k[2]); k[3] += muk.w * (bfhi(pv.y) - k[3]);
    }
    {
      uint2 cu = *(const uint2*)(pr + 1024), pv = first ? make_uint2(0u, 0u) : *(const uint2*)(pr + 1024 - 1792);
      v[0] = bflo(cu.x); v[1] = bfhi(cu.x); v[2] = bflo(cu.y); v[3] = bfhi(cu.y);
      v[0] += muv.x * (bflo(pv.x) - v[0]); v[1] += muv.y * (bfhi(pv.x) - v[1]);
      v[2] += muv.z * (bflo(pv.y) - v[2]); v[3] += muv.w * (bfhi(pv.y) - v[3]);
    }
    const uint2 au = *(const uint2*)(AA + (size_t)t * 512 + c);
    const float a[4] = {bflo(au.x), bfhi(au.x), bflo(au.y), bfhi(au.y)};
    const float kkc[4] = {kk_.x, kk_.y, kk_.z, kk_.w}, kac[4] = {ka_.x, ka_.y, ka_.z, ka_.w}, rkc[4] = {rk_.x, rk_.y, rk_.z, rk_.w};
    float kk[4], km[4];
    float n2 = 0.f, bs = 0.f;
#pragma unroll
    for (int e = 0; e < 4; ++e) {
      kk[e] = k[e] * kkc[e];
      km[e] = k[e] * (1.f + (a[e] - 1.f) * kac[e]);
      n2 += kk[e] * kk[e];
      bs += r[e] * km[e] * rkc[e];
    }
    n2 = row16_sum(n2);
    bs = row16_sum(bs);
    const float inv = fminf(__builtin_amdgcn_rsqf(n2), 1e12f);
    const size_t o = (size_t)t * 512 + c;
    *(uint2*)(R + o) = make_uint2(pack2(r[0], r[1]), pack2(r[2], r[3]));
    *(uint2*)(KM + o) = make_uint2(pack2(km[0], km[1]), pack2(km[2], km[3]));
    *(uint2*)(V + o) = make_uint2(pack2(v[0], v[1]), pack2(v[2], v[3]));
    *(uint2*)(KKN + o) = make_uint2(pack2(kk[0] * inv, kk[1] * inv), pack2(kk[2] * inv, kk[3] * inv));
    if ((tid & 15) == 0) BONUS[(size_t)t * 8 + (c >> 6)] = bs;
  }
}

constexpr size_t OFF_EU8 = OFF_REGC + 128 * MB;
constexpr size_t OFF_EV8 = OFF_REGC + 144 * MB;
constexpr int CVT_CHUNKS = 256;
__device__ __forceinline__ void cvt_chunk(const Params& p, int chunk) {
  u32* EU = (u32*)(p.ws + OFF_EU8);
  u32* EV = (u32*)(p.ws + OFF_EV8);
  const float4* su = (const float4*)p.peer_u;
  const float4* sv = (const float4*)p.peer_v;
  const size_t base = (size_t)chunk * 16384;
#pragma unroll 4
  for (int q = 0; q < 64; ++q) {
    const size_t i = base + q * 256 + threadIdx.x;
    const float4 a = su[i], b = sv[i];
    int va = 0, vb = 0;
    va = __builtin_amdgcn_cvt_pk_fp8_f32(a.x * 512.f, a.y * 512.f, va, false);
    va = __builtin_amdgcn_cvt_pk_fp8_f32(a.z * 512.f, a.w * 512.f, va, true);
    vb = __builtin_amdgcn_cvt_pk_fp8_f32(b.x * 128.f, b.y * 128.f, vb, false);
    vb = __builtin_amdgcn_cvt_pk_fp8_f32(b.z * 128.f, b.w * 128.f, vb, true);
    EU[i] = (u32)va;
    EV[i] = (u32)vb;
  }
}

__device__ __forceinline__ void mix_unit(const Params& p, int u, char* smem) {
  for (int ci = 0; ci < 4; ++ci) conv_tile(p, u * 4 + ci, smem);
}

template <int OFF>
__device__ __forceinline__ f32x4 lds_ld4(unsigned addr) {
  f32x4 r;
  asm volatile("ds_read_b128 %0, %1 offset:%2" : "=v"(r) : "v"(addr), "n"(OFF));
  return r;
}
template <int OFF>
__device__ __forceinline__ float lds_ld1(unsigned addr) {
  float r;
  asm volatile("ds_read_b32 %0, %1 offset:%2" : "=v"(r) : "v"(addr), "n"(OFF));
  return r;
}
constexpr int SC_BUF = 27648;
template <int OFF>
__device__ __forceinline__ v2f lds_ld2(unsigned addr) {
  v2f r;
  asm volatile("ds_read_b64 %0, %1 offset:%2" : "=v"(r) : "v"(addr), "n"(OFF));
  return r;
}
__device__ __forceinline__ void phase_scan(const Params& p, char* smem, int rep) {
  const u16* LW = (const u16*)(p.ws + OFF_REGF);
  const u16* R = (const u16*)(p.ws + OFF_REGF + 32 * MB);
  const u16* KM = (const u16*)(p.ws + OFF_REGF + 64 * MB);
  const u16* V = (const u16*)(p.ws + OFF_REGF + 96 * MB);
  const u16* KKN = (const u16*)(p.ws + OFF_REGF + 128 * MB);
  const u16* AA = (const u16*)(p.ws + OFF_REGD);
  float* Y = (float*)(p.ws + OFF_Y);
  const int tid = threadIdx.x, lane = tid & 63, w = tid >> 6;
  const int jl = lane & 15;
  const int ss = tid >> 4, sg = tid & 15;
  unsigned* claim = (unsigned*)(p.ws + OFF_BAR) + XCD_BAR_WORDS + rep * (2048 + 64);
  unsigned* qctr = claim + 2048;
  int* sflag = (int*)(smem + 2 * SC_BUF);
  float* ypw = (float*)(smem + 56320) + w * 1024;
  const unsigned sbase = (unsigned)(size_t)(LAS char*)smem;
  if (tid == 0) {
    const unsigned key = (xb_xcc_id() & 7u) * 256u + (((unsigned)__builtin_amdgcn_s_getreg(63492) >> 8) & 0xffu);
    sflag[0] = (atomicAdd(&claim[key], 1u) == 0u) ? 1 : 0;
  }
  __syncthreads();
  const bool scan_role = sflag[0] != 0;
  for (;;) {
    if (!scan_role) break;
    __syncthreads();
    if (tid == 0) sflag[1] = (int)atomicAdd(&qctr[0], 1u);
    __syncthreads();
    const int task = sflag[1];
    if (task >= 256) break;
    const int bh = task >> 2, rg = task & 3, b = bh >> 3, h = bh & 7;
    const int il = rg * 16 + w * 4 + (lane >> 4);
    v2f Sa = v2f{0.f, 0.f}, Sb = v2f{0.f, 0.f};
    const size_t base = (size_t)b * SEQ * 512 + h * 64 + sg * 4;
    uint2 gA_lw, gA_r, gA_km, gA_v, gA_kkn, gA_a;
    uint2 gB_lw, gB_r, gB_km, gB_v, gB_kkn, gB_a;
#define SC_GLOAD(X, t0)                                      \
  {                                                          \
    const size_t o = base + (size_t)((t0) + ss) * 512;       \
    X##_lw = *(const uint2*)(LW + o); X##_r = *(const uint2*)(R + o);   \
    X##_km = *(const uint2*)(KM + o); X##_v = *(const uint2*)(V + o);   \
    X##_kkn = *(const uint2*)(KKN + o); X##_a = *(const uint2*)(AA + o); \
  }
#define SC_STORE(X, bi)                                                                                \
  {                                                                                                    \
    float* d = (float*)(smem + (bi) * SC_BUF) + ss * 64 + sg * 4;                                      \
    const float4 kq = make_float4(bflo(X##_kkn.x), bfhi(X##_kkn.x), bflo(X##_kkn.y), bfhi(X##_kkn.y)); \
    *(float4*)(d) = make_float4(__expf(bflo(X##_lw.x)), __expf(bfhi(X##_lw.x)), __expf(bflo(X##_lw.y)), __expf(bfhi(X##_lw.y))); \
    *(float4*)(d + 1024) = kq;                                                                         \
    *(float4*)(d + 2048) = make_float4(kq.x * bflo(X##_a.x), kq.y * bfhi(X##_a.x), kq.z * bflo(X##_a.y), kq.w * bfhi(X##_a.y)); \
    *(float4*)(d + 3072) = make_float4(bflo(X##_km.x), bfhi(X##_km.x), bflo(X##_km.y), bfhi(X##_km.y)); \
    *(float4*)(d + 4096) = make_float4(bflo(X##_r.x), bfhi(X##_r.x), bflo(X##_r.y), bfhi(X##_r.y));    \
    float* vt = (float*)(smem + (bi) * SC_BUF) + 5120 + (sg * 4) * 16 + ss;     \
    vt[0] = bflo(X##_v.x); vt[16] = bfhi(X##_v.x); vt[32] = bflo(X##_v.y); vt[48] = bfhi(X##_v.y);     \
  }
#define SC_ISSUE(sl, S)                                     \
  {                                                         \
    dec_[sl] = lds_ld4<(S) * 256>(a0);                      \
    kkn_[sl] = lds_ld4<4096 + (S) * 256>(a0);               \
    km_[sl] = lds_ld4<12288 + (S) * 256>(a0);               \
    if (((S) & 3) == 0) vq_[((S) >> 2) & 1] = lds_ld4<20480 + (S) * 4>(a1); \
    nb_[sl] = lds_ld4<8192 + (S) * 256>(a0);                \
    rr_[sl] = lds_ld4<16384 + (S) * 256>(a0);               \
  }
#define SC_WAIT(N, sl)                                                                          \
  asm volatile("s_waitcnt lgkmcnt(" #N ")"                                                      \
               : "+v"(dec_[sl]), "+v"(kkn_[sl]), "+v"(nb_[sl]), "+v"(km_[sl]), "+v"(rr_[sl]), "+v"(vq_[0]), "+v"(vq_[1]));
#define LO2(q) (v2f{(q).x, (q).y})
#define HI2(q) (v2f{(q).z, (q).w})
#define SC_STEP(S, N)                                                                       \
  {                                                                                         \
    if ((S) + 2 < 16) SC_ISSUE(((S) + 2) % 3, (S) + 2)                                      \
    SC_WAIT(N, (S) % 3)                                                                     \
    const f32x4 dec = dec_[(S) % 3], kkn = kkn_[(S) % 3], nb = nb_[(S) % 3], km = km_[(S) % 3], rr = rr_[(S) % 3]; \
    const float vv = vq_[((S) >> 2) & 1][(S) & 3];                                          \
    const v2f v2 = v2f{vv, vv};                                                             \
    const v2f Ta = Sa * LO2(dec) + v2 * LO2(km);                                            \
    const v2f Tb = Sb * HI2(dec) + v2 * HI2(km);                                            \
    const v2f dv = Sa * LO2(kkn) + Sb * HI2(kkn);                                           \
    float dot = dv.x + dv.y;                                                                \
    if ((S) > 0) {     \
      dot += DPP_ROR(dot, 8); ypend += DPP_ROR(ypend, 8);                                   \
      dot += DPP_ROR(dot, 4); ypend += DPP_ROR(ypend, 4);                                   \
      dot += DPP_ROR(dot, 2); ypend += DPP_ROR(ypend, 2);                                   \
      dot += DPP_ROR(dot, 1); ypend += DPP_ROR(ypend, 1);                                   \
      ykeep = (jl == (S) - 1) ? ypend : ykeep;                                              \
    } else {                                                                                \
      dot = row16_sum(dot);                                                                 \
    }                                                                                       \
    const v2f d2 = v2f{dot, dot};                                                           \
    Sa = Ta - d2 * LO2(nb);                                                                 \
    Sb = Tb - d2 * HI2(nb);                                                                 \
    const v2f yv = Sa * LO2(rr) + Sb * HI2(rr);                                             \
    ypend = yv.x + yv.y;                                                                    \
    if ((S) == 15) { ypend = row16_sum(ypend); ykeep = (jl == 15) ? ypend : ykeep; }        \
  }
#define SC_COMPUTE(c)                                                                       \
  {                                                                                         \
    const unsigned a0 = sbase + (unsigned)(((c) & 1) * SC_BUF + jl * 16);                   \
    const unsigned a1 = sbase + (unsigned)(((c) & 1) * SC_BUF + il * 64);                   \
    f32x4 dec_[3], kkn_[3], nb_[3], km_[3], rr_[3], vq_[2];                                 \
    float ykeep = 0.f, ypend = 0.f;                                                         \
    SC_ISSUE(0, 0)                                                                          \
    SC_ISSUE(1, 1)                                                                          \
    SC_STEP(0, 10) SC_STEP(1, 10) SC_STEP(2, 10) SC_STEP(3, 10) SC_STEP(4, 10) SC_STEP(5, 10) SC_STEP(6, 10) SC_STEP(7, 10) \
    SC_STEP(8, 10) SC_STEP(9, 10) SC_STEP(10, 10) SC_STEP(11, 10) SC_STEP(12, 10) SC_STEP(13, 10) SC_STEP(14, 5) SC_STEP(15, 0) \
    yp[(size_t)((c) * 16 + jl) * 512] = ykeep;                                              \
  }
    constexpr int NCH = SEQ / 16;
    float* yp = Y + (size_t)b * SEQ * 512 + h * 64 + il;
    __syncthreads();
    SC_GLOAD(gA, 0);
    SC_STORE(gA, 0);
    SC_GLOAD(gA, 16);
    SC_GLOAD(gB, 32);
    __syncthreads();
    for (int c = 0; c < NCH; c += 2) {
      SC_COMPUTE(c)
      SC_STORE(gA, 1)
      if (c + 3 < NCH) SC_GLOAD(gA, (c + 3) * 16);
      asm volatile("s_waitcnt lgkmcnt(0)\n\ts_barrier" ::: "memory");
      SC_COMPUTE(c + 1)
      if (c + 2 < NCH) {
        SC_STORE(gB, 0)
        if (c + 4 < NCH) SC_GLOAD(gB, (c + 4) * 16);
      }
      asm volatile("s_waitcnt lgkmcnt(0)\n\ts_barrier" ::: "memory");
    }
  }
  for (;;) {
    __syncthreads();
    if (tid == 0) sflag[3] = (int)atomicAdd(&qctr[32], 1u);
    __syncthreads();
    const int u = sflag[3];
    __syncthreads();
    if (u >= T / 128) break;
    mix_unit(p, u, smem);
  }
  for (;;) {
    __syncthreads();
    if (tid == 0) sflag[2] = (int)atomicAdd(&qctr[16], 1u);
    __syncthreads();
    const int ch = sflag[2];
    if (ch >= CVT_CHUNKS) break;
    cvt_chunk(p, ch);
  }
}

__device__ __forceinline__ void phase_post(const Params& p) {
  const float* Y = (const float*)(p.ws + OFF_Y);
  const u16* V = (const u16*)(p.ws + OFF_REGF + 96 * MB);
  const u16* GG = (const u16*)(p.ws + OFF_REGD + 32 * MB);
  const float* BONUS = (const float*)(p.ws + OFF_BONUS);
  u16* MIXIN = (u16*)(p.ws + OFF_REGB);
  const int tid = threadIdx.x;
  const int c = (tid & 127) * 4;
  const float4 gw = *(const float4*)(p.gn_w + c), gb = *(const float4*)(p.gn_b + c);
  for (int tp = blockIdx.x; tp < T / 2; tp += gridDim.x) {
    const int t = tp * 2 + (tid >> 7);
    const size_t o = (size_t)t * 512 + c;
    const float4 y = *(const float4*)(Y + o);
    float s = row16_sum(y.x + y.y + y.z + y.w);
    const float mean = s * (1.f / 64.f);
    const float d0 = y.x - mean, d1 = y.y - mean, d2 = y.z - mean, d3 = y.w - mean;
    const float var = row16_sum(d0 * d0 + d1 * d1 + d2 * d2 + d3 * d3) * (1.f / 64.f);
    const float rstd = __builtin_amdgcn_rsqf(var + 64e-5f);
    const float bon = BONUS[(size_t)t * 8 + (c >> 6)];
    const uint2 vu = *(const uint2*)(V + o), gu = *(const uint2*)(GG + o);
    const float o0 = (d0 * rstd * gw.x + gb.x + bon * bflo(vu.x)) * bflo(gu.x);
    const float o1 = (d1 * rstd * gw.y + gb.y + bon * bfhi(vu.x)) * bfhi(gu.x);
    const float o2 = (d2 * rstd * gw.z + gb.z + bon * bflo(vu.y)) * bflo(gu.y);
    const float o3 = (d3 * rstd * gw.w + gb.w + bon * bfhi(vu.y)) * bfhi(gu.y);
    *(uint2*)(MIXIN + (size_t)t * D + 512 + c) = make_uint2(pack2(o0, o1), pack2(o2, o3));
  }
}

__device__ __forceinline__ void phase_gemm_out(const Params& p, char* smem) {
  const u16* MIXIN = (const u16*)(p.ws + OFF_REGB);
  const u16* WOUT = (const u16*)(p.ws + OFF_WOUT);
  const float* MOD = (const float*)(p.ws + OFF_MOD);
  constexpr int NT = D / 128, MT = T / 128;
  for (int tile = blockIdx.x; tile < NT * MT; tile += gridDim.x) {
    const int mt = tile / NT, nt = tile % NT;
    f32x16 acc[2][2];
    gemm128d(MIXIN, D, WOUT, D, D, mt * 128, nt * 128, smem, acc);
    const int b = (mt * 128) / SEQ;
    const float* gt = MOD + b * 6144 + 2048 + nt * 128;
    epi_staged(acc, smem, [&](int row, int c4, float4 v) {
      const size_t o = (size_t)(mt * 128 + row) * D + nt * 128 + c4;
      const float4 xv = *(const float4*)(p.x + o);
      const float4 g = *(const float4*)(gt + c4);
      *(float4*)(p.out + o) = make_float4(xv.x + g.x * v.x, xv.y + g.y * v.y, xv.z + g.z * v.z, xv.w + g.w * v.w);
    });
  }
}

__device__ __forceinline__ u32 f2ord(float f) {
  u32 u = __float_as_uint(f);
  return (u & 0x80000000u) ? ~u : (u | 0x80000000u);
}
__device__ __forceinline__ float ord2f(u32 u) {
  u = (u & 0x80000000u) ? (u & 0x7FFFFFFFu) : ~u;
  return __uint_as_float(u);
}
#define TOPK_INSERT(L, x)                       \
  {                                             \
    u32 _x = (x);                               \
    _Pragma("unroll") for (int _i = 0; _i < 16; ++_i) { \
      u32 _hi = max(L[_i], _x);                 \
      _x = min(L[_i], _x);                      \
      L[_i] = _hi;                              \
    }                                           \
  }

#define CMPEX_DESC(a, b) { const u32 _hi = max(a, b); const u32 _lo = min(a, b); a = _hi; b = _lo; }
__device__ __forceinline__ void sort16_desc(u32 (&v)[16]) {
#pragma unroll
  for (int k = 2; k <= 16; k <<= 1) {
#pragma unroll
    for (int j = k >> 1; j > 0; j >>= 1) {
#pragma unroll
      for (int i = 0; i < 16; ++i) {
        const int l = i ^ j;
        if (l > i) {
          if ((i & k) == 0) CMPEX_DESC(v[i], v[l]) else CMPEX_DESC(v[l], v[i])
        }
      }
    }
  }
}
__device__ __forceinline__ void merge16_desc(u32 (&a)[16], const u32 (&b)[16]) {
#pragma unroll
  for (int i = 0; i < 16; ++i) a[i] = max(a[i], b[15 - i]);
#pragma unroll
  for (int j = 8; j > 0; j >>= 1) {
#pragma unroll
    for (int i = 0; i < 16; ++i) {
      const int l = i ^ j;
      if (l > i) CMPEX_DESC(a[i], a[l])
    }
  }
}

__device__ __forceinline__ void phase_peer_route(const Params& p, char* smem) {
  const u16* U2 = (const u16*)(p.ws + OFF_REGB);
  const u16* WQ = (const u16*)(p.ws + OFF_WQ);
  const u16* KEYS = (const u16*)(p.ws + OFF_KEYS);
  int* EXPID = (int*)(p.ws + OFF_EXPID);
  float* GATE = (float*)(p.ws + OFF_GATE);
  const int tid = threadIdx.x, lane = tid & 63, wid = tid >> 6, wm = wid >> 1, wn = wid & 1, fr = lane & 15, fq = lane >> 4;
  constexpr int QROWB = 272;
  char* qs = smem;
  char* ks = smem + 128 * QROWB;
  float* sT = (float*)smem;
  for (int task = blockIdx.x; task < (T / 128) * PEER_H; task += gridDim.x) {
    const int mt = task / PEER_H, h = task % PEER_H;
    u32 L0[16], L1[16];
#pragma unroll
    for (int pp = 0; pp < 2; ++pp) {
      f32x16 sc[2][2];
      gemm128(U2, D, WQ, D, D, mt * 128, h * 256 + pp * 128, smem, sc);
      {
        const int fr32 = lane & 31, fh = lane >> 5;
#pragma unroll
        for (int mi = 0; mi < 2; ++mi)
#pragma unroll
          for (int ni = 0; ni < 2; ++ni)
#pragma unroll
            for (int g = 0; g < 4; ++g)
              *(f32x4*)(sT + (wm * 64 + mi * 32 + fr32) * 132 + wn * 64 + ni * 32 + g * 8 + fh * 4) =
                  f32x4{sc[mi][ni][g * 4 + 0], sc[mi][ni][g * 4 + 1], sc[mi][ni][g * 4 + 2], sc[mi][ni][g * 4 + 3]};
      }
      __syncthreads();
      {
        const int trow = tid & 127, half = tid >> 7;
        u32 L[16];
#pragma unroll
        for (int i = 0; i < 16; ++i) L[i] = 0u;
#pragma unroll 1
        for (int g = 0; g < 4; ++g) {
          u32 grp[16];
          const int kb = half * 64 + g * 16;
#pragma unroll
          for (int i4 = 0; i4 < 4; ++i4) {
            const float4 sv = *(const float4*)(sT + trow * 132 + kb + i4 * 4);
            grp[i4 * 4 + 0] = (f2ord(sv.x) & ~0x7Fu) | (u32)(127 - kb - i4 * 4);
            grp[i4 * 4 + 1] = (f2ord(sv.y) & ~0x7Fu) | (u32)(126 - kb - i4 * 4);
            grp[i4 * 4 + 2] = (f2ord(sv.z) & ~0x7Fu) | (u32)(125 - kb - i4 * 4);
            grp[i4 * 4 + 3] = (f2ord(sv.w) & ~0x7Fu) | (u32)(124 - kb - i4 * 4);
          }
          sort16_desc(grp);
          merge16_desc(L, grp);
        }
        __syncthreads();
        u32* xl = (u32*)smem;
        if (half == 1) {
#pragma unroll
          for (int i = 0; i < 16; ++i) xl[trow * 17 + i] = L[i];
        }
        __syncthreads();
        if (half == 0) {
          u32 oth[16];
#pragma unroll
          for (int i = 0; i < 16; ++i) oth[i] = xl[trow * 17 + i];
          merge16_desc(L, oth);
#pragma unroll
          for (int i = 0; i < 16; ++i) {
            if (pp == 0) L0[i] = L[i]; else L1[i] = L[i];
          }
        }
      }
      __syncthreads();
    }
    if (tid < 128) {
      float s0[16], s1[16];
#pragma unroll
      for (int i = 0; i < 16; ++i) {
        s0[i] = ord2f(L0[i] & ~0x7Fu);
        s1[i] = ord2f(L1[i] & ~0x7Fu);
      }
#define CKEY(i, j) ((f2ord(s0[i] + s1[j]) & ~0xFFu) | (u32)(255 - ((i) * 16 + (j))))
      u32 B[16], Bk[16], Ck[16], Dk[16];
#pragma unroll
      for (int j = 0; j < 16; ++j) B[j] = CKEY(0, j);
#pragma unroll
      for (int j = 0; j < 8; ++j) Bk[j] = CKEY(1, j);
#pragma unroll
      for (int j = 0; j < 5; ++j) Bk[8 + j] = CKEY(2, j);
#pragma unroll
      for (int j = 0; j < 3; ++j) Bk[13 + j] = CKEY(4, j);
#pragma unroll
      for (int j = 0; j < 4; ++j) Ck[j] = CKEY(3, j);
#pragma unroll
      for (int j = 0; j < 2; ++j) { Ck[4 + j] = CKEY(5, j); Ck[6 + j] = CKEY(6, j); Ck[8 + j] = CKEY(7, j); }
#pragma unroll
      for (int i = 8; i < 14; ++i) Ck[10 + (i - 8)] = CKEY(i, 0);
      {
        const u32 d14 = CKEY(14, 0), d15 = CKEY(15, 0);
        Dk[0] = max(d14, d15);
        Dk[1] = min(d14, d15);
#pragma unroll
        for (int i = 2; i < 16; ++i) Dk[i] = 0u;
      }
#undef CKEY
      sort16_desc(Bk);
      sort16_desc(Ck);
      merge16_desc(B, Bk);
      merge16_desc(B, Ck);
      merge16_desc(B, Dk);
      float bv[16];
      int eid[16];
      u32* slot = (u32*)smem + tid * 33;
#pragma unroll
      for (int z = 0; z < 16; ++z) { slot[z] = L0[z]; slot[16 + z] = L1[z]; }
#pragma unroll
      for (int q = 0; q < 16; ++q) {
        const int pos = 255 - (int)(B[q] & 0xFFu);
        const u32 a = slot[pos >> 4], bq = slot[16 + (pos & 15)];
        const int i0 = 127 - (int)(a & 0x7Fu), i1 = 127 - (int)(bq & 0x7Fu);
        eid[q] = i0 * NKEYS + i1;
        bv[q] = ord2f(a & ~0x7Fu) + ord2f(bq & ~0x7Fu);
      }
      float mx = bv[0];
#pragma unroll
      for (int q = 1; q < 16; ++q) mx = fmaxf(mx, bv[q]);
      float den = 0.f;
#pragma unroll
      for (int q = 0; q < 16; ++q) { bv[q] = __expf(bv[q] - mx); den += bv[q]; }
      const float rden = __builtin_amdgcn_rcpf(den);
      const size_t o = ((size_t)(mt * 128 + tid) * PEER_H + h) * 16;
#pragma unroll
      for (int q = 0; q < 16; q += 4) {
        *(int4*)(EXPID + o + q) = make_int4(eid[q], eid[q + 1], eid[q + 2], eid[q + 3]);
        *(float4*)(GATE + o + q) = make_float4(bv[q] * rden, bv[q + 1] * rden, bv[q + 2] * rden, bv[q + 3] * rden);
      }
    }
    __syncthreads();
  }
}

#define CVT_LO(w) __builtin_amdgcn_cvt_pk_f32_fp8((int)(w), false)
#define CVT_HI(w) __builtin_amdgcn_cvt_pk_f32_fp8((int)(w), true)
__device__ __forceinline__ void phase_peer_gather(const Params& p) {
  const u16* U2 = (const u16*)(p.ws + OFF_REGB);
  const uint4* EU = (const uint4*)(p.ws + OFF_EU8);
  const uint4* EV = (const uint4*)(p.ws + OFF_EV8);
  const int* EXPID = (const int*)(p.ws + OFF_EXPID);
  const float* GATE = (const float*)(p.ws + OFF_GATE);
  const float* MOD = (const float*)(p.ws + OFF_MOD);
  const int lane = threadIdx.x & 63;
  const int gw = blockIdx.x * 4 + (threadIdx.x >> 6), nw = gridDim.x * 4;
  for (int t = gw; t < T; t += nw) {
    const int b = t / SEQ;
    const uint4 xa = *(const uint4*)(U2 + (size_t)t * D + lane * 16);
    const uint4 xb = *(const uint4*)(U2 + (size_t)t * D + lane * 16 + 8);
    v2f x2[8];
    x2[0] = v2f{bflo(xa.x), bfhi(xa.x)}; x2[1] = v2f{bflo(xa.y), bfhi(xa.y)};
    x2[2] = v2f{bflo(xa.z), bfhi(xa.z)}; x2[3] = v2f{bflo(xa.w), bfhi(xa.w)};
    x2[4] = v2f{bflo(xb.x), bfhi(xb.x)}; x2[5] = v2f{bflo(xb.y), bfhi(xb.y)};
    x2[6] = v2f{bflo(xb.z), bfhi(xb.z)}; x2[7] = v2f{bflo(xb.w), bfhi(xb.w)};
    v2f o2[8];
#pragma unroll
    for (int i = 0; i < 8; ++i) o2[i] = v2f{0.f, 0.f};
    const int idA = EXPID[(size_t)t * 128 + lane], idB = EXPID[(size_t)t * 128 + 64 + lane];
    const float gA = GATE[(size_t)t * 128 + lane], gB = GATE[(size_t)t * 128 + 64 + lane];
    for (int h = 0; h < PEER_H; ++h) {
      const int idv = (h < 4) ? idA : idB;
      const float gtv = (h < 4) ? gA : gB;
      const int lb = (h & 3) * 16;
      float part[16];
#pragma unroll
      for (int e = 0; e < 16; ++e) {
        const int id = __builtin_amdgcn_readlane(idv, lb + e);
        const uint4 a = EU[(size_t)id * 64 + lane];
        v2f acc = CVT_LO(a.x) * x2[0];
        acc = CVT_HI(a.x) * x2[1] + acc;
        acc = CVT_LO(a.y) * x2[2] + acc;
        acc = CVT_HI(a.y) * x2[3] + acc;
        acc = CVT_LO(a.z) * x2[4] + acc;
        acc = CVT_HI(a.z) * x2[5] + acc;
        acc = CVT_LO(a.w) * x2[6] + acc;
        acc = CVT_HI(a.w) * x2[7] + acc;
        part[e] = acc.x + acc.y;
      }
      float p8[8], p4[4], p2[2], p1;
      {
        const bool up = (lane & 32) != 0;
#pragma unroll
        for (int e = 0; e < 8; ++e) {
          const float mine = up ? part[e + 8] : part[e];
          const float oth = up ? part[e] : part[e + 8];
          p8[e] = mine + __shfl_xor(oth, 32);
        }
      }
      {
        const bool up = (lane & 16) != 0;
#pragma unroll
        for (int e = 0; e < 4; ++e) {
          const float mine = up ? p8[e + 4] : p8[e];
          const float oth = up ? p8[e] : p8[e + 4];
          p4[e] = mine + __shfl_xor(oth, 16);
        }
      }
      {
        const bool up = (lane & 8) != 0;
#pragma unroll
        for (int e = 0; e < 2; ++e) {
          const float mine = up ? p4[e + 2] : p4[e];
          const float oth = up ? p4[e] : p4[e + 2];
          p2[e] = mine + DPP_ROR(oth, 8);
        }
      }
      {
        const bool up = (lane & 4) != 0;
        const float mine = up ? p2[1] : p2[0];
        const float oth = up ? p2[0] : p2[1];
        p1 = mine + __shfl_xor(oth, 4);
      }
      p1 += __builtin_bit_cast(float, __builtin_amdgcn_update_dpp(0, __builtin_bit_cast(int, p1), 0x4E, 0xF, 0xF, false));
      p1 += __builtin_bit_cast(float, __builtin_amdgcn_update_dpp(0, __builtin_bit_cast(int, p1), 0xB1, 0xF, 0xF, false));
      p1 *= (1.0f / 512.f);
      const int myE = ((lane >> 5) & 1) * 8 + ((lane >> 4) & 1) * 4 + ((lane >> 3) & 1) * 2 + ((lane >> 2) & 1);
      const float gmine = __shfl(gtv, lb + myE);
      const float hv = 0.5f * p1 * (1.0f + erff(p1 * 0.70710678118654752f));
      const float coef = gmine * hv * (1.0f / 128.f);
#pragma unroll
      for (int e = 0; e < 16; ++e) {
        const int srcLane = ((e >> 3) & 1) * 32 + ((e >> 2) & 1) * 16 + ((e >> 1) & 1) * 8 + (e & 1) * 4;
        const float ce = __builtin_bit_cast(float, __builtin_amdgcn_readlane(__builtin_bit_cast(int, coef), srcLane));
        const int id = __builtin_amdgcn_readlane(idv, lb + e);
        const uint4 a = EV[(size_t)id * 64 + lane];
        const v2f c2 = v2f{ce, ce};
        o2[0] = CVT_LO(a.x) * c2 + o2[0];
        o2[1] = CVT_HI(a.x) * c2 + o2[1];
        o2[2] = CVT_LO(a.y) * c2 + o2[2];
        o2[3] = CVT_HI(a.y) * c2 + o2[3];
        o2[4] = CVT_LO(a.z) * c2 + o2[4];
        o2[5] = CVT_HI(a.z) * c2 + o2[5];
        o2[6] = CVT_LO(a.w) * c2 + o2[6];
        o2[7] = CVT_HI(a.w) * c2 + o2[7];
      }
    }
    float* orow = p.out + (size_t)t * D + lane * 16;
    const float* gt = MOD + b * 6144 + 5120 + lane * 16;
    float xf[16];
    float ss = 0.f;
#pragma unroll
    for (int q = 0; q < 4; ++q) {
      const float4 x0 = *(const float4*)(orow + q * 4);
      const float4 g0 = *(const float4*)(gt + q * 4);
      xf[q * 4 + 0] = x0.x + g0.x * o2[q * 2].x;
      xf[q * 4 + 1] = x0.y + g0.y * o2[q * 2].y;
      xf[q * 4 + 2] = x0.z + g0.z * o2[q * 2 + 1].x;
      xf[q * 4 + 3] = x0.w + g0.w * o2[q * 2 + 1].y;
    }
#pragma unroll
    for (int i = 0; i < 16; ++i) ss += xf[i] * xf[i];
    ss = wave_sum(ss);
    const float rstd = __builtin_amdgcn_rsqf(ss * (1.0f / D) + 1e-6f);
#pragma unroll
    for (int q = 0; q < 4; ++q) {
      const float4 f0 = *(const float4*)(p.final_g + lane * 16 + q * 4);
      *(float4*)(orow + q * 4) =
          make_float4(xf[q * 4 + 0] * rstd * f0.x, xf[q * 4 + 1] * rstd * f0.y, xf[q * 4 + 2] * rstd * f0.z, xf[q * 4 + 3] * rstd * f0.w);
    }
  }
}

#ifndef PROBE_MASK
#define PROBE_MASK 0
#endif
__global__ void __launch_bounds__(NTHREADS, 2) hymba_mega(Params p) {
  __shared__ __attribute__((aligned(16))) char smem[SMEM_BYTES];
  __shared__ uint4 xb_words;
  cg::grid_group grid = cg::this_grid();
  if (threadIdx.x == 0) xb_words = make_uint4(0u, 0u, 0u, 0u);
  __syncthreads();
  const XcdBarrier xb = xcd_barrier_post((unsigned*)(p.ws + OFF_BAR), (volatile LAS unsigned*)&xb_words);
#define RUN_PHASE(N, CALL)                          \
  {                                                 \
    CALL;                                           \
    if ((PROBE_MASK >> (N)) & 1) { xcd_barrier(xb); CALL; } \
  }
  RUN_PHASE(0, phase_prep(p, smem))
  grid.sync();
  phase_peer_fold(p, smem);
  RUN_PHASE(1, phase_normmod(p.x, p.norm_mix_g, (const float*)(p.ws + OFF_MOD), 0, 1024, (u16*)(p.ws + OFF_REGB)))
  xcd_barrier(xb);
  RUN_PHASE(2, phase_gemm_in(p, smem))
  xcd_barrier(xb);
  RUN_PHASE(3, phase_act(p))
  xcd_barrier(xb);
  RUN_PHASE(4, phase_lora_conv(p, smem))
  xcd_barrier(xb);
  RUN_PHASE(5, phase_scanprep(p))
  xcd_barrier(xb);
  phase_scan(p, smem, 0);
  if ((PROBE_MASK >> 6) & 1) { xcd_barrier(xb); phase_scan(p, smem, 1); }
  xcd_barrier(xb);
  RUN_PHASE(7, phase_post(p))
  xcd_barrier(xb);
  RUN_PHASE(8, phase_gemm_out(p, smem))
  xcd_barrier(xb);
  RUN_PHASE(9, phase_normmod(p.out, p.norm_ffn_g, (const float*)(p.ws + OFF_MOD), 3072, 4096, (u16*)(p.ws + OFF_REGB)))
  xcd_barrier(xb);
  RUN_PHASE(10, phase_peer_route(p, smem))
  xcd_barrier(xb);
  phase_peer_gather(p);
#ifdef PROBE_TIME
  xcd_barrier(xb);
  if (blockIdx.x == 0 && threadIdx.x == 0) p.out[0] += *(const float*)(p.ws + OFF_BAR + 32768);
#endif
}

extern "C" void kernel_launch(void* const* d_in, const int* in_sizes, int n_in, void* d_out, int out_size, void* d_ws,
                              size_t ws_size, hipStream_t stream) {
  static int grid_blocks = 0;
  if (!grid_blocks) {
    int dev = 0, cus = 0, per_cu = 0;
    (void)hipGetDevice(&dev);
    (void)hipDeviceGetAttribute(&cus, hipDeviceAttributeMultiprocessorCount, dev);
    (void)hipOccupancyMaxActiveBlocksPerMultiprocessor(&per_cu, hymba_mega, NTHREADS, 0);
    if (per_cu > 2) per_cu = 2;
    grid_blocks = cus * per_cu;
  }
  if (ws_size < WS_NEEDED) {
    fprintf(stderr, "workspace too small: %zu < %zu\n", ws_size, (size_t)WS_NEEDED);
    return;
  }
  Params p{};
  const float** pf = (const float**)&p;
  for (int i = 0; i < 28; ++i) pf[i] = (const float*)d_in[i];
  p.out = (float*)d_out;
  p.ws = (char*)d_ws;
  (void)hipMemsetAsync((char*)d_ws + OFF_BAR, 0, (XCD_BAR_WORDS + 2 * (2048 + 64)) * 4, stream);
  void* args[] = {&p};
  hipError_t e = hipLaunchCooperativeKernel((void*)hymba_mega, dim3(grid_blocks), dim3(NTHREADS), args, 0, stream);
  if (e != hipSuccess) fprintf(stderr, "cooperative launch failed: %s (grid %d)\n", hipGetErrorString(e), grid_blocks);
}
```

```cpp
#include <hip/hip_runtime.h>
#include <hip/hip_cooperative_groups.h>
#include <cstdio>
#include <cstdint>
namespace cg = cooperative_groups;

typedef unsigned short u16;
typedef unsigned int u32;
using bf16x8 = __attribute__((ext_vector_type(8))) short;
using f32x4 = __attribute__((ext_vector_type(4))) float;
using f32x16 = __attribute__((ext_vector_type(16))) float;
typedef __attribute__((ext_vector_type(2))) __bf16 bf2_t;
typedef float v2f __attribute__((ext_vector_type(2)));

constexpr int D = 1024, NBATCH = 8, SEQ = 4096, T = NBATCH * SEQ;
constexpr int CONV_CH = 512, RW = 512, NPROJ = 2816, RWKV_PROJ = 1792;
constexpr int CONV_W = 31;
constexpr int NHEAD = 8;
constexpr int PEER_H = 8, PEER_K = 16, NKEYS = 128;
constexpr int NTHREADS = 256;
constexpr int SMEM_BYTES = 79872;

constexpr size_t MB = 1ull << 20;
constexpr size_t OFF_WIN = 0;
constexpr size_t OFF_WOUT = OFF_WIN + (size_t)NPROJ * D * 2;
constexpr size_t OFF_WQ = OFF_WOUT + (size_t)D * D * 2;
constexpr size_t OFF_WLORA = OFF_WQ + (size_t)2048 * D * 2;
constexpr size_t OFF_KEYS = OFF_WLORA + (size_t)1536 * 256 * 2;
constexpr size_t OFF_MOD = OFF_KEYS + (size_t)16 * 128 * 128 * 2;
constexpr size_t OFF_BONUS = OFF_MOD + (size_t)8 * 6144 * 4;
constexpr size_t OFF_BAR = OFF_BONUS + (size_t)T * 8 * 4;
constexpr size_t OFF_REGB = 16 * MB;
constexpr size_t OFF_REGC = OFF_REGB + 64 * MB;
constexpr size_t SZ_P = (size_t)T * NPROJ * 2;
constexpr size_t OFF_PC = OFF_REGC;
constexpr size_t OFF_PR = OFF_REGC + 64 * MB;
constexpr size_t OFF_Y = OFF_REGC + 64 * MB;
constexpr size_t OFF_EXPID = OFF_REGC + 160 * MB;
constexpr size_t OFF_GATE = OFF_REGC + 176 * MB;
constexpr size_t OFF_REGD = OFF_REGC + 176 * MB + 16 * MB;
constexpr size_t OFF_REGF = OFF_REGD + 64 * MB;
constexpr size_t WS_NEEDED = OFF_REGF + 160 * MB;
static_assert(OFF_BAR + (3456 + 2 * (2048 + 64)) * 4 <= OFF_REGB, "small region overflow");
static_assert(SZ_P <= 192 * MB, "P overflow");

struct Params {
  const float *x, *c, *ada_w, *ada_b, *norm_mix_g, *w_in, *conv_w, *conv_b, *ln_w, *ln_b;
  const float *mu, *w0, *w2, *a0, *a2, *g2, *k_k, *k_a, *r_k, *gn_w, *gn_b, *w_out, *norm_ffn_g;
  const float *w_q, *sub_keys, *peer_u, *peer_v, *final_g;
  float* out;
  char* ws;
};

typedef __bf16 bf2v_t __attribute__((ext_vector_type(2)));
__device__ __forceinline__ u32 pack2(float a, float b) {
  return __builtin_bit_cast(u32, __builtin_convertvector((v2f{a, b}), bf2v_t));
}
__device__ __forceinline__ u16 f2bf(float f) { return (u16)(pack2(f, 0.f) & 0xFFFFu); }
__device__ __forceinline__ float bf2f(u16 h) { return __uint_as_float(((u32)h) << 16); }

__device__ __forceinline__ float bflo(u32 v) { return __uint_as_float(v << 16); }
__device__ __forceinline__ float bfhi(u32 v) { return __uint_as_float(v & 0xFFFF0000u); }
__device__ __forceinline__ float sigmoidf_(float x) { return __builtin_amdgcn_rcpf(1.0f + __expf(-x)); }
__device__ __forceinline__ float tanhf_(float x) {
  const float e = __expf(-2.0f * fabsf(x));
  return copysignf((1.0f - e) * __builtin_amdgcn_rcpf(1.0f + e), x);
}
__device__ __forceinline__ float erff_(float x) {
  const float ax = fabsf(x);
  const float t = __builtin_amdgcn_rcpf(1.0f + 0.3275911f * ax);
  const float poly = t * (0.254829592f + t * (-0.284496736f + t * (1.421413741f + t * (-1.453152027f + t * 1.061405429f))));
  return copysignf(1.0f - poly * __expf(-ax * ax), x);
}
__device__ __forceinline__ float siluf_(float x) { return x * sigmoidf_(x); }
__device__ __forceinline__ float wave_sum(float v) {
#pragma unroll
  for (int o = 32; o > 0; o >>= 1) v += __shfl_xor(v, o);
  return v;
}
__device__ __forceinline__ float dpp_ror_add(float x, int) { return x; }
#define DPP_ROR(x, N) __builtin_bit_cast(float, __builtin_amdgcn_update_dpp(0, __builtin_bit_cast(int, (x)), 0x120 + (N), 0xF, 0xF, false))
__device__ __forceinline__ float row16_sum(float x) {
  x += DPP_ROR(x, 8);
  x += DPP_ROR(x, 4);
  x += DPP_ROR(x, 2);
  x += DPP_ROR(x, 1);
  return x;
}

#define XB_TMO      128
#define XB_XCNT(j)  (256  + 64 * (j))
#define XB_XSUB(j)  (1280 + 64 * (j))
#define XB_XGEN(j)  (2304 + 64 * (j))
#define XB_TOP      3328
#define XB_TOPGEN   3392
#define XCD_BAR_WORDS 3456
#define XB_SPIN_CAP (1u << 18)
#define LAS __attribute__((address_space(3)))
__device__ __forceinline__ unsigned xb_ld(unsigned* p)              { return __hip_atomic_load(p, __ATOMIC_RELAXED, __HIP_MEMORY_SCOPE_AGENT); }
__device__ __forceinline__ unsigned xb_add(unsigned* p, unsigned v) { return __hip_atomic_fetch_add(p, v, __ATOMIC_RELAXED, __HIP_MEMORY_SCOPE_AGENT); }
__device__ __forceinline__ unsigned xb_xcc_id() { return (unsigned)__builtin_amdgcn_s_getreg((3 << 11) | 20) & 0xFu; }
#define XB_SPIN(cond, bar) do { unsigned _sp = 0; while (cond) { __builtin_amdgcn_s_sleep(1); \
    if ((++_sp & 255u) == 0u) { if (xb_ld(&(bar)[XB_TMO])) break; if (_sp > XB_SPIN_CAP) { atomicAdd(&(bar)[XB_TMO], 1u); break; } } } } while (0)
struct XcdBarrier { unsigned* bar; unsigned x; volatile LAS unsigned* st; };
__device__ __forceinline__ XcdBarrier xcd_barrier_post(unsigned* bar, volatile LAS unsigned* st) {
    XcdBarrier b; b.bar = bar; b.x = xb_xcc_id(); b.st = st;
    if (threadIdx.x == 0) (void)xb_add(&bar[XB_XCNT(b.x)], 1u);
    return b;
}
__device__ __forceinline__ void xcd_barrier_complete(unsigned* bar, unsigned x, unsigned& nloc, unsigned& nx) {
    const unsigned G = gridDim.x * gridDim.y * gridDim.z;
    unsigned sum, cnt, mine, sp = 0u;
    for (;;) {
        sum = 0u; cnt = 0u; mine = 0u;
#pragma unroll
        for (unsigned j = 0; j < 16; ++j) { const unsigned c = xb_ld(&bar[XB_XCNT(j)]); sum += c; cnt += (c > 0u) ? 1u : 0u; mine = (j == x) ? c : mine; }
        if (sum == G) break;
        __builtin_amdgcn_s_sleep(1);
        if ((++sp & 255u) == 0u) { if (xb_ld(&bar[XB_TMO])) break; if (sp > XB_SPIN_CAP) { atomicAdd(&bar[XB_TMO], 1u); break; } }
    }
    nloc = mine > 0u ? mine : 1u; nx = cnt > 0u ? cnt : 1u;
}
__device__ __forceinline__ void xcd_barrier(const XcdBarrier& b) {
    asm volatile("s_waitcnt vmcnt(0)" ::: "memory");
    __syncthreads();
    if (threadIdx.x == 0) {
        unsigned* bar = b.bar;
        __builtin_amdgcn_s_waitcnt(0);
        unsigned nloc = b.st[0], nx = b.st[1];
        if (nloc == 0u) { xcd_barrier_complete(bar, b.x, nloc, nx); b.st[0] = nloc; b.st[1] = nx; }
        const unsigned old = xb_add(&bar[XB_XSUB(b.x)], 1u);
        const unsigned gen = old / nloc;
        if (old + 1u == (gen + 1u) * nloc) {
            __builtin_amdgcn_fence(__ATOMIC_RELEASE, "agent");
            asm volatile("s_waitcnt vmcnt(0)" ::: "memory");
            const unsigned og = xb_add(&bar[XB_TOP], 1u);
            const unsigned tg = og / nx;
            if (og + 1u == (tg + 1u) * nx) xb_add(&bar[XB_TOPGEN], 1u);
            else XB_SPIN(xb_ld(&bar[XB_TOPGEN]) == tg, bar);
            __builtin_amdgcn_fence(__ATOMIC_ACQUIRE, "agent");
            xb_add(&bar[XB_XGEN(b.x)], 1u);
            asm volatile("s_waitcnt vmcnt(0)" ::: "memory");
        } else {
            XB_SPIN(xb_ld(&bar[XB_XGEN(b.x)]) == gen, bar);
            __builtin_amdgcn_fence(__ATOMIC_ACQUIRE, "agent");
            asm volatile("s_waitcnt vmcnt(0)" ::: "memory");
        }
    }
    __syncthreads();
}

constexpr int G_ROWB = 144;
constexpr int G_TILEB = 128 * G_ROWB;
template <bool SWAP = true>
__device__ __forceinline__ void gemm128(const u16* __restrict__ A, int lda, const u16* __restrict__ B, int ldb, int K,
                                        int m0, int n0, char* smem, f32x16 (&acc)[2][2]) {
  const int tid = threadIdx.x, lane = tid & 63, wid = tid >> 6, wm = wid >> 1, wn = wid & 1;
  const int fr = lane & 15, fq = lane >> 4;
  const int ldrow = tid >> 3, ldc = tid & 7;
#pragma unroll
  for (int i = 0; i < 2; ++i)
#pragma unroll
    for (int j = 0; j < 2; ++j)
#pragma unroll
      for (int r = 0; r < 16; ++r) acc[i][j][r] = 0.f;
  const int fr32 = lane & 31, fh = lane >> 5;
  uint4 ra[4], rb[4];
  const u16* ga = A + (size_t)(m0 + ldrow) * lda + ldc * 8;
  const u16* gb = B + (size_t)(n0 + ldrow) * ldb + ldc * 8;
  const int nk = K >> 6;
#pragma unroll
  for (int i = 0; i < 4; ++i) {
    ra[i] = *(const uint4*)(ga + (size_t)(32 * i) * lda);
    rb[i] = *(const uint4*)(gb + (size_t)(32 * i) * ldb);
  }
  {
    char* sa = smem + ldrow * G_ROWB + ldc * 16;
#pragma unroll
    for (int i = 0; i < 4; ++i) {
      *(uint4*)(sa + 32 * i * G_ROWB) = ra[i];
      *(uint4*)(sa + G_TILEB + 32 * i * G_ROWB) = rb[i];
    }
  }
  __syncthreads();
  for (int kt = 0; kt < nk; ++kt) {
    const bool more = (kt + 1 < nk);
    if (more) {
      const int k0 = (kt + 1) << 6;
#pragma unroll
      for (int i = 0; i < 4; ++i) {
        ra[i] = *(const uint4*)(ga + (size_t)(32 * i) * lda + k0);
        rb[i] = *(const uint4*)(gb + (size_t)(32 * i) * ldb + k0);
      }
    }
    const char* cur = smem + (kt & 1) * 2 * G_TILEB;
    const char* sa = cur + (wm * 64 + fr32) * G_ROWB + fh * 16;
    const char* sb = cur + G_TILEB + (wn * 64 + fr32) * G_ROWB + fh * 16;
#pragma unroll
    for (int ks = 0; ks < 4; ++ks) {
      bf16x8 af[2], bfr[2];
#pragma unroll
      for (int i = 0; i < 2; ++i) {
        af[i] = *(const bf16x8*)(sa + i * 32 * G_ROWB + ks * 32);
        bfr[i] = *(const bf16x8*)(sb + i * 32 * G_ROWB + ks * 32);
      }
#pragma unroll
      for (int mi = 0; mi < 2; ++mi)
#pragma unroll
        for (int ni = 0; ni < 2; ++ni)
          acc[mi][ni] = SWAP ? __builtin_amdgcn_mfma_f32_32x32x16_bf16(bfr[ni], af[mi], acc[mi][ni], 0, 0, 0)
                             : __builtin_amdgcn_mfma_f32_32x32x16_bf16(af[mi], bfr[ni], acc[mi][ni], 0, 0, 0);
    }
    if (more) {
      char* nxt = smem + ((kt + 1) & 1) * 2 * G_TILEB + ldrow * G_ROWB + ldc * 16;
#pragma unroll
      for (int i = 0; i < 4; ++i) {
        *(uint4*)(nxt + 32 * i * G_ROWB) = ra[i];
        *(uint4*)(nxt + G_TILEB + 32 * i * G_ROWB) = rb[i];
      }
    }
    __syncthreads();
  }
}

__device__ __forceinline__ void gemm128d(const u16* __restrict__ A, int lda, const u16* __restrict__ B, int ldb, int K,
                                        int m0, int n0, char* smem, f32x16 (&acc)[2][2]) {
  const int tid = threadIdx.x, lane = tid & 63, wid = tid >> 6, wm = wid >> 1, wn = wid & 1;
  const int fr = lane & 15, fq = lane >> 4;
  const int ldrow = tid >> 3, ldc = tid & 7;
#pragma unroll
  for (int i = 0; i < 2; ++i)
#pragma unroll
    for (int j = 0; j < 2; ++j)
#pragma unroll
      for (int r = 0; r < 16; ++r) acc[i][j][r] = 0.f;
  const int fr32 = lane & 31, fh = lane >> 5;
  uint4 ra0_0, ra0_1, ra0_2, ra0_3, rb0_0, rb0_1, rb0_2, rb0_3;
  uint4 ra1_0, ra1_1, ra1_2, ra1_3, rb1_0, rb1_1, rb1_2, rb1_3;
  const u16* ga = A + (size_t)(m0 + ldrow) * lda + ldc * 8;
  const u16* gb = B + (size_t)(n0 + ldrow) * ldb + ldc * 8;
  const int nk = K >> 6;
  char* const sw = smem + ldrow * G_ROWB + ldc * 16;
#define G_LOAD1(RA, RB, I, k0)                                          \
  RA##_##I = *(const uint4*)(ga + (size_t)(32 * I) * lda + k0);         \
  RB##_##I = *(const uint4*)(gb + (size_t)(32 * I) * ldb + k0);
#define G_LOAD(RA, RB, KT)                                              \
  {                                                                     \
    const int k0 = (KT) << 6;                                           \
    G_LOAD1(RA, RB, 0, k0) G_LOAD1(RA, RB, 1, k0) G_LOAD1(RA, RB, 2, k0) G_LOAD1(RA, RB, 3, k0) \
  }
#define G_STORE1(RA, RB, I)                                             \
  *(uint4*)(d + 32 * I * G_ROWB) = RA##_##I;                            \
  *(uint4*)(d + G_TILEB + 32 * I * G_ROWB) = RB##_##I;
#define G_STORE(RA, RB, BUF)                                            \
  {                                                                     \
    char* d = sw + (BUF) * 2 * G_TILEB;                                 \
    G_STORE1(RA, RB, 0) G_STORE1(RA, RB, 1) G_STORE1(RA, RB, 2) G_STORE1(RA, RB, 3) \
  }
#define G_COMPUTE(BUF)                                                                          \
  {                                                                                             \
    const char* cur = smem + (BUF) * 2 * G_TILEB;                                               \
    const char* sa = cur + (wm * 64 + fr32) * G_ROWB + fh * 16;                                 \
    const char* sb = cur + G_TILEB + (wn * 64 + fr32) * G_ROWB + fh * 16;                       \
    _Pragma("unroll") for (int ks = 0; ks < 4; ++ks) {                                          \
      bf16x8 af[2], bfr[2];                                                                     \
      _Pragma("unroll") for (int i = 0; i < 2; ++i) {                                           \
        af[i] = *(const bf16x8*)(sa + i * 32 * G_ROWB + ks * 32);                               \
        bfr[i] = *(const bf16x8*)(sb + i * 32 * G_ROWB + ks * 32);                              \
      }                                                                                         \
      _Pragma("unroll") for (int mi = 0; mi < 2; ++mi)                                          \
      _Pragma("unroll") for (int ni = 0; ni < 2; ++ni)                                          \
        acc[mi][ni] = __builtin_amdgcn_mfma_f32_32x32x16_bf16(bfr[ni], af[mi], acc[mi][ni], 0, 0, 0); \
    }                                                                                           \
  }
  G_LOAD(ra0, rb0, 0)
  G_STORE(ra0, rb0, 0)
  G_LOAD(ra0, rb0, 1)
  if (nk > 2) G_LOAD(ra1, rb1, 2)
  __syncthreads();
  for (int kt = 0; kt < nk; kt += 2) {
    G_COMPUTE(0)
    G_STORE(ra0, rb0, 1)
    if (kt + 3 < nk) G_LOAD(ra0, rb0, kt + 3)
    __syncthreads();
    G_COMPUTE(1)
    if (kt + 2 < nk) {
      G_STORE(ra1, rb1, 0)
      if (kt + 4 < nk) G_LOAD(ra1, rb1, kt + 4)
    }
    __syncthreads();
  }
#undef G_LOAD
#undef G_LOAD1
#undef G_STORE
#undef G_STORE1
#undef G_COMPUTE
}

#define ACC_FOREACH(BODY)                                                            \
  {                                                                                  \
    const int _lane = threadIdx.x & 63, _wid = threadIdx.x >> 6;                     \
    const int _wm = _wid >> 1, _wn = _wid & 1, _fr = _lane & 15, _fq = _lane >> 4;   \
    _Pragma("unroll") for (int mi = 0; mi < 4; ++mi)                                 \
    _Pragma("unroll") for (int ni = 0; ni < 4; ++ni)                                 \
    _Pragma("unroll") for (int j = 0; j < 4; ++j) {                                  \
      const int lrow = _wm * 64 + mi * 16 + _fq * 4 + j;                             \
      const int lcol = _wn * 64 + ni * 16 + _fr;                                     \
      const float v = acc[mi][ni][j];                                                \
      BODY                                                                           \
    }                                                                                \
  }

template <class F>
__device__ __forceinline__ void epi_staged(f32x16 (&acc)[2][2], char* smem, F f) {
  float* st = (float*)smem;
  {
    const int lane = threadIdx.x & 63, wid = threadIdx.x >> 6, wm = wid >> 1, wn = wid & 1, fr32 = lane & 31, fh = lane >> 5;
#pragma unroll
    for (int mi = 0; mi < 2; ++mi)
#pragma unroll
      for (int ni = 0; ni < 2; ++ni)
#pragma unroll
        for (int g = 0; g < 4; ++g)
          *(f32x4*)(st + (wm * 64 + mi * 32 + fr32) * 132 + wn * 64 + ni * 32 + g * 8 + fh * 4) =
              f32x4{acc[mi][ni][g * 4 + 0], acc[mi][ni][g * 4 + 1], acc[mi][ni][g * 4 + 2], acc[mi][ni][g * 4 + 3]};
  }
  __syncthreads();
#pragma unroll 4
  for (int i = threadIdx.x; i < 128 * 32; i += NTHREADS) {
    const int row = i >> 5, c4 = (i & 31) << 2;
    const float4 v = *(const float4*)(st + row * 132 + c4);
    f(row, c4, v);
  }
  __syncthreads();
}

constexpr int H_ROWB = 80;
constexpr int H_A = 256 * H_ROWB, H_B = 128 * H_ROWB, H_STAGE = H_A + H_B;
__device__ __forceinline__ void gemm256(const u16* __restrict__ A, int lda, const u16* __restrict__ B, int ldb, int K,
                                        int m0, int n0, char* smem, f32x16 (&acc)[4][2]) {
  const int tid = threadIdx.x, lane = tid & 63, wid = tid >> 6, wm = wid >> 1, wn = wid & 1;
  const int fr32 = lane & 31, fh = lane >> 5;
#pragma unroll
  for (int i = 0; i < 4; ++i)
#pragma unroll
    for (int j = 0; j < 2; ++j)
#pragma unroll
      for (int r = 0; r < 16; ++r) acc[i][j][r] = 0.f;
  const int ldrow = tid >> 2, ldc = tid & 3;
  const u16* ga = A + (size_t)(m0 + ldrow) * lda + ldc * 8;
  const u16* gb = B + (size_t)(n0 + ldrow) * ldb + ldc * 8;
  uint4 a0, a1, a2, a3, b0, b1;
  uint4 c0, c1, c2, c3, d0, d1;
  const int nk = K >> 5;
  char* const swa = smem + ldrow * H_ROWB + ldc * 16;
  char* const swb = smem + H_A + ldrow * H_ROWB + ldc * 16;
#define H_LOAD(k0, A0, A1, A2, A3, B0, B1)                      \
  A0 = *(const uint4*)(ga + (k0));                              \
  A1 = *(const uint4*)(ga + (size_t)64 * lda + (k0));           \
  A2 = *(const uint4*)(ga + (size_t)128 * lda + (k0));          \
  A3 = *(const uint4*)(ga + (size_t)192 * lda + (k0));          \
  B0 = *(const uint4*)(gb + (k0));                              \
  B1 = *(const uint4*)(gb + (size_t)64 * ldb + (k0));
#define H_STORE(BUF, A0, A1, A2, A3, B0, B1)                    \
  *(uint4*)(swa + (BUF) * H_STAGE) = A0;                        \
  *(uint4*)(swa + (BUF) * H_STAGE + 64 * H_ROWB) = A1;          \
  *(uint4*)(swa + (BUF) * H_STAGE + 128 * H_ROWB) = A2;         \
  *(uint4*)(swa + (BUF) * H_STAGE + 192 * H_ROWB) = A3;         \
  *(uint4*)(swb + (BUF) * H_STAGE) = B0;                        \
  *(uint4*)(swb + (BUF) * H_STAGE + 64 * H_ROWB) = B1;
#define H_COMPUTE(BUF)                                                                          \
  {                                                                                             \
    const char* cur = smem + (BUF) * H_STAGE;                                                   \
    const char* sa = cur + (wm * 128 + fr32) * H_ROWB + fh * 16;                                \
    const char* sb = cur + H_A + (wn * 64 + fr32) * H_ROWB + fh * 16;                           \
    _Pragma("unroll") for (int ks = 0; ks < 2; ++ks) {                                          \
      bf16x8 af[4], bfr[2];                                                                     \
      _Pragma("unroll") for (int i = 0; i < 4; ++i) af[i] = *(const bf16x8*)(sa + i * 32 * H_ROWB + ks * 32); \
      _Pragma("unroll") for (int i = 0; i < 2; ++i) bfr[i] = *(const bf16x8*)(sb + i * 32 * H_ROWB + ks * 32); \
      _Pragma("unroll") for (int mi = 0; mi < 4; ++mi)                                          \
      _Pragma("unroll") for (int ni = 0; ni < 2; ++ni)                                          \
        acc[mi][ni] = __builtin_amdgcn_mfma_f32_32x32x16_bf16(bfr[ni], af[mi], acc[mi][ni], 0, 0, 0); \
    }                                                                                           \
  }
  H_LOAD(0, a0, a1, a2, a3, b0, b1)
  H_STORE(0, a0, a1, a2, a3, b0, b1)
  H_LOAD(32, a0, a1, a2, a3, b0, b1)
  if (nk > 2) { H_LOAD(64, c0, c1, c2, c3, d0, d1) }
  __syncthreads();
  for (int kt = 0; kt < nk; kt += 2) {
    H_COMPUTE(0)
    H_STORE(1, a0, a1, a2, a3, b0, b1)
    if (kt + 3 < nk) { const int k0 = (kt + 3) << 5; H_LOAD(k0, a0, a1, a2, a3, b0, b1) }
    __syncthreads();
    H_COMPUTE(1)
    if (kt + 2 < nk) {
      H_STORE(0, c0, c1, c2, c3, d0, d1)
      if (kt + 4 < nk) { const int k0 = (kt + 4) << 5; H_LOAD(k0, c0, c1, c2, c3, d0, d1) }
    }
    __syncthreads();
  }
#undef H_COMPUTE
#undef H_LOAD
#undef H_STORE
}
template <class F>
__device__ __forceinline__ void epi_staged256(f32x16 (&acc)[4][2], char* smem, F f) {
  float* st = (float*)smem;
  const int lane = threadIdx.x & 63, wid = threadIdx.x >> 6, wm = wid >> 1, wn = wid & 1, fr32 = lane & 31, fh = lane >> 5;
#pragma unroll
  for (int half = 0; half < 2; ++half) {
    if (wm == half) {
#pragma unroll
      for (int mi = 0; mi < 4; ++mi)
#pragma unroll
        for (int ni = 0; ni < 2; ++ni)
#pragma unroll
          for (int g = 0; g < 4; ++g)
            *(f32x4*)(st + (mi * 32 + fr32) * 132 + wn * 64 + ni * 32 + g * 8 + fh * 4) =
                f32x4{acc[mi][ni][g * 4 + 0], acc[mi][ni][g * 4 + 1], acc[mi][ni][g * 4 + 2], acc[mi][ni][g * 4 + 3]};
    }
    __syncthreads();
#pragma unroll 4
    for (int i = threadIdx.x; i < 128 * 32; i += NTHREADS) {
      const int row = i >> 5, c4 = (i & 31) << 2;
      const float4 v = *(const float4*)(st + row * 132 + c4);
      f(half * 128 + row, c4, v);
    }
    __syncthreads();
  }
}

__device__ __forceinline__ void transpose_tile(const float* __restrict__ W, int N, u16* __restrict__ Wt, int K, int k0, int n0, float* lds) {
  const int tid = threadIdx.x;
  __syncthreads();
#pragma unroll
  for (int i = 0; i < 16; ++i) {
    int k = i * 4 + (tid >> 6), n = tid & 63;
    lds[k * 65 + n] = W[(size_t)(k0 + k) * N + n0 + n];
  }
  __syncthreads();
#pragma unroll
  for (int i = 0; i < 16; ++i) {
    int n = i * 4 + (tid >> 6), k = tid & 63;
    Wt[(size_t)(n0 + n) * K + k0 + k] = f2bf(lds[k * 65 + n]);
  }
}

__device__ __forceinline__ void phase_prep(const Params& p, char* smem) {
  const int tid = threadIdx.x;
  float* lds = (float*)smem;
  u16* WIN = (u16*)(p.ws + OFF_WIN);
  u16* WOUT = (u16*)(p.ws + OFF_WOUT);
  u16* WLORA = (u16*)(p.ws + OFF_WLORA);
  u16* KEYS = (u16*)(p.ws + OFF_KEYS);
  float* MOD = (float*)(p.ws + OFF_MOD);
  constexpr int N_MOD = 96, N_T1 = 44 * 16, N_T2 = 16 * 16, N_T3 = 0;
  constexpr int N_TASK = N_MOD + N_T1 + N_T2 + N_T3;
  for (int task = blockIdx.x; task < N_TASK; task += gridDim.x) {
    if (task < N_MOD) {
      __syncthreads();
      for (int i = tid; i < 8 * 1024; i += NTHREADS) lds[i] = siluf_(p.c[i]);
      __syncthreads();
      const int lane = tid & 63, w = tid >> 6;
      const int col = task * 64 + lane;
      float a[8];
#pragma unroll
      for (int b = 0; b < 8; ++b) a[b] = 0.f;
      const float* wp = p.ada_w + (size_t)(w * 256) * 6144 + col;
#pragma unroll 8
      for (int k = 0; k < 256; ++k) {
        float wv = wp[(size_t)k * 6144];
#pragma unroll
        for (int b = 0; b < 8; ++b) a[b] += lds[b * 1024 + w * 256 + k] * wv;
      }
      __syncthreads();
#pragma unroll
      for (int b = 0; b < 8; ++b) lds[8192 + (w * 8 + b) * 64 + lane] = a[b];
      __syncthreads();
      for (int i = tid; i < 512; i += NTHREADS) {
        int b = i >> 6, l = i & 63;
        float s = lds[8192 + (0 * 8 + b) * 64 + l] + lds[8192 + (1 * 8 + b) * 64 + l] + lds[8192 + (2 * 8 + b) * 64 + l] +
                  lds[8192 + (3 * 8 + b) * 64 + l];
        MOD[b * 6144 + task * 64 + l] = s + p.ada_b[task * 64 + l];
      }
    } else {
      int t = task - N_MOD;
      if (t < N_T1) {
        transpose_tile(p.w_in, NPROJ, WIN, D, (t & 15) * 64, (t >> 4) * 64, lds);
      } else if (t < N_T1 + N_T2) {
        t -= N_T1;
        transpose_tile(p.w_out, D, WOUT, D, (t & 15) * 64, (t >> 4) * 64, lds);
      }
    }
  }
  const size_t gtid = (size_t)blockIdx.x * NTHREADS + tid, gn = (size_t)gridDim.x * NTHREADS;
  for (size_t i = gtid; i < (size_t)1536 * 256; i += gn) {
    int n = (int)(i >> 8), k = (int)(i & 255);
    float v = 0.f;
    if (n < 512) { if (k < 64) v = p.w2[k * 512 + n]; }
    else if (n < 1024) { if (k >= 64 && k < 128) v = p.a2[(k - 64) * 512 + (n - 512)]; }
    else { if (k >= 128) v = p.g2[(k - 128) * 512 + (n - 1024)]; }
    WLORA[i] = f2bf(v);
  }
  for (size_t i = gtid; i < (size_t)16 * 128 * 128; i += gn) KEYS[i] = f2bf(p.sub_keys[i]);
  {
    uint2* WQB = (uint2*)(p.ws + OFF_REGF);
    const float4* wq4 = (const float4*)p.w_q;
    for (size_t i = gtid; i < (size_t)1024 * 2048 / 4; i += gn) {
      const float4 v = wq4[i];
      WQB[i] = make_uint2(pack2(v.x, v.y), pack2(v.z, v.w));
    }
  }
}

__device__ __forceinline__ void phase_peer_fold(const Params& p, char* smem) {
  const u16* KEYS = (const u16*)(p.ws + OFF_KEYS);
  const u16* WQB = (const u16*)(p.ws + OFF_REGF);
  u16* MT = (u16*)(p.ws + OFF_WQ);
  for (int tile = blockIdx.x; tile < 16 * 8; tile += gridDim.x) {
    const int hp = tile >> 3, dt = tile & 7;
    f32x16 acc[2][2];
    gemm128(KEYS + (size_t)hp * 128 * 128, 128, WQB + hp * 128, 2048, 128, 0, dt * 128, smem, acc);
    epi_staged(acc, smem, [&](int row, int c4, float4 v) {
      *(uint2*)(MT + (size_t)(hp * 128 + row) * D + dt * 128 + c4) = make_uint2(pack2(v.x, v.y), pack2(v.z, v.w));
    });
  }
}

__device__ __forceinline__ void phase_normmod(const float* __restrict__ X, const float* __restrict__ g, const float* __restrict__ MOD,
                              int sh_off, int sc_off, u16* __restrict__ U) {
  const int lane = threadIdx.x & 63;
  const int gw = blockIdx.x * 4 + (threadIdx.x >> 6), nw = gridDim.x * 4;
  for (int t = gw; t < T; t += nw) {
    const int b = t / SEQ;
    const float4* xr = (const float4*)(X + (size_t)t * D);
    float4 v[4];
    float ss = 0.f;
#pragma unroll
    for (int i = 0; i < 4; ++i) {
      v[i] = xr[i * 64 + lane];
      ss += v[i].x * v[i].x + v[i].y * v[i].y + v[i].z * v[i].z + v[i].w * v[i].w;
    }
    ss = wave_sum(ss);
    const float rstd = __builtin_amdgcn_rsqf(ss * (1.0f / D) + 1e-6f);
    const float4* gp = (const float4*)g;
    const float4* shp = (const float4*)(MOD + b * 6144 + sh_off);
    const float4* scp = (const float4*)(MOD + b * 6144 + sc_off);
    uint2* up = (uint2*)(U + (size_t)t * D);
#pragma unroll
    for (int i = 0; i < 4; ++i) {
      float4 gg = gp[i * 64 + lane], sh = shp[i * 64 + lane], sc = scp[i * 64 + lane];
      float o0 = v[i].x * rstd * gg.x * (1.f + sc.x) + sh.x;
      float o1 = v[i].y * rstd * gg.y * (1.f + sc.y) + sh.y;
      float o2 = v[i].z * rstd * gg.z * (1.f + sc.z) + sh.z;
      float o3 = v[i].w * rstd * gg.w * (1.f + sc.w) + sh.w;
      up[i * 64 + lane] = make_uint2(pack2(o0, o1), pack2(o2, o3));
    }
  }
}

__device__ __forceinline__ void phase_gemm_in(const Params& p, char* smem) {
  const u16* U1 = (const u16*)(p.ws + OFF_REGB);
  const u16* WIN = (const u16*)(p.ws + OFF_WIN);
  u16* P = (u16*)(p.ws + OFF_REGC);
  constexpr int NT = NPROJ / 128, MT = T / 256;
  for (int tile = blockIdx.x; tile < NT * MT; tile += gridDim.x) {
    const int mt = tile / NT, nt = tile % NT;
    f32x16 acc[4][2];
    gemm256(U1, D, WIN, D, D, mt * 256, nt * 128, smem, acc);
    epi_staged256(acc, smem, [&](int row, int c4, float4 v) {
      u16* dst = (nt < 8) ? (P + (size_t)(mt * 256 + row) * 1024 + nt * 128 + c4)
                          : (P + (size_t)32 * MB + (size_t)(mt * 256 + row) * 1792 + (nt - 8) * 128 + c4);
      *(uint2*)dst = make_uint2(pack2(v.x, v.y), pack2(v.z, v.w));
    });
  }
}

__device__ __forceinline__ void phase_act(const Params& p) {
  const u16* P = (const u16*)(p.ws + OFF_PR);
  u16* ACT = (u16*)(p.ws + OFF_REGF + 128 * MB);
  const size_t gtid = (size_t)blockIdx.x * NTHREADS + threadIdx.x, gn = (size_t)gridDim.x * NTHREADS;
  for (size_t i = gtid; i < (size_t)T * 64; i += gn) {
    const int t = (int)(i >> 6), c = (int)(i & 63) * 4;
    const u16* pr = P + (size_t)t * 1792 + 1536 + c;
    uint2 cur = *(const uint2*)pr;
    uint2 prv = make_uint2(0u, 0u);
    if ((t % SEQ) != 0) prv = *(const uint2*)(pr - 1792);
    float4 m = *(const float4*)(p.mu + 1536 + c);
    float x0 = bflo(cur.x), x1 = bfhi(cur.x), x2 = bflo(cur.y), x3 = bfhi(cur.y);
    x0 += m.x * (bflo(prv.x) - x0);
    x1 += m.y * (bfhi(prv.x) - x1);
    x2 += m.z * (bflo(prv.y) - x2);
    x3 += m.w * (bfhi(prv.y) - x3);
    if (c < 64) { x0 = tanhf_(x0); x1 = tanhf_(x1); x2 = tanhf_(x2); x3 = tanhf_(x3); }
    else if (c >= 128) { x0 = sigmoidf_(x0); x1 = sigmoidf_(x1); x2 = sigmoidf_(x2); x3 = sigmoidf_(x3); }
    *(uint2*)(ACT + (size_t)t * 256 + c) = make_uint2(pack2(x0, x1), pack2(x2, x3));
  }
}

__device__ __forceinline__ void conv_tile(const Params& p, int tile, char* smem) {
  const u16* P = (const u16*)(p.ws + OFF_PC);
  u16* MIXIN = (u16*)(p.ws + OFF_REGB);
  const int tid = threadIdx.x, lane = tid & 63, wid = tid >> 6;
  u32* ylds = (u32*)smem;
  float* olds = (float*)(smem + 62 * 1024);
  const int tok0 = tile * 32;
  const int s0 = tok0 % SEQ;
  __syncthreads();
  for (int r = 0; r < 62; ++r) {
    const int s = s0 - 30 + r;
    u32 val = 0u;
    if (s >= 0) {
      const u16* pr = P + (size_t)(tok0 - 30 + r) * 1024;
      u32 a = *(const u32*)(pr + 2 * tid);
      u32 bq = *(const u32*)(pr + 512 + 2 * tid);
      val = pack2(bflo(a) * sigmoidf_(bflo(bq)), bfhi(a) * sigmoidf_(bfhi(bq)));
    }
    ylds[r * 256 + tid] = val;
  }
  __syncthreads();
  float w0[31], w1[31];
#pragma unroll
  for (int j = 0; j < 31; ++j) {
    const float2 wv = *(const float2*)(p.conv_w + j * 512 + 2 * tid);
    w0[j] = wv.x; w1[j] = wv.y;
  }
  const float2 bias = *(const float2*)(p.conv_b + 2 * tid);
  for (int sub = 0; sub < 4; ++sub) {
    float a0[8], a1[8];
#pragma unroll
    for (int q = 0; q < 8; ++q) { a0[q] = bias.x; a1[q] = bias.y; }
#pragma unroll
    for (int rr = 0; rr < 38; ++rr) {
      const u32 yv = ylds[(sub * 8 + rr) * 256 + tid];
      const float y0 = bflo(yv), y1 = bfhi(yv);
#pragma unroll
      for (int q = 0; q < 8; ++q) {
        const int j = rr - q;
        if (j >= 0 && j < 31) { a0[q] += w0[j] * y0; a1[q] += w1[j] * y1; }
      }
    }
#pragma unroll
    for (int q = 0; q < 8; ++q) *(float2*)(olds + q * 512 + 2 * tid) = make_float2(a0[q], a1[q]);
    __syncthreads();
#pragma unroll
    for (int q2 = 0; q2 < 2; ++q2) {
      const int q = wid * 2 + q2;
      const float4 va = *(const float4*)(olds + q * 512 + lane * 8);
      const float4 vb = *(const float4*)(olds + q * 512 + lane * 8 + 4);
      float s = va.x + va.y + va.z + va.w + vb.x + vb.y + vb.z + vb.w;
      s = wave_sum(s);
      const float mean = s * (1.0f / 512.f);
      float d[8] = {va.x - mean, va.y - mean, va.z - mean, va.w - mean, vb.x - mean, vb.y - mean, vb.z - mean, vb.w - mean};
      float vs = 0.f;
#pragma unroll
      for (int e = 0; e < 8; ++e) vs += d[e] * d[e];
      vs = wave_sum(vs);
      const float rstd = __builtin_amdgcn_rsqf(vs * (1.0f / 512.f) + 1e-5f);
      const float4 lw0 = *(const float4*)(p.ln_w + lane * 8), lw1 = *(const float4*)(p.ln_w + lane * 8 + 4);
      const float4 lb0 = *(const float4*)(p.ln_b + lane * 8), lb1 = *(const float4*)(p.ln_b + lane * 8 + 4);
      const float lw[8] = {lw0.x, lw0.y, lw0.z, lw0.w, lw1.x, lw1.y, lw1.z, lw1.w};
      const float lb[8] = {lb0.x, lb0.y, lb0.z, lb0.w, lb1.x, lb1.y, lb1.z, lb1.w};
      float o[8];
#pragma unroll
      for (int e = 0; e < 8; ++e) o[e] = siluf_(d[e] * rstd * lw[e] + lb[e]);
      uint4 pk = make_uint4(pack2(o[0], o[1]), pack2(o[2], o[3]), pack2(o[4], o[5]), pack2(o[6], o[7]));
      *(uint4*)(MIXIN + (size_t)(tok0 + sub * 8 + q) * D + lane * 8) = pk;
    }
    __syncthreads();
  }
}

__device__ __forceinline__ void phase_lora_conv(const Params& p, char* smem) {
  const u16* ACT = (const u16*)(p.ws + OFF_REGF + 128 * MB);
  const u16* WLORA = (const u16*)(p.ws + OFF_WLORA);
  u16* LW = (u16*)(p.ws + OFF_REGF);
  u16* AA = (u16*)(p.ws + OFF_REGD);
  u16* GG = (u16*)(p.ws + OFF_REGD + 32 * MB);
  constexpr int NT = 12, MT = T / 128, NG = NT * MT, NC = T / 32;
  for (int task = blockIdx.x; task < NG; task += gridDim.x) {
    {
      const int mt = task / NT, nt = task % NT;
      f32x16 acc[2][2];
      const int k0 = (nt < 8) ? 0 : 128;
      gemm128d(ACT + k0, 256, WLORA + k0, 256, 128, mt * 128, nt * 128, smem, acc);
      if (nt < 4) {
        epi_staged(acc, smem, [&](int row, int c4, float4 v) {
          const int n = nt * 128 + c4;
          const float4 w0 = *(const float4*)(p.w0 + n);
          const float vv[4] = {v.x + w0.x, v.y + w0.y, v.z + w0.z, v.w + w0.w};
          float o[4];
#pragma unroll
          for (int e = 0; e < 4; ++e) {
            const float z = -vv[e];
            const float sp = fmaxf(z, 0.f) + __logf(1.0f + __expf(-fabsf(z)));
            o[e] = -__expf(-sp - 0.5f);
          }
          *(uint2*)(LW + (size_t)(mt * 128 + row) * 512 + n) = make_uint2(pack2(o[0], o[1]), pack2(o[2], o[3]));
        });
      } else if (nt < 8) {
        epi_staged(acc, smem, [&](int row, int c4, float4 v) {
          const int n = (nt - 4) * 128 + c4;
          const float4 a0 = *(const float4*)(p.a0 + n);
          *(uint2*)(AA + (size_t)(mt * 128 + row) * 512 + n) =
              make_uint2(pack2(sigmoidf_(a0.x + v.x), sigmoidf_(a0.y + v.y)), pack2(sigmoidf_(a0.z + v.z), sigmoidf_(a0.w + v.w)));
        });
      } else {
        epi_staged(acc, smem, [&](int row, int c4, float4 v) {
          const int n = (nt - 8) * 128 + c4;
          *(uint2*)(GG + (size_t)(mt * 128 + row) * 512 + n) = make_uint2(pack2(v.x, v.y), pack2(v.z, v.w));
        });
      }
    }
  }
}

__device__ __forceinline__ void phase_scanprep(const Params& p) {
  const u16* P = (const u16*)(p.ws + OFF_PR);
  const u16* AA = (const u16*)(p.ws + OFF_REGD);
  u16* R = (u16*)(p.ws + OFF_REGF + 32 * MB);
  u16* KM = (u16*)(p.ws + OFF_REGF + 64 * MB);
  u16* V = (u16*)(p.ws + OFF_REGF + 96 * MB);
  u16* KKN = (u16*)(p.ws + OFF_REGF + 128 * MB);
  float* BONUS = (float*)(p.ws + OFF_BONUS);
  const int tid = threadIdx.x;
  const int c = (tid & 127) * 4;
  const float4 mur = *(const float4*)(p.mu + c), muk = *(const float4*)(p.mu + 512 + c), muv = *(const float4*)(p.mu + 1024 + c);
  const float4 kk_ = *(const float4*)(p.k_k + c), ka_ = *(const float4*)(p.k_a + c), rk_ = *(const float4*)(p.r_k + c);
  for (int tp = blockIdx.x; tp < T / 2; tp += gridDim.x) {
    const int t = tp * 2 + (tid >> 7);
    const bool first = (t % SEQ) == 0;
    const u16* pr = P + (size_t)t * 1792 + c;
    float r[4], k[4], v[4];
    {
      uint2 cu = *(const uint2*)pr, pv = first ? make_uint2(0u, 0u) : *(const uint2*)(pr - 1792);
      r[0] = bflo(cu.x); r[1] = bfhi(cu.x); r[2] = bflo(cu.y); r[3] = bfhi(cu.y);
      r[0] += mur.x * (bflo(pv.x) - r[0]); r[1] += mur.y * (bfhi(pv.x) - r[1]);
      r[2] += mur.z * (bflo(pv.y) - r[2]); r[3] += mur.w * (bfhi(pv.y) - r[3]);
    }
    {
      uint2 cu = *(const uint2*)(pr + 512), pv = first ? make_uint2(0u, 0u) : *(const uint2*)(pr + 512 - 1792);
      k[0] = bflo(cu.x); k[1] = bfhi(cu.x); k[2] = bflo(cu.y); k[3] = bfhi(cu.y);
      k[0] += muk.x * (bflo(pv.x) - k[0]); k[1] += muk.y * (bfhi(pv.x) - k[1]);
      k[2] += muk.z * (bflo(pv.y) - k[2]); k[3] += muk.w * (bfhi(pv.y) - k[3]);
    }
    {
      uint2 cu = *(const uint2*)(pr + 1024), pv = first ? make_uint2(0u, 0u) : *(const uint2*)(pr + 1024 - 1792);
      v[0] = bflo(cu.x); v[1] = bfhi(cu.x); v[2] = bflo(cu.y); v[3] = bfhi(cu.y);
      v[0] += muv.x * (bflo(pv.x) - v[0]); v[1] += muv.y * (bfhi(pv.x) - v[1]);
      v[2] += muv.z * (bflo(pv.y) - v[2]); v[3] += muv.w * (bfhi(pv.y) - v[3]);
    }
    const uint2 au = *(const uint2*)(AA + (size_t)t * 512 + c);
    const float a[4] = {bflo(au.x), bfhi(au.x), bflo(au.y), bfhi(au.y)};
    const float kkc[4] = {kk_.x, kk_.y, kk_.z, kk_.w}, kac[4] = {ka_.x, ka_.y, ka_.z, ka_.w}, rkc[4] = {rk_.x, rk_.y, rk_.z, rk_.w};
    float kk[4], km[4];
    float n2 = 0.f, bs = 0.f;
#pragma unroll
    for (int e = 0; e < 4; ++e) {
      kk[e] = k[e] * kkc[e];
      km[e] = k[e] * (1.f + (a[e] - 1.f) * kac[e]);
      n2 += kk[e] * kk[e];
      bs += r[e] * km[e] * rkc[e];
    }
    n2 = row16_sum(n2);
    bs = row16_sum(bs);
    const float inv = fminf(__builtin_amdgcn_rsqf(n2), 1e12f);
    const size_t o = (size_t)t * 512 + c;
    *(uint2*)(R + o) = make_uint2(pack2(r[0], r[1]), pack2(r[2], r[3]));
    *(uint2*)(KM + o) = make_uint2(pack2(km[0], km[1]), pack2(km[2], km[3]));
    *(uint2*)(V + o) = make_uint2(pack2(v[0], v[1]), pack2(v[2], v[3]));
    *(uint2*)(KKN + o) = make_uint2(pack2(kk[0] * inv, kk[1] * inv), pack2(kk[2] * inv, kk[3] * inv));
    if ((tid & 15) == 0) BONUS[(size_t)t * 8 + (c >> 6)] = bs;
  }
}

constexpr size_t OFF_EU8 = OFF_REGC + 128 * MB;
constexpr size_t OFF_EV8 = OFF_REGC + 144 * MB;
constexpr int CVT_CHUNKS = 256;
__device__ __forceinline__ void cvt_chunk(const Params& p, int chunk) {
  u32* EU = (u32*)(p.ws + OFF_EU8);
  u32* EV = (u32*)(p.ws + OFF_EV8);
  const float4* su = (const float4*)p.peer_u;
  const float4* sv = (const float4*)p.peer_v;
  const size_t base = (size_t)chunk * 16384;
#pragma unroll 4
  for (int q = 0; q < 64; ++q) {
    const size_t i = base + q * 256 + threadIdx.x;
    const float4 a = su[i], b = sv[i];
    int va = 0, vb = 0;
    va = __builtin_amdgcn_cvt_pk_fp8_f32(a.x * 512.f, a.y * 512.f, va, false);
    va = __builtin_amdgcn_cvt_pk_fp8_f32(a.z * 512.f, a.w * 512.f, va, true);
    vb = __builtin_amdgcn_cvt_pk_fp8_f32(b.x * 128.f, b.y * 128.f, vb, false);
    vb = __builtin_amdgcn_cvt_pk_fp8_f32(b.z * 128.f, b.w * 128.f, vb, true);
    EU[i] = (u32)va;
    EV[i] = (u32)vb;
  }
}

__device__ __forceinline__ void mix_unit(const Params& p, int u, char* smem) {
  for (int ci = 0; ci < 4; ++ci) conv_tile(p, u * 4 + ci, smem);
}

template <int OFF>
__device__ __forceinline__ f32x4 lds_ld4(unsigned addr) {
  f32x4 r;
  asm volatile("ds_read_b128 %0, %1 offset:%2" : "=v"(r) : "v"(addr), "n"(OFF));
  return r;
}
template <int OFF>
__device__ __forceinline__ float lds_ld1(unsigned addr) {
  float r;
  asm volatile("ds_read_b32 %0, %1 offset:%2" : "=v"(r) : "v"(addr), "n"(OFF));
  return r;
}
constexpr int SC_BUF = 27648;
template <int OFF>
__device__ __forceinline__ v2f lds_ld2(unsigned addr) {
  v2f r;
  asm volatile("ds_read_b64 %0, %1 offset:%2" : "=v"(r) : "v"(addr), "n"(OFF));
  return r;
}
__device__ __forceinline__ void phase_scan(const Params& p, char* smem, int rep) {
  const u16* LW = (const u16*)(p.ws + OFF_REGF);
  const u16* R = (const u16*)(p.ws + OFF_REGF + 32 * MB);
  const u16* KM = (const u16*)(p.ws + OFF_REGF + 64 * MB);
  const u16* V = (const u16*)(p.ws + OFF_REGF + 96 * MB);
  const u16* KKN = (const u16*)(p.ws + OFF_REGF + 128 * MB);
  const u16* AA = (const u16*)(p.ws + OFF_REGD);
  float* Y = (float*)(p.ws + OFF_Y);
  const int tid = threadIdx.x, lane = tid & 63, w = tid >> 6;
  const int jl = lane & 15;
  const int ss = tid >> 4, sg = tid & 15;
  unsigned* claim = (unsigned*)(p.ws + OFF_BAR) + XCD_BAR_WORDS + rep * (2048 + 64);
  unsigned* qctr = claim + 2048;
  int* sflag = (int*)(smem + 2 * SC_BUF);
  float* ypw = (float*)(smem + 56320) + w * 1024;
  const unsigned sbase = (unsigned)(size_t)(LAS char*)smem;
  if (tid == 0) {
    const unsigned key = (xb_xcc_id() & 7u) * 256u + (((unsigned)__builtin_amdgcn_s_getreg(63492) >> 8) & 0xffu);
    sflag[0] = (atomicAdd(&claim[key], 1u) == 0u) ? 1 : 0;
  }
  __syncthreads();
  const bool scan_role = sflag[0] != 0;
  for (;;) {
    if (!scan_role) break;
    __syncthreads();
    if (tid == 0) sflag[1] = (int)atomicAdd(&qctr[0], 1u);
    __syncthreads();
    const int task = sflag[1];
    if (task >= 256) break;
    const int bh = task >> 2, rg = task & 3, b = bh >> 3, h = bh & 7;
    const int il = rg * 16 + w * 4 + (lane >> 4);
    v2f Sa = v2f{0.f, 0.f}, Sb = v2f{0.f, 0.f};
    const size_t base = (size_t)b * SEQ * 512 + h * 64 + sg * 4;
    uint2 gA_lw, gA_r, gA_km, gA_v, gA_kkn, gA_a;
    uint2 gB_lw, gB_r, gB_km, gB_v, gB_kkn, gB_a;
#define SC_GLOAD(X, t0)                                      \
  {                                                          \
    const size_t o = base + (size_t)((t0) + ss) * 512;       \
    X##_lw = *(const uint2*)(LW + o); X##_r = *(const uint2*)(R + o);   \
    X##_km = *(const uint2*)(KM + o); X##_v = *(const uint2*)(V + o);   \
    X##_kkn = *(const uint2*)(KKN + o); X##_a = *(const uint2*)(AA + o); \
  }
#define SC_STORE(X, bi)                                                                                \
  {                                                                                                    \
    float* d = (float*)(smem + (bi) * SC_BUF) + ss * 64 + sg * 4;                                      \
    const float4 kq = make_float4(bflo(X##_kkn.x), bfhi(X##_kkn.x), bflo(X##_kkn.y), bfhi(X##_kkn.y)); \
    *(float4*)(d) = make_float4(__expf(bflo(X##_lw.x)), __expf(bfhi(X##_lw.x)), __expf(bflo(X##_lw.y)), __expf(bfhi(X##_lw.y))); \
    *(float4*)(d + 1024) = kq;                                                                         \
    *(float4*)(d + 2048) = make_float4(kq.x * bflo(X##_a.x), kq.y * bfhi(X##_a.x), kq.z * bflo(X##_a.y), kq.w * bfhi(X##_a.y)); \
    *(float4*)(d + 3072) = make_float4(bflo(X##_km.x), bfhi(X##_km.x), bflo(X##_km.y), bfhi(X##_km.y)); \
    *(float4*)(d + 4096) = make_float4(bflo(X##_r.x), bfhi(X##_r.x), bflo(X##_r.y), bfhi(X##_r.y));    \
    float* vt = (float*)(smem + (bi) * SC_BUF) + 5120 + (sg * 4) * 16 + ss;     \
    vt[0] = bflo(X##_v.x); vt[16] = bfhi(X##_v.x); vt[32] = bflo(X##_v.y); vt[48] = bfhi(X##_v.y);     \
  }
#define SC_ISSUE(sl, S)                                     \
  {                                                         \
    dec_[sl] = lds_ld4<(S) * 256>(a0);                      \
    kkn_[sl] = lds_ld4<4096 + (S) * 256>(a0);               \
    km_[sl] = lds_ld4<12288 + (S) * 256>(a0);               \
    if (((S) & 3) == 0) vq_[((S) >> 2) & 1] = lds_ld4<20480 + (S) * 4>(a1); \
    nb_[sl] = lds_ld4<8192 + (S) * 256>(a0);                \
    rr_[sl] = lds_ld4<16384 + (S) * 256>(a0);               \
  }
#define SC_WAIT(N, sl)                                                                          \
  asm volatile("s_waitcnt lgkmcnt(" #N ")"                                                      \
               : "+v"(dec_[sl]), "+v"(kkn_[sl]), "+v"(nb_[sl]), "+v"(km_[sl]), "+v"(rr_[sl]), "+v"(vq_[0]), "+v"(vq_[1]));
#define LO2(q) (v2f{(q).x, (q).y})
#define HI2(q) (v2f{(q).z, (q).w})
#define SC_STEP(S, N)                                                                       \
  {                                                                                         \
    if ((S) + 2 < 16) SC_ISSUE(((S) + 2) % 3, (S) + 2)                                      \
    SC_WAIT(N, (S) % 3)                                                                     \
    const f32x4 dec = dec_[(S) % 3], kkn = kkn_[(S) % 3], nb = nb_[(S) % 3], km = km_[(S) % 3], rr = rr_[(S) % 3]; \
    const float vv = vq_[((S) >> 2) & 1][(S) & 3];                                          \
    const v2f v2 = v2f{vv, vv};                                                             \
    const v2f Ta = Sa * LO2(dec) + v2 * LO2(km);                                            \
    const v2f Tb = Sb * HI2(dec) + v2 * HI2(km);                                            \
    const v2f dv = Sa * LO2(kkn) + Sb * HI2(kkn);                                           \
    float dot = dv.x + dv.y;                                                                \
    if ((S) > 0) {     \
      dot += DPP_ROR(dot, 8); ypend += DPP_ROR(ypend, 8);                                   \
      dot += DPP_ROR(dot, 4); ypend += DPP_ROR(ypend, 4);                                   \
      dot += DPP_ROR(dot, 2); ypend += DPP_ROR(ypend, 2);                                   \
      dot += DPP_ROR(dot, 1); ypend += DPP_ROR(ypend, 1);                                   \
      ykeep = (jl == (S) - 1) ? ypend : ykeep;                                              \
    } else {                                                                                \
      dot = row16_sum(dot);                                                                 \
    }                                                                                       \
    const v2f d2 = v2f{dot, dot};                                                           \
    Sa = Ta - d2 * LO2(nb);                                                                 \
    Sb = Tb - d2 * HI2(nb);                                                                 \
    const v2f yv = Sa * LO2(rr) + Sb * HI2(rr);                                             \
    ypend = yv.x + yv.y;                                                                    \
    if ((S) == 15) { ypend = row16_sum(ypend); ykeep = (jl == 15) ? ypend : ykeep; }        \
  }
#define SC_COMPUTE(c)                                                                       \
  {                                                                                         \
    const unsigned a0 = sbase + (unsigned)(((c) & 1) * SC_BUF + jl * 16);                   \
    const unsigned a1 = sbase + (unsigned)(((c) & 1) * SC_BUF + il * 64);                   \
    f32x4 dec_[3], kkn_[3], nb_[3], km_[3], rr_[3], vq_[2];                                 \
    float ykeep = 0.f, ypend = 0.f;                                                         \
    SC_ISSUE(0, 0)                                                                          \
    SC_ISSUE(1, 1)                                                                          \
    SC_STEP(0, 10) SC_STEP(1, 10) SC_STEP(2, 10) SC_STEP(3, 10) SC_STEP(4, 10) SC_STEP(5, 10) SC_STEP(6, 10) SC_STEP(7, 10) \
    SC_STEP(8, 10) SC_STEP(9, 10) SC_STEP(10, 10) SC_STEP(11, 10) SC_STEP(12, 10) SC_STEP(13, 10) SC_STEP(14, 5) SC_STEP(15, 0) \
    yp[(size_t)((c) * 16 + jl) * 512] = ykeep;                                              \
  }
    constexpr int NCH = SEQ / 16;
    float* yp = Y + (size_t)b * SEQ * 512 + h * 64 + il;
    __syncthreads();
    SC_GLOAD(gA, 0);
    SC_STORE(gA, 0);
    SC_GLOAD(gA, 16);
    SC_GLOAD(gB, 32);
    __syncthreads();
    for (int c = 0; c < NCH; c += 2) {
      SC_COMPUTE(c)
      SC_STORE(gA, 1)
      if (c + 3 < NCH) SC_GLOAD(gA, (c + 3) * 16);
      asm volatile("s_waitcnt lgkmcnt(0)\n\ts_barrier" ::: "memory");
      SC_COMPUTE(c + 1)
      if (c + 2 < NCH) {
        SC_STORE(gB, 0)
        if (c + 4 < NCH) SC_GLOAD(gB, (c + 4) * 16);
      }
      asm volatile("s_waitcnt lgkmcnt(0)\n\ts_barrier" ::: "memory");
    }
  }
  for (;;) {
    __syncthreads();
    if (tid == 0) sflag[3] = (int)atomicAdd(&qctr[32], 1u);
    __syncthreads();
    const int u = sflag[3];
    __syncthreads();
    if (u >= T / 128) break;
    mix_unit(p, u, smem);
  }
  for (;;) {
    __syncthreads();
    if (tid == 0) sflag[2] = (int)atomicAdd(&qctr[16], 1u);
    __syncthreads();
    const int ch = sflag[2];
    if (ch >= CVT_CHUNKS) break;
    cvt_chunk(p, ch);
  }
}

__device__ __forceinline__ void phase_post(const Params& p) {
  const float* Y = (const float*)(p.ws + OFF_Y);
  const u16* V = (const u16*)(p.ws + OFF_REGF + 96 * MB);
  const u16* GG = (const u16*)(p.ws + OFF_REGD + 32 * MB);
  const float* BONUS = (const float*)(p.ws + OFF_BONUS);
  u16* MIXIN = (u16*)(p.ws + OFF_REGB);
  const int tid = threadIdx.x;
  const int c = (tid & 127) * 4;
  const float4 gw = *(const float4*)(p.gn_w + c), gb = *(const float4*)(p.gn_b + c);
  for (int tp = blockIdx.x; tp < T / 2; tp += gridDim.x) {
    const int t = tp * 2 + (tid >> 7);
    const size_t o = (size_t)t * 512 + c;
    const float4 y = *(const float4*)(Y + o);
    float s = row16_sum(y.x + y.y + y.z + y.w);
    const float mean = s * (1.f / 64.f);
    const float d0 = y.x - mean, d1 = y.y - mean, d2 = y.z - mean, d3 = y.w - mean;
    const float var = row16_sum(d0 * d0 + d1 * d1 + d2 * d2 + d3 * d3) * (1.f / 64.f);
    const float rstd = __builtin_amdgcn_rsqf(var + 64e-5f);
    const float bon = BONUS[(size_t)t * 8 + (c >> 6)];
    const uint2 vu = *(const uint2*)(V + o), gu = *(const uint2*)(GG + o);
    const float o0 = (d0 * rstd * gw.x + gb.x + bon * bflo(vu.x)) * bflo(gu.x);
    const float o1 = (d1 * rstd * gw.y + gb.y + bon * bfhi(vu.x)) * bfhi(gu.x);
    const float o2 = (d2 * rstd * gw.z + gb.z + bon * bflo(vu.y)) * bflo(gu.y);
    const float o3 = (d3 * rstd * gw.w + gb.w + bon * bfhi(vu.y)) * bfhi(gu.y);
    *(uint2*)(MIXIN + (size_t)t * D + 512 + c) = make_uint2(pack2(o0, o1), pack2(o2, o3));
  }
}

__device__ __forceinline__ void phase_gemm_out(const Params& p, char* smem) {
  const u16* MIXIN = (const u16*)(p.ws + OFF_REGB);
  const u16* WOUT = (const u16*)(p.ws + OFF_WOUT);
  const float* MOD = (const float*)(p.ws + OFF_MOD);
  constexpr int NT = D / 128, MT = T / 128;
  for (int tile = blockIdx.x; tile < NT * MT; tile += gridDim.x) {
    const int mt = tile / NT, nt = tile % NT;
    f32x16 acc[2][2];
    gemm128d(MIXIN, D, WOUT, D, D, mt * 128, nt * 128, smem, acc);
    const int b = (mt * 128) / SEQ;
    const float* gt = MOD + b * 6144 + 2048 + nt * 128;
    epi_staged(acc, smem, [&](int row, int c4, float4 v) {
      const size_t o = (size_t)(mt * 128 + row) * D + nt * 128 + c4;
      const float4 xv = *(const float4*)(p.x + o);
      const float4 g = *(const float4*)(gt + c4);
      *(float4*)(p.out + o) = make_float4(xv.x + g.x * v.x, xv.y + g.y * v.y, xv.z + g.z * v.z, xv.w + g.w * v.w);
    });
  }
}

__device__ __forceinline__ u32 f2ord(float f) {
  u32 u = __float_as_uint(f);
  return (u & 0x80000000u) ? ~u : (u | 0x80000000u);
}
__device__ __forceinline__ float ord2f(u32 u) {
  u = (u & 0x80000000u) ? (u & 0x7FFFFFFFu) : ~u;
  return __uint_as_float(u);
}
#define TOPK_INSERT(L, x)                       \
  {                                             \
    u32 _x = (x);                               \
    _Pragma("unroll") for (int _i = 0; _i < 16; ++_i) { \
      u32 _hi = max(L[_i], _x);                 \
      _x = min(L[_i], _x);                      \
      L[_i] = _hi;                              \
    }                                           \
  }

#define CMPEX_DESC(a, b) { const u32 _hi = max(a, b); const u32 _lo = min(a, b); a = _hi; b = _lo; }
__device__ __forceinline__ void sort16_desc(u32 (&v)[16]) {
#pragma unroll
  for (int k = 2; k <= 16; k <<= 1) {
#pragma unroll
    for (int j = k >> 1; j > 0; j >>= 1) {
#pragma unroll
      for (int i = 0; i < 16; ++i) {
        const int l = i ^ j;
        if (l > i) {
          if ((i & k) == 0) CMPEX_DESC(v[i], v[l]) else CMPEX_DESC(v[l], v[i])
        }
      }
    }
  }
}
__device__ __forceinline__ void merge16_desc(u32 (&a)[16], const u32 (&b)[16]) {
#pragma unroll
  for (int i = 0; i < 16; ++i) a[i] = max(a[i], b[15 - i]);
#pragma unroll
  for (int j = 8; j > 0; j >>= 1) {
#pragma unroll
    for (int i = 0; i < 16; ++i) {
      const int l = i ^ j;
      if (l > i) CMPEX_DESC(a[i], a[l])
    }
  }
}

__device__ __forceinline__ void phase_peer_route(const Params& p, char* smem) {
  const u16* U2 = (const u16*)(p.ws + OFF_REGB);
  const u16* WQ = (const u16*)(p.ws + OFF_WQ);
  const u16* KEYS = (const u16*)(p.ws + OFF_KEYS);
  int* EXPID = (int*)(p.ws + OFF_EXPID);
  float* GATE = (float*)(p.ws + OFF_GATE);
  const int tid = threadIdx.x, lane = tid & 63, wid = tid >> 6, wm = wid >> 1, wn = wid & 1, fr = lane & 15, fq = lane >> 4;
  constexpr int QROWB = 272;
  char* qs = smem;
  char* ks = smem + 128 * QROWB;
  float* sT = (float*)smem;
  for (int task = blockIdx.x; task < (T / 128) * PEER_H; task += gridDim.x) {
    const int mt = task / PEER_H, h = task % PEER_H;
    u32 L0[16], L1[16];
#pragma unroll
    for (int pp = 0; pp < 2; ++pp) {
      f32x16 sc[2][2];
      gemm128(U2, D, WQ, D, D, mt * 128, h * 256 + pp * 128, smem, sc);
      {
        const int fr32 = lane & 31, fh = lane >> 5;
#pragma unroll
        for (int mi = 0; mi < 2; ++mi)
#pragma unroll
          for (int ni = 0; ni < 2; ++ni)
#pragma unroll
            for (int g = 0; g < 4; ++g)
              *(f32x4*)(sT + (wm * 64 + mi * 32 + fr32) * 132 + wn * 64 + ni * 32 + g * 8 + fh * 4) =
                  f32x4{sc[mi][ni][g * 4 + 0], sc[mi][ni][g * 4 + 1], sc[mi][ni][g * 4 + 2], sc[mi][ni][g * 4 + 3]};
      }
      __syncthreads();
      {
        const int trow = tid & 127, half = tid >> 7;
        u32 L[16];
#pragma unroll
        for (int i = 0; i < 16; ++i) L[i] = 0u;
#pragma unroll 1
        for (int g = 0; g < 4; ++g) {
          u32 grp[16];
          const int kb = half * 64 + g * 16;
#pragma unroll
          for (int i4 = 0; i4 < 4; ++i4) {
            const float4 sv = *(const float4*)(sT + trow * 132 + kb + i4 * 4);
            grp[i4 * 4 + 0] = (f2ord(sv.x) & ~0x7Fu) | (u32)(127 - kb - i4 * 4);
            grp[i4 * 4 + 1] = (f2ord(sv.y) & ~0x7Fu) | (u32)(126 - kb - i4 * 4);
            grp[i4 * 4 + 2] = (f2ord(sv.z) & ~0x7Fu) | (u32)(125 - kb - i4 * 4);
            grp[i4 * 4 + 3] = (f2ord(sv.w) & ~0x7Fu) | (u32)(124 - kb - i4 * 4);
          }
          sort16_desc(grp);
          merge16_desc(L, grp);
        }
        __syncthreads();
        u32* xl = (u32*)smem;
        if (half == 1) {
#pragma unroll
          for (int i = 0; i < 16; ++i) xl[trow * 17 + i] = L[i];
        }
        __syncthreads();
        if (half == 0) {
          u32 oth[16];
#pragma unroll
          for (int i = 0; i < 16; ++i) oth[i] = xl[trow * 17 + i];
          merge16_desc(L, oth);
#pragma unroll
          for (int i = 0; i < 16; ++i) {
            if (pp == 0) L0[i] = L[i]; else L1[i] = L[i];
          }
        }
      }
      __syncthreads();
    }
    if (tid < 128) {
      float s0[16], s1[16];
#pragma unroll
      for (int i = 0; i < 16; ++i) {
        s0[i] = ord2f(L0[i] & ~0x7Fu);
        s1[i] = ord2f(L1[i] & ~0x7Fu);
      }
#define CKEY(i, j) ((f2ord(s0[i] + s1[j]) & ~0xFFu) | (u32)(255 - ((i) * 16 + (j))))
      u32 B[16], Bk[16], Ck[16], Dk[16];
#pragma unroll
      for (int j = 0; j < 16; ++j) B[j] = CKEY(0, j);
#pragma unroll
      for (int j = 0; j < 8; ++j) Bk[j] = CKEY(1, j);
#pragma unroll
      for (int j = 0; j < 5; ++j) Bk[8 + j] = CKEY(2, j);
#pragma unroll
      for (int j = 0; j < 3; ++j) Bk[13 + j] = CKEY(4, j);
#pragma unroll
      for (int j = 0; j < 4; ++j) Ck[j] = CKEY(3, j);
#pragma unroll
      for (int j = 0; j < 2; ++j) { Ck[4 + j] = CKEY(5, j); Ck[6 + j] = CKEY(6, j); Ck[8 + j] = CKEY(7, j); }
#pragma unroll
      for (int i = 8; i < 14; ++i) Ck[10 + (i - 8)] = CKEY(i, 0);
      {
        const u32 d14 = CKEY(14, 0), d15 = CKEY(15, 0);
        Dk[0] = max(d14, d15);
        Dk[1] = min(d14, d15);
#pragma unroll
        for (int i = 2; i < 16; ++i) Dk[i] = 0u;
      }
#undef CKEY
      sort16_desc(Bk);
      sort16_desc(Ck);
      merge16_desc(B, Bk);
      merge16_desc(B, Ck);
      merge16_desc(B, Dk);
      float bv[16];
      int eid[16];
      u32* slot = (u32*)smem + tid * 33;
#pragma unroll
      for (int z = 0; z < 16; ++z) { slot[z] = L0[z]; slot[16 + z] = L1[z]; }
#pragma unroll
      for (int q = 0; q < 16; ++q) {
        const int pos = 255 - (int)(B[q] & 0xFFu);
        const u32 a = slot[pos >> 4], bq = slot[16 + (pos & 15)];
        const int i0 = 127 - (int)(a & 0x7Fu), i1 = 127 - (int)(bq & 0x7Fu);
        eid[q] = i0 * NKEYS + i1;
        bv[q] = ord2f(a & ~0x7Fu) + ord2f(bq & ~0x7Fu);
      }
      float mx = bv[0];
#pragma unroll
      for (int q = 1; q < 16; ++q) mx = fmaxf(mx, bv[q]);
      float den = 0.f;
#pragma unroll
      for (int q = 0; q < 16; ++q) { bv[q] = __expf(bv[q] - mx); den += bv[q]; }
      const float rden = __builtin_amdgcn_rcpf(den);
      const size_t o = ((size_t)(mt * 128 + tid) * PEER_H + h) * 16;
#pragma unroll
      for (int q = 0; q < 16; q += 4) {
        *(int4*)(EXPID + o + q) = make_int4(eid[q], eid[q + 1], eid[q + 2], eid[q + 3]);
        *(float4*)(GATE + o + q) = make_float4(bv[q] * rden, bv[q + 1] * rden, bv[q + 2] * rden, bv[q + 3] * rden);
      }
    }
    __syncthreads();
  }
}

#define CVT_LO(w) __builtin_amdgcn_cvt_pk_f32_fp8((int)(w), false)
#define CVT_HI(w) __builtin_amdgcn_cvt_pk_f32_fp8((int)(w), true)
__device__ __forceinline__ void phase_peer_gather(const Params& p) {
  const u16* U2 = (const u16*)(p.ws + OFF_REGB);
  const uint4* EU = (const uint4*)(p.ws + OFF_EU8);
  const uint4* EV = (const uint4*)(p.ws + OFF_EV8);
  const int* EXPID = (const int*)(p.ws + OFF_EXPID);
  const float* GATE = (const float*)(p.ws + OFF_GATE);
  const float* MOD = (const float*)(p.ws + OFF_MOD);
  const int lane = threadIdx.x & 63;
  const int gw = blockIdx.x * 4 + (threadIdx.x >> 6), nw = gridDim.x * 4;
  for (int t = gw; t < T; t += nw) {
    const int b = t / SEQ;
    const uint4 xa = *(const uint4*)(U2 + (size_t)t * D + lane * 16);
    const uint4 xb = *(const uint4*)(U2 + (size_t)t * D + lane * 16 + 8);
    v2f x2[8];
    x2[0] = v2f{bflo(xa.x), bfhi(xa.x)}; x2[1] = v2f{bflo(xa.y), bfhi(xa.y)};
    x2[2] = v2f{bflo(xa.z), bfhi(xa.z)}; x2[3] = v2f{bflo(xa.w), bfhi(xa.w)};
    x2[4] = v2f{bflo(xb.x), bfhi(xb.x)}; x2[5] = v2f{bflo(xb.y), bfhi(xb.y)};
    x2[6] = v2f{bflo(xb.z), bfhi(xb.z)}; x2[7] = v2f{bflo(xb.w), bfhi(xb.w)};
    v2f o2[8];
#pragma unroll
    for (int i = 0; i < 8; ++i) o2[i] = v2f{0.f, 0.f};
    const int idA = EXPID[(size_t)t * 128 + lane], idB = EXPID[(size_t)t * 128 + 64 + lane];
    const float gA = GATE[(size_t)t * 128 + lane], gB = GATE[(size_t)t * 128 + 64 + lane];
    for (int h = 0; h < PEER_H; ++h) {
      const int idv = (h < 4) ? idA : idB;
      const float gtv = (h < 4) ? gA : gB;
      const int lb = (h & 3) * 16;
      float part[16];
#pragma unroll
      for (int e = 0; e < 16; ++e) {
        const int id = __builtin_amdgcn_readlane(idv, lb + e);
        const uint4 a = EU[(size_t)id * 64 + lane];
        v2f acc = CVT_LO(a.x) * x2[0];
        acc = CVT_HI(a.x) * x2[1] + acc;
        acc = CVT_LO(a.y) * x2[2] + acc;
        acc = CVT_HI(a.y) * x2[3] + acc;
        acc = CVT_LO(a.z) * x2[4] + acc;
        acc = CVT_HI(a.z) * x2[5] + acc;
        acc = CVT_LO(a.w) * x2[6] + acc;
        acc = CVT_HI(a.w) * x2[7] + acc;
        part[e] = acc.x + acc.y;
      }
      float p8[8], p4[4], p2[2], p1;
      {
        const bool up = (lane & 32) != 0;
#pragma unroll
        for (int e = 0; e < 8; ++e) {
          const float mine = up ? part[e + 8] : part[e];
          const float oth = up ? part[e] : part[e + 8];
          p8[e] = mine + __shfl_xor(oth, 32);
        }
      }
      {
        const bool up = (lane & 16) != 0;
#pragma unroll
        for (int e = 0; e < 4; ++e) {
          const float mine = up ? p8[e + 4] : p8[e];
          const float oth = up ? p8[e] : p8[e + 4];
          p4[e] = mine + __shfl_xor(oth, 16);
        }
      }
      {
        const bool up = (lane & 8) != 0;
#pragma unroll
        for (int e = 0; e < 2; ++e) {
          const float mine = up ? p4[e + 2] : p4[e];
          const float oth = up ? p4[e] : p4[e + 2];
          p2[e] = mine + DPP_ROR(oth, 8);
        }
      }
      {
        const bool up = (lane & 4) != 0;
        const float mine = up ? p2[1] : p2[0];
        const float oth = up ? p2[0] : p2[1];
        p1 = mine + __shfl_xor(oth, 4);
      }
      p1 += __builtin_bit_cast(float, __builtin_amdgcn_update_dpp(0, __builtin_bit_cast(int, p1), 0x4E, 0xF, 0xF, false));
      p1 += __builtin_bit_cast(float, __builtin_amdgcn_update_dpp(0, __builtin_bit_cast(int, p1), 0xB1, 0xF, 0xF, false));
      p1 *= (1.0f / 512.f);
      const int myE = ((lane >> 5) & 1) * 8 + ((lane >> 4) & 1) * 4 + ((lane >> 3) & 1) * 2 + ((lane >> 2) & 1);
      const float gmine = __shfl(gtv, lb + myE);
      const float hv = 0.5f * p1 * (1.0f + erff(p1 * 0.70710678118654752f));
      const float coef = gmine * hv * (1.0f / 128.f);
#pragma unroll
      for (int e = 0; e < 16; ++e) {
        const int srcLane = ((e >> 3) & 1) * 32 + ((e >> 2) & 1) * 16 + ((e >> 1) & 1) * 8 + (e & 1) * 4;
        const float ce = __builtin_bit_cast(float, __builtin_amdgcn_readlane(__builtin_bit_cast(int, coef), srcLane));
        const int id = __builtin_amdgcn_readlane(idv, lb + e);
        const uint4 a = EV[(size_t)id * 64 + lane];
        const v2f c2 = v2f{ce, ce};
        o2[0] = CVT_LO(a.x) * c2 + o2[0];
        o2[1] = CVT_HI(a.x) * c2 + o2[1];
        o2[2] = CVT_LO(a.y) * c2 + o2[2];
        o2[3] = CVT_HI(a.y) * c2 + o2[3];
        o2[4] = CVT_LO(a.z) * c2 + o2[4];
        o2[5] = CVT_HI(a.z) * c2 + o2[5];
        o2[6] = CVT_LO(a.w) * c2 + o2[6];
        o2[7] = CVT_HI(a.w) * c2 + o2[7];
      }
    }
    float* orow = p.out + (size_t)t * D + lane * 16;
    const float* gt = MOD + b * 6144 + 5120 + lane * 16;
    float xf[16];
    float ss = 0.f;
#pragma unroll
    for (int q = 0; q < 4; ++q) {
      const float4 x0 = *(const float4*)(orow + q * 4);
      const float4 g0 = *(const float4*)(gt + q * 4);
      xf[q * 4 + 0] = x0.x + g0.x * o2[q * 2].x;
      xf[q * 4 + 1] = x0.y + g0.y * o2[q * 2].y;
      xf[q * 4 + 2] = x0.z + g0.z * o2[q * 2 + 1].x;
      xf[q * 4 + 3] = x0.w + g0.w * o2[q * 2 + 1].y;
    }
#pragma unroll
    for (int i = 0; i < 16; ++i) ss += xf[i] * xf[i];
    ss = wave_sum(ss);
    const float rstd = __builtin_amdgcn_rsqf(ss * (1.0f / D) + 1e-6f);
#pragma unroll
    for (int q = 0; q < 4; ++q) {
      const float4 f0 = *(const float4*)(p.final_g + lane * 16 + q * 4);
      *(float4*)(orow + q * 4) =
          make_float4(xf[q * 4 + 0] * rstd * f0.x, xf[q * 4 + 1] * rstd * f0.y, xf[q * 4 + 2] * rstd * f0.z, xf[q * 4 + 3] * rstd * f0.w);
    }
  }
}

#ifndef PROBE_MASK
#define PROBE_MASK 0
#endif
__global__ void __launch_bounds__(NTHREADS, 2) hymba_mega(Params p) {
  __shared__ __attribute__((aligned(16))) char smem[SMEM_BYTES];
  __shared__ uint4 xb_words;
  cg::grid_group grid = cg::this_grid();
  if (threadIdx.x == 0) xb_words = make_uint4(0u, 0u, 0u, 0u);
  __syncthreads();
  const XcdBarrier xb = xcd_barrier_post((unsigned*)(p.ws + OFF_BAR), (volatile LAS unsigned*)&xb_words);
#define RUN_PHASE(N, CALL)                          \
  {                                                 \
    CALL;                                           \
    if ((PROBE_MASK >> (N)) & 1) { xcd_barrier(xb); CALL; } \
  }
  RUN_PHASE(0, phase_prep(p, smem))
  xcd_barrier(xb);
  phase_peer_fold(p, smem);
  RUN_PHASE(1, phase_normmod(p.x, p.norm_mix_g, (const float*)(p.ws + OFF_MOD), 0, 1024, (u16*)(p.ws + OFF_REGB)))
  xcd_barrier(xb);
  RUN_PHASE(2, phase_gemm_in(p, smem))
  xcd_barrier(xb);
  RUN_PHASE(3, phase_act(p))
  xcd_barrier(xb);
  RUN_PHASE(4, phase_lora_conv(p, smem))
  xcd_barrier(xb);
  RUN_PHASE(5, phase_scanprep(p))
  xcd_barrier(xb);
  phase_scan(p, smem, 0);
  grid.sync();
  RUN_PHASE(7, phase_post(p))
  xcd_barrier(xb);
  RUN_PHASE(8, phase_gemm_out(p, smem))
  xcd_barrier(xb);
  RUN_PHASE(9, phase_normmod(p.out, p.norm_ffn_g, (const float*)(p.ws + OFF_MOD), 3072, 4096, (u16*)(p.ws + OFF_REGB)))
  xcd_barrier(xb);
  RUN_PHASE(10, phase_peer_route(p, smem))
  xcd_barrier(xb);
  phase_peer_gather(p);
#ifdef PROBE_TIME
  xcd_barrier(xb);
  if (blockIdx.x == 0 && threadIdx.x == 0) p.out[0] += *(const float*)(p.ws + OFF_BAR + 32768);
#endif
}

extern "C" void kernel_launch(void* const* d_in, const int* in_sizes, int n_in, void* d_out, int out_size, void* d_ws,
                              size_t ws_size, hipStream_t stream) {
  static int grid_blocks = 0;
  if (!grid_blocks) {
    int dev = 0, cus = 0, per_cu = 0;
    (void)hipGetDevice(&dev);
    (void)hipDeviceGetAttribute(&cus, hipDeviceAttributeMultiprocessorCount, dev);
    (void)hipOccupancyMaxActiveBlocksPerMultiprocessor(&per_cu, hymba_mega, NTHREADS, 0);
    if (per_cu > 2) per_cu = 2;
    grid_blocks = cus * per_cu;
  }
  if (ws_size < WS_NEEDED) {
    fprintf(stderr, "workspace too small: %zu < %zu\n", ws_size, (size_t)WS_NEEDED);
    return;
  }
  Params p{};
  const float** pf = (const float**)&p;
  for (int i = 0; i < 28; ++i) pf[i] = (const float*)d_in[i];
  p.out = (float*)d_out;
  p.ws = (char*)d_ws;
  (void)hipMemsetAsync((char*)d_ws + OFF_BAR, 0, (XCD_BAR_WORDS + 2 * (2048 + 64)) * 4, stream);
  void* args[] = {&p};
  hipError_t e = hipLaunchCooperativeKernel((void*)hymba_mega, dim3(grid_blocks), dim3(NTHREADS), args, 0, stream);
  if (e != hipSuccess) fprintf(stderr, "cooperative launch failed: %s (grid %d)\n", hipGetErrorString(e), grid_blocks);
}
```
